# Optimizing an MI355X kernel written in HIP

```python
import math
import jax, jax.numpy as jnp
from jax import lax
import numpy as np

D_MODEL = 2048
BATCH = 4
SEQ = 4096
DEPTH = 2

POOL_WIDTH = D_MODEL // 2
POOL_WINDOWS = (2, 4, 8, 16)
N_POOL_GROUPS = len(POOL_WINDOWS)
POOL_GROUP = POOL_WIDTH // N_POOL_GROUPS
DIFF_HEADS = 8
DIFF_HEAD_DIM = 64
DIFF_WIDTH = DIFF_HEADS * 2 * DIFF_HEAD_DIM
Q_BLOCK = 128
MIX_IN_EVEN = POOL_WIDTH + 3 * DIFF_WIDTH
MIX_OUT_EVEN = POOL_WIDTH + DIFF_WIDTH
CONV_WIDTH = D_MODEL
CONV_K = 3
D_FF = 5632
N_EXPERTS = 8
TOP_K = 2
EXPERT_FF = 7168
LN_EPS = 1e-5
RMS_EPS = 1e-5
ALPHA = (2 * DEPTH) ** 0.25
BETA = (8 * DEPTH) ** -0.25
N_EVEN = (DEPTH + 1) // 2
N_ODD = DEPTH // 2

kernel_name = 'hybrid_pool_diffattn_shortconv_moe_deepnorm'


def layer_norm(x, g, b):
    xf = x.astype(jnp.float32)
    mu = jnp.mean(xf, axis=-1, keepdims=True)
    var = jnp.mean(jnp.square(xf - mu), axis=-1, keepdims=True)
    return ((xf - mu) * lax.rsqrt(var + LN_EPS) * g + b).astype(x.dtype)


def lambda_init_fn(layer_idx):
    return 0.8 - 0.6 * math.exp(-0.3 * layer_idx)


def causal_pool_minus_identity(u, window):
    s = u.shape[1]
    c = jnp.cumsum(u.astype(jnp.float32), axis=1)
    c_prev = jnp.pad(c, ((0, 0), (window, 0), (0, 0)))[:, :s]
    count = jnp.minimum(jnp.arange(1, s + 1), window).astype(jnp.float32)
    mean = (c - c_prev) / count[None, :, None]
    return (mean - u.astype(jnp.float32)).astype(u.dtype)


def pool_mixer(u, w_group, scale):
    groups = jnp.split(u, N_POOL_GROUPS, axis=-1)
    pooled = jnp.stack([causal_pool_minus_identity(g_, w) for g_, w in zip(groups, POOL_WINDOWS)], axis=2)
    mixed = jnp.einsum('bsgc,gcd->bsgd', pooled, w_group)
    return mixed.reshape(u.shape) * scale


def diff_attention(q, k, v, lam):
    b, h, _, s, d = q.shape
    n_blk = s // Q_BLOCK
    scale = d ** -0.5
    kf = k.astype(jnp.float32)
    vf = v.astype(jnp.float32)
    qb = q.reshape(b, h, 2, n_blk, Q_BLOCK, d).transpose(3, 0, 1, 2, 4, 5)
    k_pos = jnp.arange(s)

    def one_block(args):
        q_blk, start = args
        sc = jnp.einsum('bhcqd,bhckd->bhcqk', q_blk.astype(jnp.float32), kf) * scale
        q_pos = start + jnp.arange(Q_BLOCK)
        mask = k_pos[None, :] <= q_pos[:, None]
        sc = jnp.where(mask, sc, -jnp.inf)
        p = jax.nn.softmax(sc, axis=-1)
        a = p[:, :, 0] - lam * p[:, :, 1]
        return jnp.einsum('bhqk,bhkv->bhqv', a, vf)

    starts = jnp.arange(n_blk) * Q_BLOCK
    out = lax.map(one_block, (qb, starts))
    return out.transpose(1, 2, 0, 3, 4).reshape(b, h, s, 2 * d)


def even_mixer(x, w_in, w_pool, pool_scale, lam_q1, lam_k1, lam_q2, lam_k2, subln_g, w_out, lam_init):
    b, s, _ = x.shape
    hcat = x @ w_in
    u_pool, q, k, v = jnp.split(hcat, [POOL_WIDTH, POOL_WIDTH + DIFF_WIDTH, POOL_WIDTH + 2 * DIFF_WIDTH], axis=-1)
    q = q.reshape(b, s, DIFF_HEADS, 2, DIFF_HEAD_DIM).transpose(0, 2, 3, 1, 4)
    k = k.reshape(b, s, DIFF_HEADS, 2, DIFF_HEAD_DIM).transpose(0, 2, 3, 1, 4)
    v = v.reshape(b, s, DIFF_HEADS, 2 * DIFF_HEAD_DIM).transpose(0, 2, 1, 3)
    lam = (jnp.exp(jnp.sum(lam_q1.astype(jnp.float32) * lam_k1.astype(jnp.float32)))
           - jnp.exp(jnp.sum(lam_q2.astype(jnp.float32) * lam_k2.astype(jnp.float32))) + lam_init)
    o = diff_attention(q, k, v, lam)
    o = o * lax.rsqrt(jnp.mean(jnp.square(o), axis=-1, keepdims=True) + RMS_EPS) * subln_g * (1.0 - lam_init)
    o = o.transpose(0, 2, 1, 3).reshape(b, s, DIFF_WIDTH).astype(x.dtype)
    a = pool_mixer(u_pool, w_pool, pool_scale)
    return jnp.concatenate([a, o], axis=-1) @ w_out


def odd_mixer(x, w_in, conv_w, w_out):
    hcat = x @ w_in
    b_gate, c_gate, hx = jnp.split(hcat, 3, axis=-1)
    z = c_gate * hx
    y = lax.conv_general_dilated(z, conv_w, window_strides=(1,), padding=[(CONV_K - 1, 0)],
                                 dimension_numbers=('NWC', 'WIO', 'NWC'), feature_group_count=CONV_WIDTH)
    return (b_gate * y) @ w_out


def swiglu(x, wg, wu, wd):
    return (jax.nn.silu(x @ wg) * (x @ wu)) @ wd


def moe_swiglu(x, w_router, wg, wu, wd):
    xt = x.reshape(-1, x.shape[-1])
    logits = (xt @ w_router).astype(jnp.float32)
    top_v, top_i = lax.top_k(logits, TOP_K)
    gates = jax.nn.softmax(top_v, axis=-1)
    combine = jnp.sum(jax.nn.one_hot(top_i, N_EXPERTS, dtype=jnp.float32) * gates[..., None], axis=1)
    out = jnp.zeros(xt.shape, jnp.float32)
    for e in range(N_EXPERTS):
        out = out + combine[:, e:e + 1] * swiglu(xt, wg[e], wu[e], wd[e])
    return out.astype(x.dtype).reshape(x.shape)


def setup_inputs(seed: int = 0) -> dict:
    key = jax.random.key(seed)
    ks = iter(jax.random.split(key, 40))
    f32 = jnp.float32

    def w(shape, fan_in, mult=1.0):
        return jax.random.normal(next(ks), shape, f32) * (fan_in ** -0.5) * mult

    def gain(shape):
        return 1.0 + 0.05 * jax.random.normal(next(ks), shape, f32)

    def bias(shape):
        return 0.02 * jax.random.normal(next(ks), shape, f32)

    x = jax.random.normal(next(ks), (BATCH, SEQ, D_MODEL), f32)
    return {
        'x': x,
        'ev_w_in': w((N_EVEN, D_MODEL, MIX_IN_EVEN), D_MODEL),
        'ev_w_pool': w((N_EVEN, N_POOL_GROUPS, POOL_GROUP, POOL_GROUP), POOL_GROUP),
        'ev_pool_scale': gain((N_EVEN, POOL_WIDTH)),
        'ev_lam_q1': 0.1 * jax.random.normal(next(ks), (N_EVEN, DIFF_HEAD_DIM), f32),
        'ev_lam_k1': 0.1 * jax.random.normal(next(ks), (N_EVEN, DIFF_HEAD_DIM), f32),
        'ev_lam_q2': 0.1 * jax.random.normal(next(ks), (N_EVEN, DIFF_HEAD_DIM), f32),
        'ev_lam_k2': 0.1 * jax.random.normal(next(ks), (N_EVEN, DIFF_HEAD_DIM), f32),
        'ev_subln_g': gain((N_EVEN, 2 * DIFF_HEAD_DIM)),
        'ev_w_out': w((N_EVEN, MIX_OUT_EVEN, D_MODEL), MIX_OUT_EVEN, BETA),
        'ev_ln1_g': gain((N_EVEN, D_MODEL)),
        'ev_ln1_b': bias((N_EVEN, D_MODEL)),
        'ev_ffn_wg': w((N_EVEN, D_MODEL, D_FF), D_MODEL),
        'ev_ffn_wu': w((N_EVEN, D_MODEL, D_FF), D_MODEL),
        'ev_ffn_wd': w((N_EVEN, D_FF, D_MODEL), D_FF, BETA),
        'ev_ln2_g': gain((N_EVEN, D_MODEL)),
        'ev_ln2_b': bias((N_EVEN, D_MODEL)),
        'od_w_in': w((N_ODD, D_MODEL, 3 * CONV_WIDTH), D_MODEL),
        'od_conv_w': w((N_ODD, CONV_K, 1, CONV_WIDTH), CONV_K),
        'od_w_out': w((N_ODD, CONV_WIDTH, D_MODEL), CONV_WIDTH, BETA),
        'od_ln1_g': gain((N_ODD, D_MODEL)),
        'od_ln1_b': bias((N_ODD, D_MODEL)),
        'od_router': w((N_ODD, D_MODEL, N_EXPERTS), D_MODEL),
        'od_exp_wg': w((N_ODD, N_EXPERTS, D_MODEL, EXPERT_FF), D_MODEL),
        'od_exp_wu': w((N_ODD, N_EXPERTS, D_MODEL, EXPERT_FF), D_MODEL),
        'od_exp_wd': w((N_ODD, N_EXPERTS, EXPERT_FF, D_MODEL), EXPERT_FF, BETA),
        'od_ln2_g': gain((N_ODD, D_MODEL)),
        'od_ln2_b': bias((N_ODD, D_MODEL)),
    }


def reference(x, ev_w_in, ev_w_pool, ev_pool_scale, ev_lam_q1, ev_lam_k1, ev_lam_q2, ev_lam_k2,
              ev_subln_g, ev_w_out, ev_ln1_g, ev_ln1_b, ev_ffn_wg, ev_ffn_wu, ev_ffn_wd, ev_ln2_g, ev_ln2_b,
              od_w_in, od_conv_w, od_w_out, od_ln1_g, od_ln1_b, od_router, od_exp_wg, od_exp_wu, od_exp_wd,
              od_ln2_g, od_ln2_b):
    for layer in range(DEPTH):
        i = layer // 2
        if layer % 2 == 0:
            lam_init = lambda_init_fn(layer)
            m = even_mixer(x, ev_w_in[i], ev_w_pool[i], ev_pool_scale[i], ev_lam_q1[i], ev_lam_k1[i],
                           ev_lam_q2[i], ev_lam_k2[i], ev_subln_g[i], ev_w_out[i], lam_init)
            x = layer_norm(ALPHA * x + m, ev_ln1_g[i], ev_ln1_b[i])
            f = swiglu(x, ev_ffn_wg[i], ev_ffn_wu[i], ev_ffn_wd[i])
            x = layer_norm(ALPHA * x + f, ev_ln2_g[i], ev_ln2_b[i])
        else:
            m = odd_mixer(x, od_w_in[i], od_conv_w[i], od_w_out[i])
            x = layer_norm(ALPHA * x + m, od_ln1_g[i], od_ln1_b[i])
            f = moe_swiglu(x, od_router[i], od_exp_wg[i], od_exp_wu[i], od_exp_wd[i])
            x = layer_norm(ALPHA * x + f, od_ln2_g[i], od_ln2_b[i])
    return x
```

```cpp
#include <hip/hip_runtime.h>
#include <cstdio>
#include <cstdint>

constexpr int BATCH = 4, SEQ = 4096, DM = 2048, M = BATCH * SEQ;
constexpr int PW = 1024, NPG = 4, PG = 256;
constexpr int NH = 8, HD = 64, AW = 1024;
constexpr int DFF = 5632, NE = 8, EFF = 7168;
constexpr float LN_EPS = 1e-5f, RMS_EPS = 1e-5f;
constexpr float ALPHA = 1.41421356237309515f;
constexpr float LAM_INIT0 = 0.2f;
constexpr float C2 = 0.125f * 1.4426950408889634f;
constexpr int MAXRT = 136;
constexpr int SLOTS = MAXRT * 256;

typedef unsigned short bf16;
typedef float f32x4 __attribute__((ext_vector_type(4)));

__device__ __forceinline__ float bf2f(bf16 v) { return __uint_as_float(((unsigned)v) << 16); }
__device__ __forceinline__ bf16 f2bf(float f) { unsigned u = __float_as_uint(f); return (bf16)((u + 0x7fffu + ((u >> 16) & 1u)) >> 16); }

constexpr size_t MiB = 1u << 20;
constexpr size_t WS_CTL = 0, CTL_ZERO_BYTES = 1 * MiB;
constexpr size_t WS_XF = 796 * MiB, WS_Y = 924 * MiB, WS_XBF = 1052 * MiB, WS_HM = 1116 * MiB, WS_OS = 1592 * MiB, WS_PERM = 1728 * MiB;
constexpr size_t WS_TOK = WS_PERM + 1 * MiB;
constexpr size_t WS_END = WS_TOK + 1 * MiB;
constexpr size_t WS_PU = WS_HM, WS_Q = WS_HM + 32 * MiB, WS_K = WS_HM + 64 * MiB, WS_V = WS_HM + 96 * MiB, WS_PLD = WS_HM + 128 * MiB,
                 WS_O2 = WS_HM + 160 * MiB, WS_CAT = WS_HM + 224 * MiB;
constexpr size_t WS_H = WS_HM;
constexpr size_t WS_BG = WS_HM, WS_Z = WS_HM + 64 * MiB, WS_V1 = WS_HM + 128 * MiB;
constexpr int CW_CNT = 64;

__device__ __forceinline__ float wave_sum(float v) {
#pragma unroll
    for (int o = 1; o < 64; o <<= 1) v += __shfl_xor(v, o);
    return v;
}
__device__ __forceinline__ float lambda_full(const float* q1, const float* k1, const float* q2, const float* k2, int lane) {
    const float a = wave_sum(q1[lane] * k1[lane]), b = wave_sum(q2[lane] * k2[lane]);
    return expf(a) - expf(b) + LAM_INIT0;
}
__device__ __forceinline__ unsigned pk4_fp8_(float a, float b, float c, float d);
__device__ __forceinline__ void ln_row(const float* y, const float* g, const float* b, float* xf, bf16* xb, int lane, f32x4 (&v)[8], unsigned char* x8 = nullptr, float s8 = 1.f, const bf16* yb = nullptr) {
    float s = 0.f;
#pragma unroll
    for (int j = 0; j < 8; ++j) {
        if (yb) { const unsigned long long w = *(const unsigned long long*)(yb + j * 256 + lane * 4); v[j] = (f32x4){__uint_as_float((unsigned)w << 16), __uint_as_float((unsigned)w & 0xffff0000u), __uint_as_float((unsigned)(w >> 32) << 16), __uint_as_float((unsigned)(w >> 32) & 0xffff0000u)}; }
        else v[j] = *(const f32x4*)(y + j * 256 + lane * 4);
        s += (v[j][0] + v[j][1]) + (v[j][2] + v[j][3]); }
    const float mean = wave_sum(s) * (1.f / DM); float s2 = 0.f;
#pragma unroll
    for (int j = 0; j < 8; ++j) { v[j] = v[j] - mean; s2 += (v[j][0] * v[j][0] + v[j][1] * v[j][1]) + (v[j][2] * v[j][2] + v[j][3] * v[j][3]); }
    const float rstd = 1.f / sqrtf(wave_sum(s2) * (1.f / DM) + LN_EPS);
#pragma unroll
    for (int j = 0; j < 8; ++j) { const f32x4 gg = *(const f32x4*)(g + j * 256 + lane * 4), bb = *(const f32x4*)(b + j * 256 + lane * 4);
        v[j] = v[j] * rstd * gg + bb;
        if (xf) *(f32x4*)(xf + j * 256 + lane * 4) = v[j];
        if (x8) *(unsigned*)(x8 + j * 256 + lane * 4) = pk4_fp8_(v[j][0] * s8, v[j][1] * s8, v[j][2] * s8, v[j][3] * s8);
        if (xb) { unsigned long long w = (unsigned long long)f2bf(v[j][0]) | ((unsigned long long)f2bf(v[j][1]) << 16) | ((unsigned long long)f2bf(v[j][2]) << 32) | ((unsigned long long)f2bf(v[j][3]) << 48);
            *(unsigned long long*)(xb + j * 256 + lane * 4) = w; } }
}


namespace pg8 {
#define PG8_LAS __attribute__((address_space(3)))
typedef unsigned short bf16_t;
typedef short bf16x8 __attribute__((ext_vector_type(8)));
typedef float f32x4 __attribute__((ext_vector_type(4)));
typedef unsigned u32x4 __attribute__((ext_vector_type(4)));
typedef int i32x4 __attribute__((ext_vector_type(4)));
typedef unsigned u32x2 __attribute__((ext_vector_type(2)));
constexpr int BM = 256, BK = 64, HALF = 128, HTB = HALF * BK * 2  , STAGE_BYTES = 8 * HTB, NXCD = 8, WGM = 8;

__host__ __device__ __forceinline__ int lds_byte(int r, int c) { const int st = (r >> 4) * 2 + (c >> 5), rr = r & 15, cc = c & 31, ob = rr * 64 + cc * 2; return st * 1024 + (ob ^ (((ob >> 9) & 1) << 5)); }
__host__ __device__ __forceinline__ void stage_rc(int b, int& R, int& C) { const int st = b / 1024, sb = b % 1024, swz = sb ^ (((sb >> 9) & 1) << 5); R = (st >> 1) * 16 + swz / 64; C = (st & 1) * 32 + (swz % 64) / 2; }
__host__ __device__ __forceinline__ int perm32(int rho) { const int n = rho >> 4, i = rho & 15; return 8 * (i >> 2) + 4 * n + (i & 3); }

struct Unit { int pm, pn, bt, acol, bcol, sel, am; };
struct Gemm { const bf16_t* A; const bf16_t* Bt; int lda, ldb, K; int pad; const float* rs; };

struct StaticOrder {
    int nM, nN, nwg, G, c;
    __device__ void init(int nM_, int nN_, int G_, int c_) { nM = nM_; nN = nN_; nwg = nM * nN; G = G_; c = c_; }
    __device__ __forceinline__ bool tile(int i, int& pm, int& pn) const {
        const int L = i * G + c; if (L >= nwg) return false;
        int wgid = L; { const int q = nwg / NXCD, r = nwg % NXCD, xcd = wgid % NXCD, off = wgid / NXCD; wgid = (xcd < r ? xcd * (q + 1) : r * (q + 1) + (xcd - r) * q) + off; }
        const int nig = WGM * nN, gid = wgid / nig, fm = gid * WGM, gsz = (nM - fm) < WGM ? (nM - fm) : WGM;
        pm = fm + ((wgid % nig) % gsz); pn = (wgid % nig) / gsz; return true;
    }
    __device__ __forceinline__ bool next(int i, Unit& u) const { int pm, pn; if (!tile(i, pm, pn)) return false; u.pm = pm; u.am = pm; u.pn = pn; u.bt = pn; u.acol = 0; u.bcol = 0; u.sel = 0; return true; }
    __device__ __forceinline__ void a_ready(const Unit&) const {}
    __device__ __forceinline__ void done(const Unit&) const {}
};
struct PoolOrder : StaticOrder {
    __device__ __forceinline__ bool next(int i, Unit& u) const { int pm, pn; if (!tile(i, pm, pn)) return false; u.pm = pm; u.am = pm; u.pn = pn; u.bt = pn; u.acol = 256 * pn; u.bcol = 0; u.sel = 0; return true; }
};
template <int NBT, int KS, int KLEN> struct MoeOrder : StaticOrder {
    int ts1, ts2, ts3, ts4, ts5, ts6, ts7;
    __device__ __forceinline__ int expert(int pm) const { return (pm >= ts1) + (pm >= ts2) + (pm >= ts3) + (pm >= ts4) + (pm >= ts5) + (pm >= ts6) + (pm >= ts7); }
    __device__ __forceinline__ bool next(int i, Unit& u) const { int pm, pn; if (!tile(i, pm, pn)) return false;
        const int kslice = pn % KS, pc = pn / KS; u.pm = pm; u.am = pm; u.pn = pc; u.bt = expert(pm) * NBT + pc; u.acol = kslice * KLEN; u.bcol = kslice * KLEN; u.sel = kslice; return true; }
};

template <int NBT, int KS, int KLEN> struct MoeTail {
    int ts1, ts2, ts3, ts4, ts5, ts6, ts7, t0, nT, c;
    __device__ __forceinline__ int expert(int pm) const { return (pm >= ts1) + (pm >= ts2) + (pm >= ts3) + (pm >= ts4) + (pm >= ts5) + (pm >= ts6) + (pm >= ts7); }
    __device__ __forceinline__ bool next(int i, Unit& u) const { if (i != 0 || c >= nT * NBT * KS) return false;
        const int pm = __builtin_amdgcn_readfirstlane(t0 + c % nT), pn = __builtin_amdgcn_readfirstlane(c / nT);
        const int kslice = pn % KS, pc = pn / KS; u.pm = pm; u.am = pm; u.pn = pc; u.bt = expert(pm) * NBT + pc; u.acol = kslice * KLEN; u.bcol = kslice * KLEN; u.sel = kslice; return true; }
    __device__ __forceinline__ void a_ready(const Unit&) const {}
    __device__ __forceinline__ void done(const Unit&) const {}
};

template <int NBT> struct MoeOrderX : StaticOrder {
    int ts1, ts2, ts3, ts4, ts5, ts6, ts7;
    __device__ __forceinline__ int expert(int pm) const { return (pm >= ts1) + (pm >= ts2) + (pm >= ts3) + (pm >= ts4) + (pm >= ts5) + (pm >= ts6) + (pm >= ts7); }
    __device__ __forceinline__ bool next(int i, Unit& u) const {
        constexpr int CW = NBT / NXCD; const int x = c % NXCD, j = c / NXCD, per = G / NXCD;
        const int n = i * per + j, r = n / CW, cc = n % CW; if (r >= nM) return false;
        const int e = expert(r); const int tse = e == 0 ? 0 : e == 1 ? ts1 : e == 2 ? ts2 : e == 3 ? ts3 : e == 4 ? ts4 : e == 5 ? ts5 : e == 6 ? ts6 : ts7;
        u.pm = r; u.am = e * (16384 / BM) + (r - tse); u.pn = x * CW + cc; u.bt = e * NBT + u.pn; u.acol = 0; u.bcol = 0; u.sel = 0; return true; }
};
__device__ __forceinline__ unsigned cvt_pk_bf16(float lo, float hi) { unsigned r; asm volatile("v_cvt_pk_bf16_f32 %0, %1, %2" : "=v"(r) : "v"(lo), "v"(hi)); return r; }
__device__ __forceinline__ float fast_silu(float v) { return v * __builtin_amdgcn_rcpf(1.0f + __builtin_amdgcn_exp2f(-1.4426950408889634f * v)); }

#define PG8_PACK8(v0, v1) ({ u32x4 w_; w_.x = cvt_pk_bf16((v0)[0], (v0)[1]); w_.y = cvt_pk_bf16((v0)[2], (v0)[3]); w_.z = cvt_pk_bf16((v1)[0], (v1)[1]); w_.w = cvt_pk_bf16((v1)[2], (v1)[3]); w_; })
struct EpiQkv {
    static constexpr bool PERM = true, AFTER_DRAIN = false;
    bf16_t* O0; size_t stride; float qscale; float inv;
    __device__ __forceinline__ void operator()(const f32x4 (&acc)[2][2][4][2], const Unit& u, int wr, int wc, int fr, int fq, const PG8_LAS float* rsl = nullptr) const {
        const int t = u.pn >> 2; bf16_t* base = O0 + (size_t)t * stride; const float sc0 = (t == 1) ? qscale * inv : inv;
        const int row0 = u.pm * BM + wr * 64 + fr, col0 = (u.pn & 3) * BM + wc * 32 + 8 * fq;
#pragma unroll
        for (int ai = 0; ai < 2; ++ai)
#pragma unroll
            for (int m = 0; m < 4; ++m) { bf16_t* rowp = base + (size_t)(row0 + ai * HALF + m * 16) * 1024 + col0; const float sc = rsl ? rsl[ai * HALF + wr * 64 + m * 16 + fr] * sc0 : sc0;
#pragma unroll
                for (int bj = 0; bj < 2; ++bj) { const f32x4 v0 = acc[ai][bj][m][0] * sc, v1 = acc[ai][bj][m][1] * sc; *(u32x4*)(rowp + bj * HALF) = PG8_PACK8(v0, v1); } }
    }
};
struct EpiPool {
    static constexpr bool PERM = true, AFTER_DRAIN = false;
    bf16_t* O; const float* scale; int ldc; int pad;
    __device__ __forceinline__ void operator()(const f32x4 (&acc)[2][2][4][2], const Unit& u, int wr, int wc, int fr, int fq, const PG8_LAS float* rsl = nullptr) const {
        const int row0 = u.pm * BM + wr * 64 + fr, col0 = u.pn * BM + wc * 32 + 8 * fq;
        f32x4 sv[2][2];
#pragma unroll
        for (int bj = 0; bj < 2; ++bj)
#pragma unroll
            for (int n = 0; n < 2; ++n) sv[bj][n] = *(const f32x4*)(scale + col0 + bj * HALF + 4 * n);
#pragma unroll
        for (int ai = 0; ai < 2; ++ai)
#pragma unroll
            for (int m = 0; m < 4; ++m) { bf16_t* rowp = O + (size_t)(row0 + ai * HALF + m * 16) * ldc + col0;
#pragma unroll
                for (int bj = 0; bj < 2; ++bj) { const f32x4 v0 = acc[ai][bj][m][0] * sv[bj][0], v1 = acc[ai][bj][m][1] * sv[bj][1]; *(u32x4*)(rowp + bj * HALF) = PG8_PACK8(v0, v1); } }
    }
};
template <bool XB16> struct EpiResid {
    static constexpr bool PERM = true, AFTER_DRAIN = false;
    bf16_t* Y; const void* X; int ldc; float alpha; float scale; int pad;
    __device__ __forceinline__ void operator()(const f32x4 (&acc)[2][2][4][2], const Unit& u, int wr, int wc, int fr, int fq, const PG8_LAS float* rsl = nullptr) const {
        const int row0 = u.pm * BM + wr * 64 + fr, col0 = u.pn * BM + wc * 32 + 8 * fq;
#pragma unroll
        for (int ai = 0; ai < 2; ++ai)
#pragma unroll
            for (int m = 0; m < 4; ++m) { const size_t off = (size_t)(row0 + ai * HALF + m * 16) * ldc + col0;
                f32x4 xv[2][2];
#pragma unroll
                for (int bj = 0; bj < 2; ++bj)
#pragma unroll
                    for (int n = 0; n < 2; ++n) {
                        if constexpr (XB16) { const u32x2 w = *(const u32x2*)((const bf16_t*)X + off + bj * HALF + n * 4); xv[bj][n] = (f32x4){__uint_as_float(w.x << 16), __uint_as_float(w.x & 0xffff0000u), __uint_as_float(w.y << 16), __uint_as_float(w.y & 0xffff0000u)}; }
                        else xv[bj][n] = *(const f32x4*)((const float*)X + off + bj * HALF + n * 4); }
                const float sc = rsl ? rsl[ai * HALF + wr * 64 + m * 16 + fr] * scale : scale;
#pragma unroll
                for (int bj = 0; bj < 2; ++bj) { const f32x4 v0 = xv[bj][0] * alpha + acc[ai][bj][m][0] * sc, v1 = xv[bj][1] * alpha + acc[ai][bj][m][1] * sc; *(u32x4*)(Y + off + bj * HALF) = PG8_PACK8(v0, v1); } }
    }
};
struct EpiSwiglu {
    static constexpr bool PERM = true, AFTER_DRAIN = false;
    bf16_t* H; int ldh; float inv;
    __device__ __forceinline__ void operator()(const f32x4 (&acc)[2][2][4][2], const Unit& u, int wr, int wc, int fr, int fq, const PG8_LAS float* rsl = nullptr) const {
        const int row0 = u.pm * BM + wr * 64 + fr, col0 = u.pn * HALF + wc * 32 + 8 * fq;
#pragma unroll
        for (int ai = 0; ai < 2; ++ai)
#pragma unroll
            for (int m = 0; m < 4; ++m) { f32x4 v0, v1; const float ri = rsl ? rsl[ai * HALF + wr * 64 + m * 16 + fr] * inv : inv;
#pragma unroll
                for (int j = 0; j < 4; ++j) { v0[j] = fast_silu(acc[ai][0][m][0][j] * ri) * (acc[ai][1][m][0][j] * ri); v1[j] = fast_silu(acc[ai][0][m][1][j] * ri) * (acc[ai][1][m][1][j] * ri); }
                *(u32x4*)(H + (size_t)(row0 + ai * HALF + m * 16) * ldh + col0) = PG8_PACK8(v0, v1); }
    }
};
struct EpiL1in {
    static constexpr bool PERM = true, AFTER_DRAIN = false;
    bf16_t* Z; bf16_t* BG; float inv; int pad;
    __device__ __forceinline__ void operator()(const f32x4 (&acc)[2][2][4][2], const Unit& u, int wr, int wc, int fr, int fq, const PG8_LAS float* rsl = nullptr) const {
        const int row0 = u.pm * BM + wr * 64 + fr;
        if (u.pn < 16) { const int col0 = u.pn * HALF + wc * 32 + 8 * fq;
#pragma unroll
            for (int ai = 0; ai < 2; ++ai)
#pragma unroll
                for (int m = 0; m < 4; ++m) { const float ri = rsl ? rsl[ai * HALF + wr * 64 + m * 16 + fr] * inv : inv, r2 = ri * ri;
                    const f32x4 v0 = acc[ai][0][m][0] * acc[ai][1][m][0] * r2, v1 = acc[ai][0][m][1] * acc[ai][1][m][1] * r2;
                    *(u32x4*)(Z + (size_t)(row0 + ai * HALF + m * 16) * 2048 + col0) = PG8_PACK8(v0, v1); }
        } else { const int col0 = (u.pn - 16) * BM + wc * 32 + 8 * fq;
#pragma unroll
            for (int ai = 0; ai < 2; ++ai)
#pragma unroll
                for (int m = 0; m < 4; ++m) { bf16_t* rowp = BG + (size_t)(row0 + ai * HALF + m * 16) * 2048 + col0; const float ri = rsl ? rsl[ai * HALF + wr * 64 + m * 16 + fr] * inv : inv;
#pragma unroll
                    for (int bj = 0; bj < 2; ++bj) { const f32x4 v0 = acc[ai][bj][m][0] * ri, v1 = acc[ai][bj][m][1] * ri; *(u32x4*)(rowp + bj * HALF) = PG8_PACK8(v0, v1); } }
        }
    }
};
struct EpiBf16 {
    static constexpr bool PERM = true, AFTER_DRAIN = false;
    bf16_t* O; long sel_stride; int ldc; float scale;
    __device__ __forceinline__ void operator()(const f32x4 (&acc)[2][2][4][2], const Unit& u, int wr, int wc, int fr, int fq, const PG8_LAS float* rsl = nullptr) const {
        const int row0 = u.pm * BM + wr * 64 + fr, col0 = u.pn * BM + wc * 32 + 8 * fq; bf16_t* base = O + (long)u.sel * sel_stride;
#pragma unroll
        for (int ai = 0; ai < 2; ++ai)
#pragma unroll
            for (int m = 0; m < 4; ++m) { bf16_t* rowp = base + (size_t)(row0 + ai * HALF + m * 16) * ldc + col0;
#pragma unroll
                for (int bj = 0; bj < 2; ++bj) { const f32x4 v0 = acc[ai][bj][m][0] * scale, v1 = acc[ai][bj][m][1] * scale; *(u32x4*)(rowp + bj * HALF) = PG8_PACK8(v0, v1); } }
    }
};

__device__ __forceinline__ unsigned pk4_fp8(float a, float b, float c, float d) {
    a = __builtin_amdgcn_fmed3f(a, -448.f, 448.f); b = __builtin_amdgcn_fmed3f(b, -448.f, 448.f); c = __builtin_amdgcn_fmed3f(c, -448.f, 448.f); d = __builtin_amdgcn_fmed3f(d, -448.f, 448.f);
    int w = __builtin_amdgcn_cvt_pk_fp8_f32(a, b, 0, false); w = __builtin_amdgcn_cvt_pk_fp8_f32(c, d, w, true); return (unsigned)w;
}
struct EpiOut8 {
    static constexpr bool PERM = true, AFTER_DRAIN = false;
    unsigned char* O; long sel_stride; int ldc; float scale;
    __device__ __forceinline__ void operator()(const f32x4 (&acc)[2][2][4][2], const Unit& u, int wr, int wc, int fr, int fq, const PG8_LAS float* rsl = nullptr) const {
        const int row0 = u.pm * BM + wr * 64 + fr, col0 = u.pn * BM + wc * 32 + 8 * fq; unsigned char* base = O + (long)u.sel * sel_stride;
#pragma unroll
        for (int ai = 0; ai < 2; ++ai)
#pragma unroll
            for (int m = 0; m < 4; ++m) { unsigned char* rowp = base + (size_t)(row0 + ai * HALF + m * 16) * ldc + col0;
#pragma unroll
                for (int bj = 0; bj < 2; ++bj) { const f32x4 v0 = acc[ai][bj][m][0] * scale, v1 = acc[ai][bj][m][1] * scale;
                    u32x2 w; w.x = pk4_fp8(v0[0], v0[1], v0[2], v0[3]); w.y = pk4_fp8(v1[0], v1[1], v1[2], v1[3]); *(u32x2*)(rowp + bj * HALF) = w; } }
    }
};
__device__ __forceinline__ unsigned pk4_i8(float a, float b, float c, float d) {
    const float MG = 12582912.f;
    const unsigned ua = __float_as_uint(__builtin_amdgcn_fmed3f(a, -127.f, 127.f) + MG), ub = __float_as_uint(__builtin_amdgcn_fmed3f(b, -127.f, 127.f) + MG);
    const unsigned uc = __float_as_uint(__builtin_amdgcn_fmed3f(c, -127.f, 127.f) + MG), ud = __float_as_uint(__builtin_amdgcn_fmed3f(d, -127.f, 127.f) + MG);
    return __builtin_amdgcn_perm(ub, ua, 0x0c0c0400u) | __builtin_amdgcn_perm(ud, uc, 0x04000c0cu);
}
struct EpiSwigluF8 {
    static constexpr bool PERM = true, AFTER_DRAIN = false;
    unsigned char* H; int ldh; float inv, hscale;
    __device__ __forceinline__ void operator()(const f32x4 (&acc)[2][2][4][2], const Unit& u, int wr, int wc, int fr, int fq, const PG8_LAS float* rsl = nullptr) const {
        const int row0 = u.pm * BM + wr * 64 + fr, col0 = u.pn * HALF + wc * 32 + 8 * fq;
#pragma unroll
        for (int ai = 0; ai < 2; ++ai)
#pragma unroll
            for (int m = 0; m < 4; ++m) { const float ri = rsl ? rsl[ai * HALF + wr * 64 + m * 16 + fr] * inv : inv, ce = ri * -1.4426950408889634f, ics = __builtin_amdgcn_rcpf(ri * ri * hscale);
                f32x4 t0 = acc[ai][0][m][0] * ce, t1 = acc[ai][0][m][1] * ce, p0 = acc[ai][0][m][0] * acc[ai][1][m][0], p1 = acc[ai][0][m][1] * acc[ai][1][m][1], v0, v1;
#pragma unroll
                for (int j = 0; j < 4; ++j) { v0[j] = p0[j] * __builtin_amdgcn_rcpf(__builtin_fmaf(__builtin_amdgcn_exp2f(t0[j]), ics, ics)); v1[j] = p1[j] * __builtin_amdgcn_rcpf(__builtin_fmaf(__builtin_amdgcn_exp2f(t1[j]), ics, ics)); }
                u32x2 w; w.x = pk4_fp8(v0[0], v0[1], v0[2], v0[3]); w.y = pk4_fp8(v1[0], v1[1], v1[2], v1[3]);
                *(u32x2*)(H + (size_t)(row0 + ai * HALF + m * 16) * ldh + col0) = w; }
    }
};
__device__ __forceinline__ void glds_s(const void* sbase, unsigned voff, unsigned lds_dst) {
    unsigned keep;
    asm volatile("s_mov_b32 %0, m0\n\ts_mov_b32 m0, %3\n\ts_nop 0\n\tglobal_load_lds_dwordx4 %1, %2\n\ts_mov_b32 m0, %0" : "=&s"(keep) : "v"(voff), "s"(sbase), "s"(lds_dst) : "memory");
}
__device__ __forceinline__ void glds_s4(const void* sbase, unsigned voff, unsigned lds_dst) {
    unsigned keep;
    asm volatile("s_mov_b32 %0, m0\n\ts_mov_b32 m0, %3\n\ts_nop 0\n\tglobal_load_lds_dword %1, %2\n\ts_mov_b32 m0, %0" : "=&s"(keep) : "v"(voff), "s"(sbase), "s"(lds_dst) : "memory");
}
template <class Epi, class Sched, bool ALIGN_EPI = false, bool SP2 = false, int ESZ = 2, bool I8 = false, bool RSC = false, bool OPAQUE_TID = false>
__device__ __forceinline__ void gemm_phase(PG8_LAS unsigned char* lds, const Gemm g, const Sched& S, const Epi& E) {
    int tid_ = threadIdx.x; if constexpr (OPAQUE_TID) asm volatile("" : "+v"(tid_));
    const int tid = tid_, wid = __builtin_amdgcn_readfirstlane(tid >> 6), lane = tid & 63, wr = wid >> 2, wc = wid & 3, fr = lane & 15, fq = lane >> 4;
    const int K = g.K, nt = K * ESZ / (BK * 2);
    unsigned voffA[2], voffB[2];
#pragma unroll
    for (int i = 0; i < 2; ++i) { int R, C; stage_rc(tid * 16 + i * 8192, R, C); const int Rb = Epi::PERM ? ((R & ~31) + perm32(R & 31)) : R;
        voffA[i] = (unsigned)(R * g.lda * ESZ + C * 2); voffB[i] = (unsigned)(Rb * g.ldb * ESZ + C * 2); }
    const size_t kstep = (size_t)(BK * 2);
    const size_t hstepA = (size_t)HALF * g.lda * ESZ, hstepB = (size_t)HALF * g.ldb * ESZ;
    const unsigned ldsbase = (unsigned)(size_t)lds + (unsigned)wid * 1024u;
    const int aoff = lds_byte(wr * 64 + fr, fq * 8), boff = lds_byte(wc * 32 + fr, fq * 8);
#define PG8_SA(b, h) (((b) * 2 + (h)) * HTB)
#define PG8_SB(b, h) ((4 + (b) * 2 + (h)) * HTB)
#define PG8_UA(u) ((const char*)g.A + ((size_t)(u).am * BM * g.lda + (u).acol) * ESZ)
#define PG8_UB(u) ((const char*)g.Bt + ((size_t)(u).bt * BM * g.ldb + (u).bcol) * ESZ)
#define PG8_STAGE(bufoff, gbase, voff) do { _Pragma("unroll") for (int _i = 0; _i < 2; ++_i) glds_s((gbase), (voff)[_i], ldsbase + (unsigned)((bufoff) + _i * 8192)); } while (0)
#define PG8_LDA(dst, b, h) do { _Pragma("unroll") for (int m = 0; m < 4; ++m) _Pragma("unroll") for (int k = 0; k < 2; ++k) dst[m][k] = *(const PG8_LAS bf16x8*)(lds + PG8_SA(b, h) + aoff + m * 2048 + k * 1024); } while (0)
#define PG8_LDB(dst, b, h) do { _Pragma("unroll") for (int n = 0; n < 2; ++n) _Pragma("unroll") for (int k = 0; k < 2; ++k) dst[n][k] = *(const PG8_LAS bf16x8*)(lds + PG8_SB(b, h) + boff + n * 2048 + k * 1024); } while (0)
#define PG8_CAT8(x, y) __builtin_shufflevector(__builtin_bit_cast(i32x4, (x)), __builtin_bit_cast(i32x4, (y)), 0, 1, 2, 3, 4, 5, 6, 7)
#define PG8_MMA(ai, bj, At, Bt) do { __builtin_amdgcn_s_setprio(1); \
        if constexpr (ESZ == 2) { _Pragma("unroll") for (int m = 0; m < 4; ++m) _Pragma("unroll") for (int n = 0; n < 2; ++n) _Pragma("unroll") for (int k = 0; k < 2; ++k) \
            acc[ai][bj][m][n] = __builtin_amdgcn_mfma_f32_16x16x32_bf16(Bt[n][k], At[m][k], acc[ai][bj][m][n], 0, 0, 0); } \
        else if constexpr (I8) { _Pragma("unroll") for (int m = 0; m < 4; ++m) _Pragma("unroll") for (int n = 0; n < 2; ++n) _Pragma("unroll") for (int k = 0; k < 2; ++k) \
            acc[ai][bj][m][n] = __builtin_bit_cast(f32x4, __builtin_amdgcn_mfma_i32_16x16x64_i8(__builtin_bit_cast(i32x4, Bt[n][k]), __builtin_bit_cast(i32x4, At[m][k]), __builtin_bit_cast(i32x4, acc[ai][bj][m][n]), 0, 0, 0)); } \
        else { _Pragma("unroll") for (int m = 0; m < 4; ++m) _Pragma("unroll") for (int n = 0; n < 2; ++n) \
            acc[ai][bj][m][n] = __builtin_amdgcn_mfma_scale_f32_16x16x128_f8f6f4(PG8_CAT8(Bt[n][0], Bt[n][1]), PG8_CAT8(At[m][0], At[m][1]), acc[ai][bj][m][n], 0, 0, 0, 0, 0, 0); } \
        __builtin_amdgcn_s_setprio(0); } while (0)
#define PG8_WAIT_V(n) asm volatile("s_waitcnt vmcnt(" #n ")" ::: "memory")
#define PG8_WAIT_L(n) asm volatile("s_waitcnt lgkmcnt(" #n ")" ::: "memory")
#define PG8_BAR __builtin_amdgcn_s_barrier()
#define PG8_SCHED __builtin_amdgcn_sched_barrier(0)
    Unit cur, nxt; int ui = 0;
    if (!S.next(0, cur)) return;
    f32x4 acc[2][2][4][2];
#pragma unroll
    for (int a = 0; a < 2; ++a)
#pragma unroll
        for (int b = 0; b < 2; ++b)
#pragma unroll
            for (int m = 0; m < 4; ++m)
#pragma unroll
                for (int n = 0; n < 2; ++n) acc[a][b][m][n] = (f32x4){0.f, 0.f, 0.f, 0.f};
    bf16x8 At[4][2], B0[2][2], B1[2][2];
    const char* cA = PG8_UA(cur); const char* cB = PG8_UB(cur);
    S.a_ready(cur);
    if constexpr (SP2) {
        PG8_STAGE(PG8_SB(0, 0), cB, voffB); PG8_STAGE(PG8_SB(0, 1), cB + hstepB, voffB); PG8_STAGE(PG8_SA(0, 0), cA, voffA); PG8_STAGE(PG8_SA(0, 1), cA + hstepA, voffA);
        if (wr == 1) PG8_BAR;
        PG8_WAIT_V(2); PG8_BAR;
        PG8_STAGE(PG8_SB(1, 0), cB + kstep, voffB); PG8_STAGE(PG8_SA(1, 0), cA + kstep, voffA); PG8_STAGE(PG8_SB(1, 1), cB + hstepB + kstep, voffB);
        PG8_WAIT_V(6); PG8_BAR;
    } else {
        PG8_STAGE(PG8_SB(0, 0), cB, voffB); PG8_STAGE(PG8_SA(0, 0), cA, voffA); PG8_STAGE(PG8_SB(0, 1), cB + hstepB, voffB); PG8_STAGE(PG8_SA(0, 1), cA + hstepA, voffA);
        if (wr == 1) PG8_BAR;
        PG8_WAIT_V(4); PG8_BAR;
        PG8_STAGE(PG8_SB(1, 0), cB + kstep, voffB); PG8_STAGE(PG8_SA(1, 0), cA + kstep, voffA); PG8_STAGE(PG8_SB(1, 1), cB + hstepB + kstep, voffB);
        PG8_WAIT_V(6); PG8_BAR;
    }
    const unsigned rs_lds = (unsigned)(size_t)lds + (unsigned)STAGE_BYTES + 1024u;
    for (;;) {
        if constexpr (RSC) { if (wid < 4) glds_s4(g.rs + (size_t)cur.am * BM, (unsigned)(wid * 256 + lane * 4), rs_lds + (unsigned)((ui & 1) * 1024 + wid * 256)); }
        const bool has_next = S.next(ui + 1, nxt);
        const char* nA = has_next ? PG8_UA(nxt) : cA; const char* nB = has_next ? PG8_UB(nxt) : cB;
        for (int t = 0; t < nt; t += 2) {
            const bool last = (t == nt - 2);
            const char* a1 = cA + (size_t)(t + 1) * kstep;
            const char* a2 = last ? nA : cA + (size_t)(t + 2) * kstep; const char* b2 = last ? nB : cB + (size_t)(t + 2) * kstep;
            const char* a3 = a2 + kstep; const char* b3 = b2 + kstep;
            if (last && has_next) S.a_ready(nxt);
            if constexpr (SP2) {
            PG8_LDB(B0, 0, 0); PG8_LDB(B1, 0, 1); PG8_SCHED; PG8_LDA(At, 0, 0); PG8_STAGE(PG8_SA(1, 1), a1 + hstepA, voffA);
            PG8_WAIT_V(8); PG8_WAIT_L(0); PG8_BAR; PG8_MMA(0, 0, At, B0); PG8_MMA(0, 1, At, B1); PG8_BAR; PG8_SCHED;
            PG8_LDA(At, 0, 1); PG8_STAGE(PG8_SB(0, 0), b2, voffB); PG8_STAGE(PG8_SB(0, 1), b2 + hstepB, voffB); PG8_STAGE(PG8_SA(0, 0), a2, voffA);
            PG8_WAIT_V(8); PG8_WAIT_L(0); PG8_BAR; PG8_MMA(1, 0, At, B0); PG8_MMA(1, 1, At, B1); PG8_BAR; PG8_SCHED;
            PG8_LDB(B0, 1, 0); PG8_LDB(B1, 1, 1); PG8_SCHED; PG8_LDA(At, 1, 0); PG8_STAGE(PG8_SA(0, 1), a2 + hstepA, voffA);
            PG8_WAIT_V(8); PG8_WAIT_L(0); PG8_BAR; PG8_MMA(0, 0, At, B0); PG8_MMA(0, 1, At, B1); PG8_BAR; PG8_SCHED;
            PG8_LDA(At, 1, 1); PG8_STAGE(PG8_SB(1, 0), b3, voffB); PG8_STAGE(PG8_SB(1, 1), b3 + hstepB, voffB); PG8_STAGE(PG8_SA(1, 0), a3, voffA);
            PG8_WAIT_V(8); PG8_WAIT_L(0); PG8_BAR; PG8_MMA(1, 0, At, B0); PG8_MMA(1, 1, At, B1); PG8_BAR; PG8_SCHED;
            } else {
            PG8_LDB(B0, 0, 0); PG8_SCHED; PG8_LDA(At, 0, 0); PG8_STAGE(PG8_SA(1, 1), a1 + hstepA, voffA);
            PG8_WAIT_L(8); PG8_BAR; PG8_WAIT_L(0); PG8_MMA(0, 0, At, B0); PG8_BAR; PG8_SCHED;
            PG8_LDB(B1, 0, 1); PG8_STAGE(PG8_SB(0, 0), b2, voffB);
            PG8_BAR; PG8_WAIT_L(0); PG8_MMA(0, 1, At, B1); PG8_BAR;
            PG8_LDA(At, 0, 1); PG8_STAGE(PG8_SA(0, 0), a2, voffA);
            PG8_BAR; PG8_WAIT_L(0); PG8_MMA(1, 0, At, B0); PG8_BAR; PG8_SCHED;
            PG8_STAGE(PG8_SB(0, 1), b2 + hstepB, voffB);
            PG8_WAIT_V(6); PG8_BAR; PG8_MMA(1, 1, At, B1); PG8_BAR;
            PG8_LDB(B0, 1, 0); PG8_SCHED; PG8_LDA(At, 1, 0); PG8_STAGE(PG8_SA(0, 1), a2 + hstepA, voffA);
            PG8_WAIT_L(8); PG8_BAR; PG8_WAIT_L(0); PG8_MMA(0, 0, At, B0); PG8_BAR; PG8_SCHED;
            PG8_LDB(B1, 1, 1); PG8_STAGE(PG8_SB(1, 0), b3, voffB);
            PG8_BAR; PG8_WAIT_L(0); PG8_MMA(0, 1, At, B1); PG8_BAR;
            PG8_LDA(At, 1, 1); PG8_STAGE(PG8_SA(1, 0), a3, voffA);
            PG8_BAR; PG8_WAIT_L(0); PG8_MMA(1, 0, At, B0); PG8_BAR; PG8_SCHED;
            PG8_STAGE(PG8_SB(1, 1), b3 + hstepB, voffB);
            PG8_WAIT_V(6); PG8_BAR; PG8_MMA(1, 1, At, B1); PG8_BAR;
            }
        }
        if constexpr (ALIGN_EPI) { if (wr == 0) PG8_BAR; }
        if constexpr (I8) {
#pragma unroll
            for (int a = 0; a < 2; ++a)
#pragma unroll
                for (int b = 0; b < 2; ++b)
#pragma unroll
                    for (int m = 0; m < 4; ++m)
#pragma unroll
                        for (int n = 0; n < 2; ++n) acc[a][b][m][n] = __builtin_convertvector(__builtin_bit_cast(i32x4, acc[a][b][m][n]), f32x4); }
        if constexpr (!Epi::AFTER_DRAIN) { E(acc, cur, wr, wc, fr, fq, RSC ? (const PG8_LAS float*)(lds + STAGE_BYTES + 1024 + (ui & 1) * 1024) : (const PG8_LAS float*)nullptr); S.done(cur); }
        if (!has_next) break;
#pragma unroll
        for (int a = 0; a < 2; ++a)
#pragma unroll
            for (int b = 0; b < 2; ++b)
#pragma unroll
                for (int m = 0; m < 4; ++m)
#pragma unroll
                    for (int n = 0; n < 2; ++n) acc[a][b][m][n] = (f32x4){0.f, 0.f, 0.f, 0.f};
        cur = nxt; cA = nA; cB = nB; ++ui;
        if constexpr (ALIGN_EPI) { if (wr == 1) PG8_BAR; }
    }
    PG8_WAIT_V(0);
    if constexpr (!ALIGN_EPI) { if (wr == 0) PG8_BAR; }
    PG8_BAR;
    if constexpr (Epi::AFTER_DRAIN) { E.fused(acc, cur, wr, wc, fr, fq, lds, wid, lane); S.done(cur); }
#undef PG8_SA
#undef PG8_SB
#undef PG8_UA
#undef PG8_UB
#undef PG8_STAGE
#undef PG8_LDA
#undef PG8_LDB
#undef PG8_MMA
#undef PG8_CAT8
#undef PG8_WAIT_V
#undef PG8_WAIT_L
#undef PG8_BAR
#undef PG8_SCHED
}
}

#include <hip/hip_bf16.h>
#include <cmath>
namespace attn_body {
using bf16=__hip_bfloat16;
using bf16x8=__attribute__((ext_vector_type(8)))short;
using s16x4=__attribute__((ext_vector_type(4)))short;
using f32x16=__attribute__((ext_vector_type(16)))float;
using u32x4=__attribute__((ext_vector_type(4)))unsigned;
constexpr int BATCH=4,SEQ=4096,D=64,DM=1024;
constexpr int NW=8,QBLK=32,QB=QBLK*NW,KVBLK=64,NQB=SEQ/QB;
constexpr int ATTN_PITCH=DM, ATTN_UNIT_ROWS=QB;
static_assert(NQB==16,"attention order assumes 16 query blocks");
__device__ __forceinline__ int crow(int r,int hi){return (r&3)+8*(r>>2)+4*hi;}
#define SBAR() __builtin_amdgcn_sched_barrier(0)
__device__ __forceinline__ void cmask(f32x16&p0,f32x16&p1,int jb,int qrel,int hi){
  const float NEG=-INFINITY; int kb=64*jb+4*hi;
  #pragma unroll
  for(int r=0;r<16;++r){int kv=kb+(r&3)+8*(r>>2); if(kv>qrel)p0[r]=NEG; if(kv+32>qrel)p1[r]=NEG;}
}

constexpr int NSLOT=3, SLOTB=8192;
constexpr int LDS_K=0, LDS_V=NSLOT*SLOTB, LDS_WS=2*NSLOT*SLOTB, LDS_OST=LDS_WS+NW*64*4, LDS_BYTES=LDS_OST+NW*4096;
constexpr float C2=0.125f*1.4426950408889634f;
__device__ __forceinline__ void glds16(const void*gsrc,unsigned lds_dst){unsigned keep;
  asm volatile("s_mov_b32 %0, m0\n\ts_mov_b32 m0, %2\n\ts_nop 0\n\tglobal_load_lds_dwordx4 %1, off\n\ts_mov_b32 m0, %0":"=&s"(keep):"v"(gsrc),"s"(lds_dst):"memory");}
__device__ __forceinline__ float max3f(float a,float b,float c){float r;asm("v_max3_f32 %0, %1, %2, %3":"=v"(r):"v"(a),"v"(b),"v"(c));return r;}
__device__ __forceinline__ float max2f(float a,float b){float r;asm("v_max_f32_e32 %0, %1, %2":"=v"(r):"v"(a),"v"(b));return r;}
__device__ __forceinline__ float fadd_s(float a,float b){float r;asm("v_add_f32_e32 %0, %1, %2":"=v"(r):"v"(a),"v"(b));return r;}
__device__ __forceinline__ float fsub_s(float a,float b){float r;asm("v_sub_f32_e32 %0, %1, %2":"=v"(r):"v"(a),"v"(b));return r;}
typedef float f32x2_t __attribute__((ext_vector_type(2))); typedef __bf16 bf16x2_t __attribute__((ext_vector_type(2)));
__device__ __forceinline__ unsigned cvtpk_s(float lo,float hi){f32x2_t v={lo,hi};bf16x2_t b=__builtin_convertvector(v,bf16x2_t);return __builtin_bit_cast(unsigned,b);}
#define WAIT_BAR(N) asm volatile("s_waitcnt vmcnt(" #N ") lgkmcnt(0)\n\ts_barrier":::"memory")

__device__ __forceinline__ void qkt(f32x16&p0,f32x16&p1,const char*Kslot,const bf16x8*qr,const f32x16&negm,int r32,int hi){
  const char*kb=Kslot+hi*1024+r32*16;
  #pragma unroll
  for(int d0=0;d0<4;++d0){
    const bf16x8 b0=*reinterpret_cast<const bf16x8*>(kb+d0*2048);
    const bf16x8 b1=*reinterpret_cast<const bf16x8*>(kb+d0*2048+512);
    if(d0==0){p0=__builtin_amdgcn_mfma_f32_32x32x16_bf16(b0,qr[0],negm,0,0,0);p1=__builtin_amdgcn_mfma_f32_32x32x16_bf16(b1,qr[0],negm,0,0,0);}
    else{p0=__builtin_amdgcn_mfma_f32_32x32x16_bf16(b0,qr[d0],p0,0,0,0);p1=__builtin_amdgcn_mfma_f32_32x32x16_bf16(b1,qr[d0],p1,0,0,0);}}
}
typedef __attribute__((address_space(3))) const char* lds_cptr;
typedef short v4i16_t __attribute__((ext_vector_type(4)));
__device__ __forceinline__ void kload8(bf16x8*kf,lds_cptr kp){
  kf[0]=*(const __attribute__((address_space(3))) bf16x8*)(kp);      kf[1]=*(const __attribute__((address_space(3))) bf16x8*)(kp+512);
  kf[2]=*(const __attribute__((address_space(3))) bf16x8*)(kp+2048); kf[3]=*(const __attribute__((address_space(3))) bf16x8*)(kp+2560);
  kf[4]=*(const __attribute__((address_space(3))) bf16x8*)(kp+4096); kf[5]=*(const __attribute__((address_space(3))) bf16x8*)(kp+4608);
  kf[6]=*(const __attribute__((address_space(3))) bf16x8*)(kp+6144); kf[7]=*(const __attribute__((address_space(3))) bf16x8*)(kp+6656);
}
__device__ __forceinline__ void kload2(bf16x8*kf,lds_cptr kp,int j){ kf[2*j]=*(const __attribute__((address_space(3))) bf16x8*)(kp+j*2048); kf[2*j+1]=*(const __attribute__((address_space(3))) bf16x8*)(kp+j*2048+512); }
__device__ __forceinline__ s16x4 vtr(lds_cptr p){ return __builtin_bit_cast(s16x4,__builtin_amdgcn_ds_read_tr16_b64_v4i16((__attribute__((address_space(3))) v4i16_t*)p)); }
__device__ __forceinline__ float rowmax(const f32x16&p0,const f32x16&p1){
  float a=max3f(p0[0],p0[1],p1[0]),b=max3f(p0[2],p0[3],p1[1]);a=max3f(a,p1[2],p1[3]);
  #pragma unroll
  for(int r=4;r<16;r+=4){a=max3f(a,p0[r],p0[r+1]);b=max3f(b,p0[r+2],p0[r+3]);a=max3f(a,p1[r],p1[r+1]);b=max3f(b,p1[r+2],p1[r+3]);}
  const float m=max2f(a,b);
  auto rr=__builtin_amdgcn_permlane32_swap(__float_as_uint(m),__float_as_uint(m),false,false);
  return max2f(__uint_as_float(rr[0]),__uint_as_float(rr[1]));
}
__device__ __forceinline__ void pv(f32x16*o,int vb,bf16x8 pa0,bf16x8 pa1,bf16x8 pa2,bf16x8 pa3){
  #pragma unroll
  for(int d0=0;d0<2;++d0){s16x4 lo[4],hi[4];
    #pragma unroll
    for(int ks=0;ks<4;++ks){
      asm volatile("ds_read_b64_tr_b16 %0,%1 offset:%c2":"=&v"(lo[ks]):"v"(vb),"i"(d0*4096+ks*1024):"memory");
      asm volatile("ds_read_b64_tr_b16 %0,%1 offset:%c2":"=&v"(hi[ks]):"v"(vb),"i"(d0*4096+ks*1024+512):"memory");}
    asm volatile("s_waitcnt lgkmcnt(0)":::"memory");SBAR();
    #define PK(k) (bf16x8){lo[k][0],lo[k][1],lo[k][2],lo[k][3],hi[k][0],hi[k][1],hi[k][2],hi[k][3]}
    o[d0]=__builtin_amdgcn_mfma_f32_32x32x16_bf16(pa0,PK(0),o[d0],0,0,0);
    o[d0]=__builtin_amdgcn_mfma_f32_32x32x16_bf16(pa1,PK(1),o[d0],0,0,0);
    o[d0]=__builtin_amdgcn_mfma_f32_32x32x16_bf16(pa2,PK(2),o[d0],0,0,0);
    o[d0]=__builtin_amdgcn_mfma_f32_32x32x16_bf16(pa3,PK(3),o[d0],0,0,0);
    #undef PK
  }
}

#ifndef ATTN_STORE16
#define ATTN_STORE16(p,v) (*(u32x4*)(p)=(v))
#endif
template<int THRL> __device__ __forceinline__ void attn_unit(int b,int qkcol,int vcol,int qb,const bf16*Q,const bf16*__restrict__ K,const bf16*__restrict__ V,bf16*O,char*shm){
  const int tid=threadIdx.x,lane=tid&63,r32=lane&31,hi=lane>>5; const int wid=__builtin_amdgcn_readfirstlane(tid>>6);
  const long rowbase=(long)b*SEQ; const int q0=qb*QB;
  const bf16*Qw=Q+(rowbase+q0+wid*QBLK)*DM+qkcol;
  const bf16*Kh=K+rowbase*DM+qkcol,*Vh=V+rowbase*DM+vcol;
  const unsigned lds0=(unsigned)(uintptr_t)shm;
  float*wsf=(float*)(shm+LDS_WS)+wid*64;
  const bf16*ksrc=Kh+(long)lane*DM+wid*8;
  const bf16*vsrc=Vh+(long)(16*(wid&3)+(lane>>2))*DM+(wid>>2)*32+(lane&3)*8;
  const unsigned kdst=lds0+LDS_K+wid*1024, vdst=lds0+LDS_V+wid*1024;
  #define DMA_K(t,slot) glds16(ksrc+(long)(t)*KVBLK*DM,(unsigned)__builtin_amdgcn_readfirstlane(kdst+(slot)))
  #define DMA_V(t,slot) glds16(vsrc+(long)(t)*KVBLK*DM,(unsigned)__builtin_amdgcn_readfirstlane(vdst+(slot)))
  const int vb0=(int)(lds0+LDS_V)+((lane>>4)&1)*32+(lane&3)*8+(4*hi+((lane&15)>>2))*64;
  const char*Kbase=shm+LDS_K; bf16x8 kf[8];
  const lds_cptr shm3=(lds_cptr)shm; const lds_cptr kp0=shm3+LDS_K+hi*1024+r32*16; const lds_cptr vp0=shm3+LDS_V+((lane>>4)&1)*32+(lane&3)*8+(4*hi+((lane&15)>>2))*64;
  const int NT=(q0+QB)/KVBLK;
  DMA_K(0,0);DMA_V(0,0);DMA_K(1,SLOTB);
  bf16x8 qr[4];
  #pragma unroll
  for(int d0=0;d0<4;++d0)qr[d0]=*reinterpret_cast<const bf16x8*>(&Qw[(long)r32*DM+d0*16+hi*8]);
  float mhat=0.f,l_reg=0.f;f32x16 o[2];o[0]=f32x16{};o[1]=f32x16{};f32x16 negm=f32x16{};asm volatile("":"+v"(negm));
  const int qrel=wid*QBLK+r32;
  #define CMASK(P0,P1,t) do{int jb_=(t)-(NT-4); if(jb_>=0)cmask(P0,P1,jb_,qrel,hi);}while(0)
  bool resc=false;
  #define START(P0,P1) do{ const float rm=rowmax(P0,P1); resc=false; \
    { const float dl=rm; mhat=fadd_s(mhat,dl); \
      _Pragma("unroll") for(int r=0;r<16;++r){P0[r]=fsub_s(P0[r],dl);P1[r]=fsub_s(P1[r],dl);} \
      _Pragma("unroll") for(int r=0;r<16;++r)negm[r]=-mhat; asm volatile("":"+v"(negm)); } \
    _Pragma("unroll") for(int r=0;r<16;++r)P0[r]=__builtin_amdgcn_exp2f(P0[r]); }while(0)
  #define RESC() do{ if(resc){ asm volatile("s_waitcnt lgkmcnt(0)":::"memory"); \
      _Pragma("unroll") for(int d_=0;d_<2;++d_) _Pragma("unroll") for(int r=0;r<16;++r)o[d_][r]*=wsf[crow(r,hi)]; } }while(0)
  f32x16 pA0,pA1,pB0,pB1;
  int sl_prev=0,sl_cur=0,sl_next=SLOTB;
  #define ROT() do{sl_prev=sl_cur;sl_cur=sl_next;sl_next=(sl_next==(NSLOT-1)*SLOTB)?0:sl_next+SLOTB;}while(0)
  DMA_K(2,2*SLOTB);
  WAIT_BAR(3);
  qkt(pA0,pA1,Kbase,qr,negm,r32,hi);asm volatile("s_nop 15\n\ts_nop 7":"+v"(pA0),"+v"(pA1));CMASK(pA0,pA1,0);
  START(pA0,pA1);
  _Pragma("unroll") for(int r=0;r<16;++r)pA1[r]=__builtin_amdgcn_exp2f(pA1[r]);
  WAIT_BAR(0);
  DMA_K(3,0);DMA_V(1,SLOTB);
  ROT();
  kload8(kf,kp0+sl_cur);
  WAIT_BAR(2);
  s16x4 vlo[8],vhi[8]; u32x4 pw0,pw1,pw2,pw3;
  #define PKW(P,B) cvtpk_s(P[B],P[B+1])
  #define PAF(k) __builtin_bit_cast(bf16x8,pw##k)
  #define VFR(i) (bf16x8){vlo[i][0],vlo[i][1],vlo[i][2],vlo[i][3],vhi[i][0],vhi[i][1],vhi[i][2],vhi[i][3]}
  #define PIN(x) asm volatile("":"+v"(x))
  #define MX3(a,b,c) __builtin_fmaxf(__builtin_fmaxf((a),(b)),(c))
  #define GAPA(MF,A0,A1,A2,A3,W0,W1,PW) do{ MF; sacc+=A0; sacc+=A1; sacc+=A2; sacc+=A3; PIN(sacc); W0; W1; PIN(PW); SBAR(); }while(0)
  #define EX(v) __builtin_amdgcn_exp2f(v)
  #define GAPB(MF,X,B) do{ MF; X[B]=EX(X[B]); X[B+1]=EX(X[B+1]); X[B+2]=EX(X[B+2]); X[B+3]=EX(X[B+3]); PIN(X); SBAR(); }while(0)
  #define VRD(i) do{ vlo[i]=vtr(vp_+(((i)>>2)*4096+((i)&3)*1024)); vhi[i]=vtr(vp_+(((i)>>2)*4096+((i)&3)*1024+512)); }while(0)
  #define KRD(G,j) do{ if(G){ kload2(kf,kp0+sl_next,j); SBAR(); } }while(0)
  #define STEP(C0,C1,P0,P1,t,GK,GV,GL) do{ SBAR(); \
    const lds_cptr vp_=vp0+sl_prev; \
    VRD(0); SBAR(); float sacc=(P0[0]+P0[1]); \
    GAPA(C0=__builtin_amdgcn_mfma_f32_32x32x16_bf16(kf[0],qr[0],negm,0,0,0), P0[2],P0[3],P0[4],P0[5],     pw0[0]=PKW(P0,0), pw0[1]=PKW(P0,2), pw0); \
    VRD(4); SBAR(); GAPA(C1=__builtin_amdgcn_mfma_f32_32x32x16_bf16(kf[1],qr[0],negm,0,0,0), P0[6],P0[7],P0[8],P0[9],     pw0[2]=PKW(P0,4), pw0[3]=PKW(P0,6), pw0); \
    VRD(1); SBAR(); GAPA(C0=__builtin_amdgcn_mfma_f32_32x32x16_bf16(kf[2],qr[1],C0,0,0,0),   P0[10],P0[11],P0[12],P0[13], pw1[0]=PKW(P0,8), pw1[1]=PKW(P0,10), pw1); \
    VRD(5); SBAR(); GAPA(C1=__builtin_amdgcn_mfma_f32_32x32x16_bf16(kf[3],qr[1],C1,0,0,0),   P0[14],P0[15],P1[0],P1[1],   pw1[2]=PKW(P0,12),pw1[3]=PKW(P0,14), pw1); \
    VRD(2); SBAR(); GAPA(C0=__builtin_amdgcn_mfma_f32_32x32x16_bf16(kf[4],qr[2],C0,0,0,0),   P1[2],P1[3],P1[4],P1[5],     pw2[0]=PKW(P1,0), pw2[1]=PKW(P1,2), pw2); \
    VRD(6); SBAR(); GAPA(C1=__builtin_amdgcn_mfma_f32_32x32x16_bf16(kf[5],qr[2],C1,0,0,0),   P1[6],P1[7],P1[8],P1[9],     pw2[2]=PKW(P1,4), pw2[3]=PKW(P1,6), pw2); \
    VRD(3); SBAR(); GAPA(C0=__builtin_amdgcn_mfma_f32_32x32x16_bf16(kf[6],qr[3],C0,0,0,0),   P1[10],P1[11],P1[12],P1[13], pw3[0]=PKW(P1,8), pw3[1]=PKW(P1,10), pw3); \
    VRD(7); SBAR(); GAPA(C1=__builtin_amdgcn_mfma_f32_32x32x16_bf16(kf[7],qr[3],C1,0,0,0),   P1[14],P1[15],0.f,0.f,       pw3[2]=PKW(P1,12),pw3[3]=PKW(P1,14), pw3); \
    l_reg+=sacc; \
    if(GK){DMA_K((t)+3,sl_cur);} if(GV){DMA_V((t)+1,sl_next);} \
    CMASK(C0,C1,t); \
    { float a=MX3(C0[0],C0[1],C1[0]),b=MX3(C0[2],C0[3],C1[1]); a=MX3(a,C1[2],C1[3]); \
      _Pragma("unroll") for(int r=4;r<16;r+=4){a=MX3(a,C0[r],C0[r+1]);b=MX3(b,C0[r+2],C0[r+3]);a=MX3(a,C1[r],C1[r+1]);b=MX3(b,C1[r+2],C1[r+3]);} \
      float rm=__builtin_fmaxf(a,b); { auto rr=__builtin_amdgcn_permlane32_swap(__float_as_uint(rm),__float_as_uint(rm),false,false); rm=__builtin_fmaxf(__uint_as_float(rr[0]),__uint_as_float(rr[1])); } \
      resc=false; \
      if(__builtin_expect(__any(rm>(float)THRL),0)){ const float dl=__builtin_fmaxf(rm,0.f); mhat+=dl; \
        _Pragma("unroll") for(int r=0;r<16;++r){C0[r]-=dl;C1[r]-=dl;} \
        _Pragma("unroll") for(int r=0;r<16;++r)negm[r]=-mhat; asm volatile("":"+v"(negm)); \
        const float f=__builtin_amdgcn_exp2f(-dl); l_reg*=f; if(hi==0)wsf[r32]=f; resc=true; } } \
    SBAR(); \
    GAPB(o[0]=__builtin_amdgcn_mfma_f32_32x32x16_bf16(PAF(0),VFR(0),o[0],0,0,0), C0,0); \
    GAPB(o[1]=__builtin_amdgcn_mfma_f32_32x32x16_bf16(PAF(0),VFR(4),o[1],0,0,0), C0,4); \
    KRD(GL,0); GAPB(o[0]=__builtin_amdgcn_mfma_f32_32x32x16_bf16(PAF(1),VFR(1),o[0],0,0,0), C0,8); \
    KRD(GL,1); GAPB(o[1]=__builtin_amdgcn_mfma_f32_32x32x16_bf16(PAF(1),VFR(5),o[1],0,0,0), C0,12); \
    KRD(GL,2); GAPB(o[0]=__builtin_amdgcn_mfma_f32_32x32x16_bf16(PAF(2),VFR(2),o[0],0,0,0), C1,0); \
    KRD(GL,3); GAPB(o[1]=__builtin_amdgcn_mfma_f32_32x32x16_bf16(PAF(2),VFR(6),o[1],0,0,0), C1,4); \
    GAPB(o[0]=__builtin_amdgcn_mfma_f32_32x32x16_bf16(PAF(3),VFR(3),o[0],0,0,0), C1,8); \
    GAPB(o[1]=__builtin_amdgcn_mfma_f32_32x32x16_bf16(PAF(3),VFR(7),o[1],0,0,0), C1,12); \
    }while(0)
  int t=1;
  #undef CMASK
  #define CMASK(P0,P1,t) do{}while(0)
  for(;t+5<NT;t+=2){
    STEP(pB0,pB1,pA0,pA1,t,true,true,true);     WAIT_BAR(2); RESC(); ROT();
    STEP(pA0,pA1,pB0,pB1,t+1,true,true,true);   WAIT_BAR(2); RESC(); ROT();
  }
  #undef CMASK
  #define CMASK(P0,P1,t) do{int jb_=(t)-(NT-4); if(jb_>=0)cmask(P0,P1,jb_,qrel,hi);}while(0)
  #define ENDW(tt) do{ if((tt)+3<NT){WAIT_BAR(2);} else if((tt)+2<NT){WAIT_BAR(1);} else {WAIT_BAR(0);} }while(0)
  for(;t+1<NT;t+=2){
    STEP(pB0,pB1,pA0,pA1,t,(t+3<NT),(t+1<NT),(t+1<NT));       ENDW(t);   RESC(); ROT();
    STEP(pA0,pA1,pB0,pB1,t+1,(t+4<NT),(t+2<NT),(t+2<NT));     ENDW(t+1); RESC(); ROT();
  }
  STEP(pB0,pB1,pA0,pA1,NT-1,false,false,false); RESC();
  { float sacc=pB0[0]+pB0[1]; _Pragma("unroll") for(int r=2;r<16;++r)sacc+=pB0[r]; _Pragma("unroll") for(int r=0;r<16;++r)sacc+=pB1[r]; l_reg+=sacc;
    pw0=(u32x4){PKW(pB0,0),PKW(pB0,2),PKW(pB0,4),PKW(pB0,6)};pw1=(u32x4){PKW(pB0,8),PKW(pB0,10),PKW(pB0,12),PKW(pB0,14)};pw2=(u32x4){PKW(pB1,0),PKW(pB1,2),PKW(pB1,4),PKW(pB1,6)};pw3=(u32x4){PKW(pB1,8),PKW(pB1,10),PKW(pB1,12),PKW(pB1,14)};
    SBAR(); pv(o,vb0+sl_cur,PAF(0),PAF(1),PAF(2),PAF(3)); }
  #undef PKW
  #undef PAF
  #undef VFR
  #undef PIN
  #undef MX3
  #undef GAPA
  #undef GAPB
  #undef EX
  #undef VRD
  #undef KRD
  #undef STEP
  #undef ENDW
  {auto rr=__builtin_amdgcn_permlane32_swap(__float_as_uint(l_reg),__float_as_uint(l_reg),false,false);l_reg=__uint_as_float(rr[0])+__uint_as_float(rr[1]);}
  if(hi==0)wsf[32+r32]=l_reg;asm volatile("s_waitcnt lgkmcnt(0)":::"memory");
  float rli[16];
  #pragma unroll
  for(int r=0;r<16;++r)rli[r]=__builtin_amdgcn_rcpf(wsf[32+crow(r,hi)]);
  bf16*Ow=O+(rowbase+q0+wid*QBLK)*DM+vcol;
  { bf16*stg=(bf16*)(shm+LDS_OST)+wid*2048;
    #pragma unroll
    for(int r=0;r<16;++r){const int orow=crow(r,hi);
      #pragma unroll
      for(int d0=0;d0<2;++d0)stg[orow*64+d0*32+r32]=__float2bfloat16(o[d0][r]*rli[r]);}
    asm volatile("s_waitcnt lgkmcnt(0)":::"memory");
    #pragma unroll
    for(int i=0;i<4;++i){const int row=i*8+(lane>>3),ch=lane&7; const u32x4 v=*(const u32x4*)(stg+row*64+ch*8); ATTN_STORE16(Ow+(long)row*DM+ch*8,v);} }
  asm volatile("s_waitcnt lgkmcnt(0)\n\ts_barrier":::"memory");
  #undef DMA_K
  #undef DMA_V
  #undef CMASK
  #undef START
  #undef RESC
  #undef ROT
}
constexpr int ATTN_LDS_BYTES=LDS_BYTES;
struct AttnTensors { const bf16* Q; const bf16* K; const bf16* V; bf16* O2; };
struct AttnUnit { int b, qkcol, vcol, comp, qb; };
struct StaticOrder {
  int vcu, G;
  __device__ __forceinline__ explicit StaticOrder(int grid,int block):vcu((grid%8==0)?(block%8)*(grid/8)+block/8:block),G(grid){}
  __device__ __forceinline__ bool next(int i,AttnUnit&u)const{
    const int L=(i>>3)*G+vcu; const int j=i&7;
    if(L>=256)return false;
    const int combo=L>>1, s=4*(L&1)+(j>>1); const int b=combo>>5, ph=combo&31, h=ph>>2, c=(ph>>1)&1, vh=ph&1;
    u.b=b; u.qkcol=(h*2+c)*64; u.vcol=h*128+vh*64; u.comp=c; u.qb=(j&1)?15-s:s; return true; }
  __device__ __forceinline__ void a_ready(const AttnUnit&)const{}
  __device__ __forceinline__ void done(const AttnUnit&)const{}
};
template<class Sched,int THRL=8> __device__ __forceinline__ void attn_phase(char*lds,const AttnTensors&T,const Sched&S){
  AttnUnit u;
  for(int i=0;S.next(i,u);++i){ S.a_ready(u); attn_unit<THRL>(u.b,u.qkcol,u.vcol,u.qb,T.Q,T.K,T.V,T.O2+(size_t)u.comp*((size_t)BATCH*SEQ*DM),lds); S.done(u); }
}
namespace v128 {
constexpr int SLOTK=8192, SLOTV=16384;
constexpr int XK=0, XV=NSLOT*SLOTK, XWS=XV+NSLOT*SLOTV, XQO=XWS+NW*64*4, XBYTES=XQO+NW*4096;
}
__device__ __forceinline__ void pv128(f32x16*o,int vb,bf16x8 pa0,bf16x8 pa1,bf16x8 pa2,bf16x8 pa3){
  #pragma unroll
  for(int d0=0;d0<4;++d0){s16x4 lo[4],hi[4];
    #pragma unroll
    for(int ks=0;ks<4;++ks){
      asm volatile("ds_read_b64_tr_b16 %0,%1 offset:%c2":"=&v"(lo[ks]):"v"(vb),"i"(d0*4096+ks*1024):"memory");
      asm volatile("ds_read_b64_tr_b16 %0,%1 offset:%c2":"=&v"(hi[ks]):"v"(vb),"i"(d0*4096+ks*1024+512):"memory");}
    asm volatile("s_waitcnt lgkmcnt(0)":::"memory");SBAR();
    #define PK(k) (bf16x8){lo[k][0],lo[k][1],lo[k][2],lo[k][3],hi[k][0],hi[k][1],hi[k][2],hi[k][3]}
    o[d0]=__builtin_amdgcn_mfma_f32_32x32x16_bf16(pa0,PK(0),o[d0],0,0,0);
    o[d0]=__builtin_amdgcn_mfma_f32_32x32x16_bf16(pa1,PK(1),o[d0],0,0,0);
    o[d0]=__builtin_amdgcn_mfma_f32_32x32x16_bf16(pa2,PK(2),o[d0],0,0,0);
    o[d0]=__builtin_amdgcn_mfma_f32_32x32x16_bf16(pa3,PK(3),o[d0],0,0,0);
    #undef PK
  }
}
template<int THRL> __device__ __forceinline__ void attn_unit128(int b,int qkcol,int vcol,int qb,const bf16*Q,const bf16*__restrict__ K,const bf16*__restrict__ V,bf16*O,char*shm){
  using namespace v128;
  int tid=threadIdx.x; asm volatile("":"+v"(tid));
  const int lane=tid&63,r32=lane&31,hi=lane>>5; const int wid=__builtin_amdgcn_readfirstlane(tid>>6);
  const long rowbase=(long)b*SEQ; const int q0=qb*QB;
  const bf16*Qw=Q+(rowbase+q0+wid*QBLK)*DM+qkcol;
  const bf16*Kh=K+rowbase*DM+qkcol,*Vh=V+rowbase*DM+vcol;
  const unsigned lds0=(unsigned)(uintptr_t)shm;
  float*wsf=(float*)(shm+XWS)+wid*64;
  const bf16*ksrc=Kh+(long)lane*DM+wid*8;
  const bf16*vsrc=Vh+(long)(16*(wid&3)+(lane>>2))*DM+(wid>>2)*32+(lane&3)*8;
  const unsigned kdst=lds0+XK+wid*1024, vdst=lds0+XV+wid*1024, qdst=lds0+XQO+wid*4096;
  #define DMA_K(t,slot) glds16(ksrc+(long)(t)*KVBLK*DM,(unsigned)__builtin_amdgcn_readfirstlane(kdst+(slot)))
  #define DMA_V(t,slot) do{ glds16(vsrc+(long)(t)*KVBLK*DM,(unsigned)__builtin_amdgcn_readfirstlane(vdst+2*(slot))); glds16(vsrc+64+(long)(t)*KVBLK*DM,(unsigned)__builtin_amdgcn_readfirstlane(vdst+2*(slot)+8192)); }while(0)
  const char*Kbase=shm+XK; bf16x8 kf[8];
  const lds_cptr shm3=(lds_cptr)shm; const lds_cptr kp0=shm3+XK+hi*1024+r32*16; const lds_cptr vp0=shm3+XV+((lane>>4)&1)*32+(lane&3)*8+(4*hi+((lane&15)>>2))*64;
  const lds_cptr qp0=shm3+XQO+wid*4096+lane*16;
  #define QLD(d0) (*(const __attribute__((address_space(3))) bf16x8*)(qp0+(d0)*1024))
  const int NT=(q0+QB)/KVBLK;
  #pragma unroll
  for(int d0=0;d0<4;++d0) glds16(Qw+(long)r32*DM+d0*16+hi*8,(unsigned)__builtin_amdgcn_readfirstlane(qdst+d0*1024));
  DMA_K(0,0);DMA_V(0,0);DMA_K(1,SLOTK);
  float mhat=0.f,l_reg=0.f;f32x16 o[4];o[0]=f32x16{};o[1]=f32x16{};o[2]=f32x16{};o[3]=f32x16{};f32x16 negm=f32x16{};asm volatile("":"+v"(negm));
  const int qrel=wid*QBLK+r32;
  #define CMASK(P0,P1,t) do{int jb_=(t)-(NT-4); if(jb_>=0)cmask(P0,P1,jb_,qrel,hi);}while(0)
  bool resc=false;
  #define START(P0,P1) do{ const float rm=rowmax(P0,P1); resc=false; \
    { const float dl=rm; mhat=fadd_s(mhat,dl); \
      _Pragma("unroll") for(int r=0;r<16;++r){P0[r]=fsub_s(P0[r],dl);P1[r]=fsub_s(P1[r],dl);} \
      _Pragma("unroll") for(int r=0;r<16;++r)negm[r]=-mhat; asm volatile("":"+v"(negm)); } \
    _Pragma("unroll") for(int r=0;r<16;++r)P0[r]=__builtin_amdgcn_exp2f(P0[r]); }while(0)
  #define RESC() do{ if(resc){ asm volatile("s_waitcnt lgkmcnt(0)":::"memory"); \
      _Pragma("unroll") for(int d_=0;d_<4;++d_) _Pragma("unroll") for(int r=0;r<16;++r)o[d_][r]*=wsf[crow(r,hi)]; } }while(0)
  f32x16 pA0,pA1,pB0,pB1;
  int sl_prev=0,sl_cur=0,sl_next=SLOTK;
  #define ROT() do{sl_prev=sl_cur;sl_cur=sl_next;sl_next=(sl_next==(NSLOT-1)*SLOTK)?0:sl_next+SLOTK;}while(0)
  DMA_K(2,2*SLOTK);
  WAIT_BAR(4);
  { bf16x8 q4[4]; q4[0]=QLD(0);q4[1]=QLD(1);q4[2]=QLD(2);q4[3]=QLD(3);
    qkt(pA0,pA1,Kbase,q4,negm,r32,hi);asm volatile("s_nop 15\n\ts_nop 7":"+v"(pA0),"+v"(pA1)); }
  CMASK(pA0,pA1,0);
  START(pA0,pA1);
  _Pragma("unroll") for(int r=0;r<16;++r)pA1[r]=__builtin_amdgcn_exp2f(pA1[r]);
  WAIT_BAR(0);
  DMA_K(3,0);DMA_V(1,SLOTK);
  ROT();
  kload8(kf,kp0+sl_cur);
  bf16x8 qa=QLD(0),qb_;
  WAIT_BAR(3);
  s16x4 vlo[16],vhi[16]; u32x4 pw0,pw1,pw2,pw3;
  #define PKW(P,B) cvtpk_s(P[B],P[B+1])
  #define PAF(k) __builtin_bit_cast(bf16x8,pw##k)
  #define VFR(i) (bf16x8){vlo[i][0],vlo[i][1],vlo[i][2],vlo[i][3],vhi[i][0],vhi[i][1],vhi[i][2],vhi[i][3]}
  #define PIN(x) asm volatile("":"+v"(x))
  #define MX3(a,b,c) __builtin_fmaxf(__builtin_fmaxf((a),(b)),(c))
  #define GAPA(MF,A0,A1,A2,A3,W0,W1,PW) do{ MF; sacc+=A0; sacc+=A1; sacc+=A2; sacc+=A3; PIN(sacc); W0; W1; PIN(PW); SBAR(); }while(0)
  #define EX(v) __builtin_amdgcn_exp2f(v)
  #define GAPB(MF,X,B) do{ MF; X[B]=EX(X[B]); X[B+1]=EX(X[B+1]); PIN(X); SBAR(); }while(0)
  #define VRD(i) do{ vlo[i]=vtr(vp_+(((i)>>2)*4096+((i)&3)*1024)); vhi[i]=vtr(vp_+(((i)>>2)*4096+((i)&3)*1024+512)); SBAR(); }while(0)
  #define KRD(G,j) do{ if(G){ kload2(kf,kp0+sl_next,j); SBAR(); } }while(0)
  #define PVM(db,ks) o[db]=__builtin_amdgcn_mfma_f32_32x32x16_bf16(PAF(ks),VFR(4*(db)+(ks)),o[db],0,0,0)
  #define STEP(C0,C1,P0,P1,t,GK,GV,GL) do{ SBAR(); \
    const lds_cptr vp_=vp0+2*sl_prev; \
    VRD(0); float sacc=(P0[0]+P0[1]); \
    qb_=QLD(1); SBAR(); \
    GAPA(C0=__builtin_amdgcn_mfma_f32_32x32x16_bf16(kf[0],qa,negm,0,0,0), P0[2],P0[3],P0[4],P0[5],     pw0[0]=PKW(P0,0), pw0[1]=PKW(P0,2), pw0); \
    VRD(4); GAPA(C1=__builtin_amdgcn_mfma_f32_32x32x16_bf16(kf[1],qa,negm,0,0,0), P0[6],P0[7],P0[8],P0[9],     pw0[2]=PKW(P0,4), pw0[3]=PKW(P0,6), pw0); \
    qa=QLD(2); SBAR(); \
    GAPA(C0=__builtin_amdgcn_mfma_f32_32x32x16_bf16(kf[2],qb_,C0,0,0,0),   P0[10],P0[11],P0[12],P0[13], pw1[0]=PKW(P0,8), pw1[1]=PKW(P0,10), pw1); \
    VRD(8); GAPA(C1=__builtin_amdgcn_mfma_f32_32x32x16_bf16(kf[3],qb_,C1,0,0,0),   P0[14],P0[15],P1[0],P1[1],   pw1[2]=PKW(P0,12),pw1[3]=PKW(P0,14), pw1); \
    qb_=QLD(3); SBAR(); \
    GAPA(C0=__builtin_amdgcn_mfma_f32_32x32x16_bf16(kf[4],qa,C0,0,0,0),   P1[2],P1[3],P1[4],P1[5],     pw2[0]=PKW(P1,0), pw2[1]=PKW(P1,2), pw2); \
    GAPA(C1=__builtin_amdgcn_mfma_f32_32x32x16_bf16(kf[5],qa,C1,0,0,0),   P1[6],P1[7],P1[8],P1[9],     pw2[2]=PKW(P1,4), pw2[3]=PKW(P1,6), pw2); \
    GAPA(C0=__builtin_amdgcn_mfma_f32_32x32x16_bf16(kf[6],qb_,C0,0,0,0),   P1[10],P1[11],P1[12],P1[13], pw3[0]=PKW(P1,8), pw3[1]=PKW(P1,10), pw3); \
    GAPA(C1=__builtin_amdgcn_mfma_f32_32x32x16_bf16(kf[7],qb_,C1,0,0,0),   P1[14],P1[15],0.f,0.f,       pw3[2]=PKW(P1,12),pw3[3]=PKW(P1,14), pw3); \
    l_reg+=sacc; \
    if(GK){DMA_K((t)+3,sl_cur);} if(GV){DMA_V((t)+1,sl_next);} \
    CMASK(C0,C1,t); \
    { float a=MX3(C0[0],C0[1],C1[0]),b=MX3(C0[2],C0[3],C1[1]); a=MX3(a,C1[2],C1[3]); \
      _Pragma("unroll") for(int r=4;r<16;r+=4){a=MX3(a,C0[r],C0[r+1]);b=MX3(b,C0[r+2],C0[r+3]);a=MX3(a,C1[r],C1[r+1]);b=MX3(b,C1[r+2],C1[r+3]);} \
      float rm=__builtin_fmaxf(a,b); { auto rr=__builtin_amdgcn_permlane32_swap(__float_as_uint(rm),__float_as_uint(rm),false,false); rm=__builtin_fmaxf(__uint_as_float(rr[0]),__uint_as_float(rr[1])); } \
      resc=false; \
      if(__builtin_expect(__any(rm>(float)THRL),0)){ const float dl=__builtin_fmaxf(rm,0.f); mhat+=dl; \
        _Pragma("unroll") for(int r=0;r<16;++r){C0[r]-=dl;C1[r]-=dl;} \
        _Pragma("unroll") for(int r=0;r<16;++r)negm[r]=-mhat; asm volatile("":"+v"(negm)); \
        const float f=__builtin_amdgcn_exp2f(-dl); l_reg*=f; if(hi==0)wsf[r32]=f; resc=true; } } \
    SBAR(); \
      \
    GAPB(PVM(0,0), C0,0);  VRD(12); \
    GAPB(PVM(1,0), C0,2);  VRD(1);  \
    GAPB(PVM(2,0), C0,4);  VRD(5);  \
    KRD(GL,0); GAPB(PVM(3,0), C0,6);  VRD(9);  \
    GAPB(PVM(0,1), C0,8);  VRD(13); \
    KRD(GL,1); GAPB(PVM(1,1), C0,10); VRD(2);  \
    GAPB(PVM(2,1), C0,12); VRD(6);  \
    KRD(GL,2); GAPB(PVM(3,1), C0,14); VRD(10); \
    GAPB(PVM(0,2), C1,0);  VRD(14); \
    KRD(GL,3); GAPB(PVM(1,2), C1,2);  VRD(3);  \
    GAPB(PVM(2,2), C1,4);  VRD(7);  \
    GAPB(PVM(3,2), C1,6);  VRD(11); \
    GAPB(PVM(0,3), C1,8);  VRD(15); \
    GAPB(PVM(1,3), C1,10); \
    qa=QLD(0); SBAR(); \
    GAPB(PVM(2,3), C1,12); \
    GAPB(PVM(3,3), C1,14); \
    }while(0)
  int t=1;
  #undef CMASK
  #define CMASK(P0,P1,t) do{}while(0)
  for(;t+5<NT;t+=2){
    STEP(pB0,pB1,pA0,pA1,t,true,true,true);     WAIT_BAR(3); RESC(); ROT();
    STEP(pA0,pA1,pB0,pB1,t+1,true,true,true);   WAIT_BAR(3); RESC(); ROT();
  }
  #undef CMASK
  #define CMASK(P0,P1,t) do{int jb_=(t)-(NT-4); if(jb_>=0)cmask(P0,P1,jb_,qrel,hi);}while(0)
  #define ENDW(tt) do{ if((tt)+3<NT){WAIT_BAR(3);} else if((tt)+2<NT){WAIT_BAR(2);} else {WAIT_BAR(0);} }while(0)
  for(;t+1<NT;t+=2){
    STEP(pB0,pB1,pA0,pA1,t,(t+3<NT),(t+1<NT),(t+1<NT));       ENDW(t);   RESC(); ROT();
    STEP(pA0,pA1,pB0,pB1,t+1,(t+4<NT),(t+2<NT),(t+2<NT));     ENDW(t+1); RESC(); ROT();
  }
  STEP(pB0,pB1,pA0,pA1,NT-1,false,false,false); RESC();
  { float sacc=pB0[0]+pB0[1]; _Pragma("unroll") for(int r=2;r<16;++r)sacc+=pB0[r]; _Pragma("unroll") for(int r=0;r<16;++r)sacc+=pB1[r]; l_reg+=sacc;
    pw0=(u32x4){PKW(pB0,0),PKW(pB0,2),PKW(pB0,4),PKW(pB0,6)};pw1=(u32x4){PKW(pB0,8),PKW(pB0,10),PKW(pB0,12),PKW(pB0,14)};pw2=(u32x4){PKW(pB1,0),PKW(pB1,2),PKW(pB1,4),PKW(pB1,6)};pw3=(u32x4){PKW(pB1,8),PKW(pB1,10),PKW(pB1,12),PKW(pB1,14)};
    SBAR(); pv128(o,(int)(unsigned)(size_t)vp0+2*sl_cur,PAF(0),PAF(1),PAF(2),PAF(3)); }
  #undef PKW
  #undef PAF
  #undef VFR
  #undef PIN
  #undef MX3
  #undef GAPA
  #undef GAPB
  #undef EX
  #undef VRD
  #undef KRD
  #undef PVM
  #undef STEP
  #undef ENDW
  {auto rr=__builtin_amdgcn_permlane32_swap(__float_as_uint(l_reg),__float_as_uint(l_reg),false,false);l_reg=__uint_as_float(rr[0])+__uint_as_float(rr[1]);}
  if(hi==0)wsf[32+r32]=l_reg;asm volatile("s_waitcnt lgkmcnt(0)":::"memory");
  float rli[16];
  #pragma unroll
  for(int r=0;r<16;++r)rli[r]=__builtin_amdgcn_rcpf(wsf[32+crow(r,hi)]);
  bf16*Ow=O+(rowbase+q0+wid*QBLK)*DM+vcol;
  { bf16*stg=(bf16*)(shm+XQO)+wid*2048;
    #pragma unroll
    for(int p=0;p<2;++p){
      #pragma unroll
      for(int r=0;r<16;++r){const int orow=crow(r,hi);
        #pragma unroll
        for(int d0=0;d0<2;++d0)stg[orow*64+d0*32+r32]=__float2bfloat16(o[2*p+d0][r]*rli[r]);}
      asm volatile("s_waitcnt lgkmcnt(0)":::"memory");
      #pragma unroll
      for(int i=0;i<4;++i){const int row=i*8+(lane>>3),ch=lane&7; const u32x4 v=*(const u32x4*)(stg+row*64+ch*8); ATTN_STORE16(Ow+(long)row*DM+p*64+ch*8,v);}
      asm volatile("s_waitcnt lgkmcnt(0)":::"memory");
    } }
  asm volatile("s_waitcnt lgkmcnt(0)\n\ts_barrier":::"memory");
  #undef DMA_K
  #undef DMA_V
  #undef QLD
  #undef CMASK
  #undef START
  #undef RESC
  #undef ROT
}
struct StaticOrder128 {
  int vcu, G;
  __device__ __forceinline__ explicit StaticOrder128(int grid,int block):vcu((grid%8==0)?(block%8)*(grid/8)+block/8:block),G(grid){}
  __device__ __forceinline__ bool next(int i,AttnUnit&u)const{
    const int L=(i>>2)*G+vcu; const int j=i&3;
    if(L>=256)return false;
    const int combo=L>>2, s=2*(L&3)+(j>>1); const int b=combo>>4, hc=combo&15, h=hc>>1, c=hc&1;
    u.b=b; u.qkcol=(h*2+c)*64; u.vcol=h*128; u.comp=c; u.qb=(j&1)?15-s:s; return true; }
  __device__ __forceinline__ void a_ready(const AttnUnit&)const{}
  __device__ __forceinline__ void done(const AttnUnit&)const{}
};
template<class Sched,int THRL=8> __device__ __forceinline__ void attn_phase128(char*lds,const AttnTensors&T,const Sched&S){
  AttnUnit u;
  for(int i=0;S.next(i,u);++i){ S.a_ready(u); attn_unit128<THRL>(u.b,u.qkcol,u.vcol,u.qb,T.Q,T.K,T.V,T.O2+(size_t)u.comp*((size_t)BATCH*SEQ*DM),lds); S.done(u); }
}
constexpr int ATTN128_LDS_BYTES=v128::XBYTES;
#undef SBAR
#undef WAIT_BAR
}
constexpr float SX8 = 8.f, SWG = 256.f, SH8 = 4.f, SWD = 1024.f, SO8 = 64.f;
constexpr float WCLIP6 = 4.f * 0.02209708691f, SWI = 127.f / WCLIP6, DWI = WCLIP6 / 127.f;
constexpr int NWAVES = 8;
constexpr int NPHASE = 17;
constexpr size_t WS_W0IN = 1 * MiB, WS_WPOOL = 17 * MiB, WS_W0OUT = 18 * MiB, WS_WGU = 26 * MiB, WS_WD = 70 * MiB, WS_W1IN = 92 * MiB, WS_W1OUT = 116 * MiB,
                 WS_EGU = 124 * MiB, WS_ED = 572 * MiB;
static_assert(WS_ED + (size_t)NE * DM * EFF * 2 <= WS_XF, "weight copies end below the activation buffers");
static_assert(WS_OS + (size_t)SLOTS * DM * 2 <= WS_PERM && WS_HM + (size_t)SLOTS * EFF * 2 <= WS_OS && WS_CAT + (size_t)M * DM * 2 <= WS_OS && WS_H + (size_t)M * DFF * 2 <= WS_OS, "d_ws map");
constexpr size_t WS_RS = WS_TOK + 1 * MiB, WS_RSG = WS_RS + 1 * MiB;
static_assert(WS_RSG + (size_t)SLOTS * 4 <= 1792 * MiB, "d_ws map");
constexpr size_t WS_XGS = WS_HM + 238 * MiB;
static_assert(WS_XGS + (size_t)NE * M * DM <= WS_PERM && WS_HM + (size_t)SLOTS * EFF <= WS_XGS && WS_RSG + (size_t)NE * M * 4 <= 1792 * MiB, "d_ws map (sparse expert rows)");
constexpr size_t WS_OS1 = WS_HM + 240 * MiB;
static_assert(WS_HM + (size_t)SLOTS * EFF <= WS_OS1 && WS_OS1 + (size_t)SLOTS * DM * 2 <= WS_OS, "d_ws map (fp8 MoE)");
constexpr int CW_BAR = 4096;
constexpr int RING_OFF = 0, RING_BYTES = 131072;
constexpr int LDSCTL_OFF = RING_BYTES, MISC_OFF = LDSCTL_OFF + 320;
constexpr int LDS_BYTES = 147456;

#define GAS __attribute__((address_space(1)))
#define LAS __attribute__((address_space(3)))
typedef unsigned v4u __attribute__((ext_vector_type(4)));
typedef GAS unsigned gu32;
#define RLX_AGENT __ATOMIC_RELAXED, __HIP_MEMORY_SCOPE_AGENT
#define LDS_WAIT() asm volatile("s_waitcnt lgkmcnt(0)" ::: "memory")
#define VM_WAIT() asm volatile("s_waitcnt vmcnt(0)" ::: "memory")
__device__ __forceinline__ unsigned pk2(float lo, float hi) { return (unsigned)f2bf(lo) | ((unsigned)f2bf(hi) << 16); }
__device__ __forceinline__ float bflo(unsigned w) { return __uint_as_float(w << 16); }
__device__ __forceinline__ float bfhi(unsigned w) { return __uint_as_float(w & 0xffff0000u); }

#define XB_TMO      128
#define XB_XCNT(j)  (256  + 64 * (j))
#define XB_XSUB(j)  (1280 + 64 * (j))
#define XB_XGEN(j)  (2304 + 64 * (j))
#define XB_TOP      3328
#define XB_TOPGEN   3392
#define XCD_BAR_WORDS 3456
#define XB_SPIN_CAP (1u << 18)

__device__ __forceinline__ unsigned xb_ld(unsigned* p)              { return __hip_atomic_load(p, __ATOMIC_RELAXED, __HIP_MEMORY_SCOPE_AGENT); }
__device__ __forceinline__ unsigned xb_add(unsigned* p, unsigned v) { return __hip_atomic_fetch_add(p, v, __ATOMIC_RELAXED, __HIP_MEMORY_SCOPE_AGENT); }
__device__ __forceinline__ unsigned xb_xcc_id() { return (unsigned)__builtin_amdgcn_s_getreg((3 << 11) | 20) & 0xFu; }
#define XB_SPIN(cond, bar) do { unsigned _sp = 0; while (cond) { __builtin_amdgcn_s_sleep(1); \
    if ((++_sp & 255u) == 0u) { if (xb_ld(&(bar)[XB_TMO])) break; if (_sp > XB_SPIN_CAP) { atomicAdd(&(bar)[XB_TMO], 1u); break; } } } } while (0)

struct XcdBarrier {
    unsigned* bar; unsigned x;
    volatile LAS unsigned* st;
};

__device__ __forceinline__ XcdBarrier xcd_barrier_post(unsigned* bar, volatile LAS unsigned* st) {
    XcdBarrier b; b.bar = bar; b.x = xb_xcc_id(); b.st = st;
    if (threadIdx.x == 0) (void)xb_add(&bar[XB_XCNT(b.x)], 1u);
    return b;
}
__device__ __forceinline__ void xcd_barrier_complete(unsigned* bar, unsigned x, unsigned& nloc, unsigned& nx) {
    const unsigned G = gridDim.x * gridDim.y * gridDim.z;
    unsigned sum, cnt, mine, sp = 0u;
    for (;;) {
        sum = 0u; cnt = 0u; mine = 0u;
#pragma unroll
        for (unsigned j = 0; j < 16; ++j) { const unsigned c = xb_ld(&bar[XB_XCNT(j)]); sum += c; cnt += (c > 0u) ? 1u : 0u; mine = (j == x) ? c : mine; }
        if (sum == G) break;
        __builtin_amdgcn_s_sleep(1);
        if ((++sp & 255u) == 0u) { if (xb_ld(&bar[XB_TMO])) break; if (sp > XB_SPIN_CAP) { atomicAdd(&bar[XB_TMO], 1u); break; } }
    }
    nloc = mine > 0u ? mine : 1u; nx = cnt > 0u ? cnt : 1u;
}

__device__ __forceinline__ void xcd_barrier(const XcdBarrier& b) {
    asm volatile("s_waitcnt vmcnt(0)" ::: "memory");
    __syncthreads();
    if (threadIdx.x == 0) {
        unsigned* bar = b.bar;
        __builtin_amdgcn_s_waitcnt(0);
        unsigned nloc = b.st[0], nx = b.st[1];
        if (nloc == 0u) { xcd_barrier_complete(bar, b.x, nloc, nx); b.st[0] = nloc; b.st[1] = nx; }
        const unsigned old = xb_add(&bar[XB_XSUB(b.x)], 1u);
        const unsigned gen = old / nloc;
        if (old + 1u == (gen + 1u) * nloc) {
            __builtin_amdgcn_fence(__ATOMIC_RELEASE, "agent");
            asm volatile("s_waitcnt vmcnt(0)" ::: "memory");
            const unsigned og = xb_add(&bar[XB_TOP], 1u);
            const unsigned tg = og / nx;
            if (og + 1u == (tg + 1u) * nx) xb_add(&bar[XB_TOPGEN], 1u);
            else XB_SPIN(xb_ld(&bar[XB_TOPGEN]) == tg, bar);
            __builtin_amdgcn_fence(__ATOMIC_ACQUIRE, "agent");
            xb_add(&bar[XB_XGEN(b.x)], 1u);
            asm volatile("s_waitcnt vmcnt(0)" ::: "memory");
        } else {
            XB_SPIN(xb_ld(&bar[XB_XGEN(b.x)]) == gen, bar);
            __builtin_amdgcn_fence(__ATOMIC_ACQUIRE, "agent");
            asm volatile("s_waitcnt vmcnt(0)" ::: "memory");
        }
    }
    __syncthreads();
}

__device__ __forceinline__ float wave_max(float v) {
#pragma unroll
    for (int o = 1; o < 64; o <<= 1) v = fmaxf(v, __shfl_xor(v, o));
    return v;
}
__device__ __forceinline__ void quant_row_i8(const f32x4 (&v)[8], unsigned char* q, float* rs, int lane, unsigned char* q2 = nullptr, float* rs2 = nullptr) {
    float m = 0.f;
#pragma unroll
    for (int j = 0; j < 8; ++j) m = fmaxf(fmaxf(m, fmaxf(fabsf(v[j][0]), fabsf(v[j][1]))), fmaxf(fabsf(v[j][2]), fabsf(v[j][3])));
    m = wave_max(m);
    const float sc = m > 0.f ? m * (1.f / 127.f) : 1.f, inv = 1.f / sc;
#pragma unroll
    for (int j = 0; j < 8; ++j) { const unsigned w = pg8::pk4_i8(v[j][0] * inv, v[j][1] * inv, v[j][2] * inv, v[j][3] * inv); *(unsigned*)(q + j * 256 + lane * 4) = w; if (q2) *(unsigned*)(q2 + j * 256 + lane * 4) = w; }
    if (lane == 0) { *rs = sc; if (rs2) *rs2 = sc; }
}
struct P0Item { const float* W; unsigned char* WT; int ldw, k0, csrc, ldt, drow, mode; float sc; };
__device__ __forceinline__ int il_row(int n) { return ((n >> 7) << 8) + (n & 127); }
constexpr int I_W0IN = (DM / 128) * (4096 / 32), I_POOL1 = (PG / 128) * (PG / 32), I_POOL = NPG * I_POOL1, I_SQ = (DM / 128) * (DM / 32), I_FF = (DM / 128) * (DFF / 32), I_WD = (DFF / 128) * (DM / 32),
              I_W1IN = (DM / 128) * (3 * DM / 32), I_EG1 = (DM / 128) * (EFF / 32), I_ED1 = (EFF / 128) * (DM / 32);
constexpr int P0_NITEMS = I_W0IN + I_POOL + I_SQ + 2 * I_FF + I_WD + I_W1IN + I_SQ + 2 * NE * I_EG1 + NE * I_ED1;
constexpr int P0_LATE = 16384, P0_EARLY = P0_NITEMS - P0_LATE;
constexpr int P0_FIRST = I_W0IN, P0_MID = P0_FIRST + (P0_EARLY - P0_FIRST) / 2;
static_assert(P0_LATE <= NE * I_ED1, "late items are expert down-projection items only");
__device__ __forceinline__ bool p0_decode(int it, P0Item& d, const float* const* in, unsigned char* ws, int it_hi = P0_NITEMS) {
    if (it >= it_hi) return false;
    int r = it;
#define P0_SET(W_, ldw_, kb_, c_, WT_, ldt_, drow_, mode_, sc_) do { d.W = (W_); d.ldw = (ldw_); d.k0 = 128 * (kb_); d.csrc = (c_); d.WT = (unsigned char*)(WT_); d.ldt = (ldt_); d.drow = (drow_); d.mode = (mode_); d.sc = (sc_); return true; } while (0)
    if (r < I_W0IN) { const int kb = r / 128, nb = r % 128; P0_SET(in[1], 4096, kb, 32 * nb, ws + WS_W0IN, DM, 32 * nb, 2, SWI); } r -= I_W0IN;
    if (r < I_POOL) { const int g = r / I_POOL1, q = r % I_POOL1, kb = q / 8, nb = q % 8; P0_SET(in[2] + (size_t)g * PG * PG, PG, kb, 32 * nb, ws + WS_WPOOL + (size_t)g * PG * PG * 2, PG, 32 * nb, 0, 1.f); } r -= I_POOL;
    if (r < I_SQ) { const int kb = r / 64, nb = r % 64; P0_SET(in[9], DM, kb, 32 * nb, ws + WS_W0OUT, DM, 32 * nb, 2, 2.f * SWI); } r -= I_SQ;
    if (r < I_FF) { const int kb = r / 176, nb = r % 176; P0_SET(in[12], DFF, kb, 32 * nb, ws + WS_WGU, DM, il_row(32 * nb), 2, SWI); } r -= I_FF;
    if (r < I_FF) { const int kb = r / 176, nb = r % 176; P0_SET(in[13], DFF, kb, 32 * nb, ws + WS_WGU, DM, il_row(32 * nb) + 128, 2, SWI); } r -= I_FF;
    if (r < I_WD) { const int kb = r / 64, nb = r % 64; P0_SET(in[14], DM, kb, 32 * nb, ws + WS_WD, DFF, 32 * nb, 1, SWD); } r -= I_WD;
    if (r < I_W1IN) { const int kb = r / 192, nb = r % 192, n0 = 32 * nb, seg = n0 >> 11, nn = n0 & 2047;
        const int drow = seg == 0 ? 4096 + nn : il_row(nn) + (seg == 2 ? 128 : 0);
        P0_SET(in[17], 3 * DM, kb, n0, ws + WS_W1IN, DM, drow, 2, SWI); } r -= I_W1IN;
    if (r < I_SQ) { const int kb = r / 64, nb = r % 64; P0_SET(in[19], DM, kb, 32 * nb, ws + WS_W1OUT, DM, 32 * nb, 0, 1.f); } r -= I_SQ;
    if (r < NE * I_EG1) { const int e = r / I_EG1, q = r % I_EG1, kb = q / 224, nb = q % 224; P0_SET(in[23] + (size_t)e * DM * EFF, EFF, kb, 32 * nb, ws + WS_EGU + (size_t)e * 2 * EFF * DM, DM, il_row(32 * nb), 2, SWI); } r -= NE * I_EG1;
    if (r < NE * I_EG1) { const int e = r / I_EG1, q = r % I_EG1, kb = q / 224, nb = q % 224; P0_SET(in[24] + (size_t)e * DM * EFF, EFF, kb, 32 * nb, ws + WS_EGU + (size_t)e * 2 * EFF * DM, DM, il_row(32 * nb) + 128, 2, SWI); } r -= NE * I_EG1;
    { const int e = r / I_ED1, q = r % I_ED1, kb = q / 64, nb = q % 64; P0_SET(in[25] + (size_t)e * EFF * DM, DM, kb, 32 * nb, ws + WS_ED + (size_t)e * DM * EFF, EFF, 32 * nb, 1, SWD); }
#undef P0_SET
}
__device__ __forceinline__ void p0_load(const P0Item& d, f32x4 (&v)[16], int lane) {
    const int rg = lane >> 3, c4 = (lane & 7) * 4; const float* p = d.W + (size_t)(d.k0 + 16 * rg) * d.ldw + d.csrc + c4;
#pragma unroll
    for (int i = 0; i < 16; ++i) v[i] = __builtin_nontemporal_load((const GAS f32x4*)(p + (size_t)i * d.ldw));
}
__device__ __forceinline__ void p0_emit(const P0Item& d, const f32x4 (&v)[16], LAS float*, int lane) {
    const int rg = lane >> 3, c4 = (lane & 7) * 4; const float sc = d.sc;
#pragma unroll
    for (int c = 0; c < 4; ++c) {
        const size_t o = (size_t)(d.drow + c4 + c) * d.ldt + d.k0 + 16 * rg;
        if (d.mode == 0) { v4u w0, w1; w0.x = pk2(v[0][c], v[1][c]); w0.y = pk2(v[2][c], v[3][c]); w0.z = pk2(v[4][c], v[5][c]); w0.w = pk2(v[6][c], v[7][c]);
            w1.x = pk2(v[8][c], v[9][c]); w1.y = pk2(v[10][c], v[11][c]); w1.z = pk2(v[12][c], v[13][c]); w1.w = pk2(v[14][c], v[15][c]);
            __builtin_nontemporal_store(w0, (GAS v4u*)((bf16*)d.WT + o)); __builtin_nontemporal_store(w1, (GAS v4u*)((bf16*)d.WT + o + 8)); }
        else if (d.mode == 2) { v4u w; w.x = pg8::pk4_i8(v[0][c] * sc, v[1][c] * sc, v[2][c] * sc, v[3][c] * sc); w.y = pg8::pk4_i8(v[4][c] * sc, v[5][c] * sc, v[6][c] * sc, v[7][c] * sc);
            w.z = pg8::pk4_i8(v[8][c] * sc, v[9][c] * sc, v[10][c] * sc, v[11][c] * sc); w.w = pg8::pk4_i8(v[12][c] * sc, v[13][c] * sc, v[14][c] * sc, v[15][c] * sc); __builtin_nontemporal_store(w, (GAS v4u*)(d.WT + o)); }
        else { v4u w; w.x = pg8::pk4_fp8(v[0][c] * sc, v[1][c] * sc, v[2][c] * sc, v[3][c] * sc); w.y = pg8::pk4_fp8(v[4][c] * sc, v[5][c] * sc, v[6][c] * sc, v[7][c] * sc);
            w.z = pg8::pk4_fp8(v[8][c] * sc, v[9][c] * sc, v[10][c] * sc, v[11][c] * sc); w.w = pg8::pk4_fp8(v[12][c] * sc, v[13][c] * sc, v[14][c] * sc, v[15][c] * sc); __builtin_nontemporal_store(w, (GAS v4u*)(d.WT + o)); }
    }
}
__device__ __forceinline__ void p0_range(const float* const* in, unsigned char* ws, int lo, int hi, int widx, int nw, int lane) {
    P0Item d0, d1, d2; f32x4 v0[16], v1[16], v2[16];
    int it = lo + widx; bool h0 = p0_decode(it, d0, in, ws, hi), h1 = false, h2 = false;
    if (h0) p0_load(d0, v0, lane);
    it += nw; h1 = p0_decode(it, d1, in, ws, hi); if (h1) p0_load(d1, v1, lane);
    while (h0) {
        it += nw; h2 = p0_decode(it, d2, in, ws, hi); if (h2) p0_load(d2, v2, lane);
        p0_emit(d0, v0, nullptr, lane);
        if (!h1) break;
        it += nw; h0 = p0_decode(it, d0, in, ws, hi); if (h0) p0_load(d0, v0, lane);
        p0_emit(d1, v1, nullptr, lane);
        if (!h2) break;
        it += nw; h1 = p0_decode(it, d1, in, ws, hi); if (h1) p0_load(d1, v1, lane);
        p0_emit(d2, v2, nullptr, lane);
    }
}
__device__ __forceinline__ void p0_prologue(const float* const* in, unsigned char* ws, LAS unsigned char* lds, int gw, int NGW, int wave, int lane) {
    p0_range(in, ws, 0, P0_FIRST, gw, NGW, lane);
    const float* x = in[0]; unsigned char* XI8 = ws + WS_XBF; float* RS = (float*)(ws + WS_RS);
    f32x4 va[8], vb[8]; int row = gw;
    if (row < M) {
#pragma unroll
        for (int j = 0; j < 8; ++j) va[j] = *(const f32x4*)(x + (size_t)row * DM + j * 256 + lane * 4); }
    while (row < M) {
        const int r2 = row + NGW;
        if (r2 < M) {
#pragma unroll
            for (int j = 0; j < 8; ++j) vb[j] = *(const f32x4*)(x + (size_t)r2 * DM + j * 256 + lane * 4); }
        __builtin_amdgcn_sched_barrier(0);
        quant_row_i8(va, XI8 + (size_t)row * DM, RS + row, lane);
        if (!(r2 < M)) break;
        const int r3 = r2 + NGW;
        if (r3 < M) {
#pragma unroll
            for (int j = 0; j < 8; ++j) va[j] = *(const f32x4*)(x + (size_t)r3 * DM + j * 256 + lane * 4); }
        __builtin_amdgcn_sched_barrier(0);
        quant_row_i8(vb, XI8 + (size_t)r2 * DM, RS + r2, lane);
        row = r3;
    }
}
__device__ __forceinline__ void pooled_ld16(const bf16* p, float (&v)[16]) {
    const v4u a = *(const v4u*)p, b = *(const v4u*)(p + 8);
    v[0] = bflo(a.x); v[1] = bfhi(a.x); v[2] = bflo(a.y); v[3] = bfhi(a.y); v[4] = bflo(a.z); v[5] = bfhi(a.z); v[6] = bflo(a.w); v[7] = bfhi(a.w);
    v[8] = bflo(b.x); v[9] = bfhi(b.x); v[10] = bflo(b.y); v[11] = bfhi(b.y); v[12] = bflo(b.z); v[13] = bfhi(b.z); v[14] = bflo(b.w); v[15] = bfhi(b.w);
}
__device__ __forceinline__ void pooled_rows(const bf16* PU, bf16* PLD, int gw, int NGW, int lane) {
    const int g = lane >> 4, w = 2 << g;
    for (int blk = gw; blk < M / 8; blk += NGW) {
        const int t0 = blk * 8, pos0 = t0 & (SEQ - 1);
        float acc[16];
#pragma unroll
        for (int i = 0; i < 16; ++i) acc[i] = 0.f;
#pragma unroll
        for (int j = 1; j < 16; ++j) if (j < w && j <= pos0) { float v[16]; pooled_ld16(PU + (size_t)(t0 - j) * PW + lane * 16, v);
#pragma unroll
            for (int i = 0; i < 16; ++i) acc[i] += v[i]; }
#pragma unroll
        for (int r = 0; r < 8; ++r) {
            const int row = t0 + r, pos = pos0 + r, cnt = (pos + 1 < w) ? pos + 1 : w;
            float cur[16]; pooled_ld16(PU + (size_t)row * PW + lane * 16, cur);
#pragma unroll
            for (int i = 0; i < 16; ++i) acc[i] += cur[i];
            if (r > 0 && pos >= w) { float old[16]; pooled_ld16(PU + (size_t)(row - w) * PW + lane * 16, old);
#pragma unroll
                for (int i = 0; i < 16; ++i) acc[i] -= old[i]; }
            const float rc = 1.f / (float)cnt;
            v4u o0, o1;
            o0.x = pk2(acc[0] * rc - cur[0], acc[1] * rc - cur[1]); o0.y = pk2(acc[2] * rc - cur[2], acc[3] * rc - cur[3]); o0.z = pk2(acc[4] * rc - cur[4], acc[5] * rc - cur[5]); o0.w = pk2(acc[6] * rc - cur[6], acc[7] * rc - cur[7]);
            o1.x = pk2(acc[8] * rc - cur[8], acc[9] * rc - cur[9]); o1.y = pk2(acc[10] * rc - cur[10], acc[11] * rc - cur[11]); o1.z = pk2(acc[12] * rc - cur[12], acc[13] * rc - cur[13]); o1.w = pk2(acc[14] * rc - cur[14], acc[15] * rc - cur[15]);
            *(v4u*)(PLD + (size_t)row * PW + lane * 16) = o0; *(v4u*)(PLD + (size_t)row * PW + lane * 16 + 8) = o1;
        }
    }
}
__device__ __forceinline__ void combine_rows_q(const bf16* O2, const bf16* CAT, unsigned char* CATQ, float* RS, const float* q1, const float* k1, const float* q2, const float* k2, const float* subg, int gw, int NGW, int lane) {
    const float lam = lambda_full(q1, k1, q2, k2, lane);
    const int cg = (lane & 7) * 16;
    float gg[16];
#pragma unroll
    for (int i = 0; i < 16; ++i) gg[i] = subg[cg + i] * (1.f - LAM_INIT0);
    for (int row = gw; row < M; row += NGW) {
        const bf16* p1 = O2 + (size_t)row * AW + lane * 16; const bf16* p2 = p1 + (size_t)M * AW; const bf16* pa = CAT + (size_t)row * DM + lane * 16;
        const v4u a0 = *(const v4u*)p1, a1 = *(const v4u*)(p1 + 8), b0 = *(const v4u*)p2, b1 = *(const v4u*)(p2 + 8), c0 = *(const v4u*)pa, c1 = *(const v4u*)(pa + 8);
        const float x[16] = {bflo(a0.x), bfhi(a0.x), bflo(a0.y), bfhi(a0.y), bflo(a0.z), bfhi(a0.z), bflo(a0.w), bfhi(a0.w), bflo(a1.x), bfhi(a1.x), bflo(a1.y), bfhi(a1.y), bflo(a1.z), bfhi(a1.z), bflo(a1.w), bfhi(a1.w)};
        const float y[16] = {bflo(b0.x), bfhi(b0.x), bflo(b0.y), bfhi(b0.y), bflo(b0.z), bfhi(b0.z), bflo(b0.w), bfhi(b0.w), bflo(b1.x), bfhi(b1.x), bflo(b1.y), bfhi(b1.y), bflo(b1.z), bfhi(b1.z), bflo(b1.w), bfhi(b1.w)};
        const float pa_[16] = {bflo(c0.x), bfhi(c0.x), bflo(c0.y), bfhi(c0.y), bflo(c0.z), bfhi(c0.z), bflo(c0.w), bfhi(c0.w), bflo(c1.x), bfhi(c1.x), bflo(c1.y), bfhi(c1.y), bflo(c1.z), bfhi(c1.z), bflo(c1.w), bfhi(c1.w)};
        float o[16], ss = 0.f;
#pragma unroll
        for (int i = 0; i < 16; ++i) { o[i] = x[i] - lam * y[i]; ss += o[i] * o[i]; }
        ss += __shfl_xor(ss, 1); ss += __shfl_xor(ss, 2); ss += __shfl_xor(ss, 4);
        const float r = 1.f / sqrtf(ss * (1.f / 128.f) + RMS_EPS);
        float m = 0.f;
#pragma unroll
        for (int i = 0; i < 16; ++i) { o[i] = o[i] * r * gg[i]; m = fmaxf(m, fmaxf(fabsf(o[i]), fabsf(pa_[i]))); }
        m = wave_max(m);
        const float sc = m > 0.f ? m * (1.f / 127.f) : 1.f, inv = 1.f / sc;
        v4u wa, wo;
        wa.x = pg8::pk4_i8(pa_[0] * inv, pa_[1] * inv, pa_[2] * inv, pa_[3] * inv); wa.y = pg8::pk4_i8(pa_[4] * inv, pa_[5] * inv, pa_[6] * inv, pa_[7] * inv);
        wa.z = pg8::pk4_i8(pa_[8] * inv, pa_[9] * inv, pa_[10] * inv, pa_[11] * inv); wa.w = pg8::pk4_i8(pa_[12] * inv, pa_[13] * inv, pa_[14] * inv, pa_[15] * inv);
        wo.x = pg8::pk4_i8(o[0] * inv, o[1] * inv, o[2] * inv, o[3] * inv); wo.y = pg8::pk4_i8(o[4] * inv, o[5] * inv, o[6] * inv, o[7] * inv);
        wo.z = pg8::pk4_i8(o[8] * inv, o[9] * inv, o[10] * inv, o[11] * inv); wo.w = pg8::pk4_i8(o[12] * inv, o[13] * inv, o[14] * inv, o[15] * inv);
        unsigned char* d = CATQ + (size_t)row * DM + lane * 16; *(v4u*)d = wa; *(v4u*)(d + PW) = wo;
        if (lane == 0) RS[row] = sc;
    }
}
__device__ __forceinline__ unsigned pk4_fp8_(float a, float b, float c, float d) { return pg8::pk4_fp8(a, b, c, d); }
__device__ __forceinline__ void ln_rows(const bf16* Y, const float* g, const float* b, float* XF, bf16* XBF, int gw, int NGW, int lane) {
    for (int row = gw; row < M; row += NGW) { f32x4 v[8]; ln_row(nullptr, g, b, XF + (size_t)row * DM, XBF + (size_t)row * DM, lane, v, nullptr, 1.f, Y + (size_t)row * DM); }
}
__device__ __forceinline__ void row_load_bf16(const bf16* y, int lane, unsigned long long (&raw)[8]) {
#pragma unroll
    for (int j = 0; j < 8; ++j) raw[j] = __builtin_nontemporal_load((const unsigned long long*)(y + j * 256 + lane * 4));
}
__device__ __forceinline__ void ln_row_raw(const unsigned long long (&raw)[8], const f32x4 (&gg)[8], const f32x4 (&bb)[8], bf16* xf, int lane, f32x4 (&v)[8]) {
    float s = 0.f;
#pragma unroll
    for (int j = 0; j < 8; ++j) { const unsigned long long w = raw[j]; v[j] = (f32x4){__uint_as_float((unsigned)w << 16), __uint_as_float((unsigned)w & 0xffff0000u), __uint_as_float((unsigned)(w >> 32) << 16), __uint_as_float((unsigned)(w >> 32) & 0xffff0000u)};
        s += (v[j][0] + v[j][1]) + (v[j][2] + v[j][3]); }
    const float mean = wave_sum(s) * (1.f / DM); float s2 = 0.f;
#pragma unroll
    for (int j = 0; j < 8; ++j) { v[j] = v[j] - mean; s2 += (v[j][0] * v[j][0] + v[j][1] * v[j][1]) + (v[j][2] * v[j][2] + v[j][3] * v[j][3]); }
    const float rstd = 1.f / sqrtf(wave_sum(s2) * (1.f / DM) + LN_EPS);
#pragma unroll
    for (int j = 0; j < 8; ++j) { v[j] = v[j] * rstd * gg[j] + bb[j];
        const unsigned long long w = (unsigned long long)f2bf(v[j][0]) | ((unsigned long long)f2bf(v[j][1]) << 16) | ((unsigned long long)f2bf(v[j][2]) << 32) | ((unsigned long long)f2bf(v[j][3]) << 48);
        *(unsigned long long*)(xf + j * 256 + lane * 4) = w; }
}
__device__ __forceinline__ void ln_rows_q(const bf16* Y, const float* g, const float* b, bf16* XF, unsigned char* XI8, float* RS, int gw, int NGW, int lane) {
    f32x4 gg[8], bb[8];
#pragma unroll
    for (int j = 0; j < 8; ++j) { gg[j] = *(const f32x4*)(g + j * 256 + lane * 4); bb[j] = *(const f32x4*)(b + j * 256 + lane * 4); }
    unsigned long long cur[8], nxt[8];
    int row = gw; if (row < M) row_load_bf16(Y + (size_t)row * DM, lane, cur);
    for (; row < M; row += NGW) {
        const int nr = row + NGW; if (nr < M) row_load_bf16(Y + (size_t)nr * DM, lane, nxt);
        __builtin_amdgcn_sched_barrier(0);
        f32x4 v[8]; ln_row_raw(cur, gg, bb, XF + (size_t)row * DM, lane, v);
        quant_row_i8(v, XI8 + (size_t)row * DM, RS + row, lane);
#pragma unroll
        for (int j = 0; j < 8; ++j) cur[j] = nxt[j];
    }
}
__device__ __forceinline__ void ln_rows8(const bf16* Y, const float* g, const float* b, float* XF, unsigned char* X8, float s8, int gw, int NGW, int lane) {
    for (int row = gw; row < M; row += NGW) { f32x4 v[8]; ln_row(nullptr, g, b, XF + (size_t)row * DM, nullptr, lane, v, X8 + (size_t)row * DM, s8, Y + (size_t)row * DM); }
}
__device__ __forceinline__ void conv_rows(const bf16* BG, const bf16* Z, const float* cw, bf16* V1, int gw, int NGW, int lane) {
    for (int row = gw; row < M; row += NGW) {
        const int pos = row & (SEQ - 1);
#pragma unroll
        for (int q = 0; q < 4; ++q) {
            const int c0 = q * 512 + lane * 8; const size_t o = (size_t)row * DM + c0;
            const v4u z0 = *(const v4u*)(Z + o), bg = *(const v4u*)(BG + o);
            v4u z1 = (v4u){0u, 0u, 0u, 0u}, z2 = (v4u){0u, 0u, 0u, 0u};
            if (pos >= 1) z1 = *(const v4u*)(Z + o - DM);
            if (pos >= 2) z2 = *(const v4u*)(Z + o - 2 * DM);
            const f32x4 w0a = *(const f32x4*)(cw + c0), w0b = *(const f32x4*)(cw + c0 + 4), w1a = *(const f32x4*)(cw + DM + c0), w1b = *(const f32x4*)(cw + DM + c0 + 4),
                        w2a = *(const f32x4*)(cw + 2 * DM + c0), w2b = *(const f32x4*)(cw + 2 * DM + c0 + 4);
            const float zz0[8] = {bflo(z0.x), bfhi(z0.x), bflo(z0.y), bfhi(z0.y), bflo(z0.z), bfhi(z0.z), bflo(z0.w), bfhi(z0.w)};
            const float zz1[8] = {bflo(z1.x), bfhi(z1.x), bflo(z1.y), bfhi(z1.y), bflo(z1.z), bfhi(z1.z), bflo(z1.w), bfhi(z1.w)};
            const float zz2[8] = {bflo(z2.x), bfhi(z2.x), bflo(z2.y), bfhi(z2.y), bflo(z2.z), bfhi(z2.z), bflo(z2.w), bfhi(z2.w)};
            const float bb[8] = {bflo(bg.x), bfhi(bg.x), bflo(bg.y), bfhi(bg.y), bflo(bg.z), bfhi(bg.z), bflo(bg.w), bfhi(bg.w)};
            const float k0[8] = {w0a[0], w0a[1], w0a[2], w0a[3], w0b[0], w0b[1], w0b[2], w0b[3]}, k1[8] = {w1a[0], w1a[1], w1a[2], w1a[3], w1b[0], w1b[1], w1b[2], w1b[3]},
                        k2[8] = {w2a[0], w2a[1], w2a[2], w2a[3], w2b[0], w2b[1], w2b[2], w2b[3]};
            float y[8];
#pragma unroll
            for (int i = 0; i < 8; ++i) y[i] = bb[i] * (k0[i] * zz2[i] + k1[i] * zz1[i] + k2[i] * zz0[i]);
            v4u w; w.x = pk2(y[0], y[1]); w.y = pk2(y[2], y[3]); w.z = pk2(y[4], y[5]); w.w = pk2(y[6], y[7]);
            *(v4u*)(V1 + o) = w;
        }
    }
}
__device__ __forceinline__ void ln_route_rows(const bf16* Y, const float* g, const float* b, bf16* XF, unsigned char* XGS, float* RSGS, const float* wr, unsigned* cnt, int* tok, int gw, int NGW, int lane, LAS float* wl, const float* const* in, unsigned char* ws) {
    for (int i = threadIdx.x; i < DM * NE; i += NWAVES * 64) wl[(i & 7) * DM + (i >> 3)] = wr[i];
    __syncthreads();
    f32x4 gg[8], bb[8];
#pragma unroll
    for (int j = 0; j < 8; ++j) { gg[j] = *(const f32x4*)(g + j * 256 + lane * 4); bb[j] = *(const f32x4*)(b + j * 256 + lane * 4); }
    unsigned long long cur[8], nxt[8];
    int row = gw; if (row < M) row_load_bf16(Y + (size_t)row * DM, lane, cur);
    int cit = P0_EARLY + gw;
    for (; row < M; row += NGW) {
        const int nr = row + NGW; if (nr < M) row_load_bf16(Y + (size_t)nr * DM, lane, nxt);
        P0Item cd; f32x4 cv[16]; const bool chave = p0_decode(cit, cd, in, ws); if (chave) p0_load(cd, cv, lane); cit += NGW;
        __builtin_amdgcn_sched_barrier(0);
        f32x4 v[8]; ln_row_raw(cur, gg, bb, XF + (size_t)row * DM, lane, v);
        float lg[NE];
#pragma unroll
        for (int e = 0; e < NE; ++e) { float a = 0.f;
#pragma unroll
            for (int j = 0; j < 8; ++j) { const f32x4 w = *(const LAS f32x4*)(wl + e * DM + j * 256 + lane * 4); a += (v[j][0] * w[0] + v[j][1] * w[1]) + (v[j][2] * w[2] + v[j][3] * w[3]); }
            lg[e] = wave_sum(a); }
        int i1 = 0; float v1 = lg[0];
#pragma unroll
        for (int e = 1; e < NE; ++e) if (lg[e] > v1) { v1 = lg[e]; i1 = e; }
        int i2 = -1; float v2 = -3.0e38f;
#pragma unroll
        for (int e = 0; e < NE; ++e) if (e != i1 && lg[e] > v2) { v2 = lg[e]; i2 = e; }
        int p1 = 0, p2 = 0;
        if (lane == 0) {
            const float g1 = 1.f / (1.f + expf(v2 - v1)), g2 = 1.f - g1;
            p1 = (int)__hip_atomic_fetch_add(cnt + 64 * i1, 1u, RLX_AGENT); p2 = (int)__hip_atomic_fetch_add(cnt + 64 * i2, 1u, RLX_AGENT);
            int* t = tok + (size_t)row * 8; t[0] = i1; t[1] = i2; t[2] = p1; t[3] = p2; ((float*)t)[4] = g1; ((float*)t)[5] = g2;
        }
        p1 = __builtin_amdgcn_readfirstlane(p1); p2 = __builtin_amdgcn_readfirstlane(p2);
        const size_t s1 = (size_t)i1 * M + p1, s2 = (size_t)i2 * M + p2;
        quant_row_i8(v, XGS + s1 * DM, RSGS + s1, lane, XGS + s2 * DM, RSGS + s2);
        if (chave) p0_emit(cd, cv, nullptr, lane);
#pragma unroll
        for (int j = 0; j < 8; ++j) cur[j] = nxt[j];
    }
    for (; cit < P0_NITEMS; cit += NGW) { P0Item cd; f32x4 cv[16]; if (p0_decode(cit, cd, in, ws)) { p0_load(cd, cv, lane); p0_emit(cd, cv, nullptr, lane); } }
}
__device__ __forceinline__ void gather_rows(const float* XF, unsigned char* XG8, float* RSG, const int* perm, const unsigned* cnt, int gw, int NGW, int lane) {
    int base = 0;
    for (int e = 0; e < NE; ++e) {
        const int n = (int)cnt[64 * e], nt = (n + 255) >> 8;
        for (int pos = gw; pos < nt * 256; pos += NGW) {
            const int tk = pos < n ? perm[e * M + pos] : 0; const size_t slot = (size_t)base * 256 + pos;
            f32x4 v[8];
#pragma unroll
            for (int j = 0; j < 8; ++j) v[j] = *(const f32x4*)(XF + (size_t)tk * DM + j * 256 + lane * 4);
            quant_row_i8(v, XG8 + slot * DM, RSG + slot, lane);
        }
        base += nt;
    }
}
typedef float f32x2_ __attribute__((ext_vector_type(2)));
template <int KS> __device__ __forceinline__ void final_rows(const bf16* XF, const unsigned char* OS, long ks_stride, float os_inv, const int* tok, const unsigned* cnt, const float* g, const float* b, float* out, int gw, int NGW, int lane, int mode = 0, int TA = 0) {
    int tb[NE + 1]; { int base = 0;
#pragma unroll
        for (int e = 0; e < NE; ++e) { tb[e] = base; base += ((int)cnt[64 * e] + 255) >> 8; } tb[NE] = base; }
    for (int row = gw; row < M; row += NGW) {
        const int* t = tok + (size_t)row * 8; const int e0 = t[0], e1 = t[1], p0 = t[2], p1 = t[3]; const float g0 = ((const float*)t)[4], g1 = ((const float*)t)[5];
        int b0 = 0, b1 = 0;
#pragma unroll
        for (int e = 0; e < NE; ++e) { if (e == e0) b0 = tb[e]; if (e == e1) b1 = tb[e]; }
        if (mode != 0) { const bool late = (b0 + (p0 >> 8) >= TA) || (b1 + (p1 >> 8) >= TA); if (late != (mode == 2)) continue; }
        const unsigned char* r0 = OS + ((size_t)b0 * 256 + p0) * DM; const unsigned char* r1 = OS + ((size_t)b1 * 256 + p1) * DM; const float h0 = g0 * os_inv, h1 = g1 * os_inv;
        f32x4 v[8]; float s = 0.f;
#pragma unroll
        for (int j = 0; j < 8; ++j) { const unsigned long long xw = *(const unsigned long long*)(XF + (size_t)row * DM + j * 256 + lane * 4);
            const f32x4 x = (f32x4){bflo((unsigned)xw), bfhi((unsigned)xw), bflo((unsigned)(xw >> 32)), bfhi((unsigned)(xw >> 32))};
            f32x4 m0 = (f32x4){0.f, 0.f, 0.f, 0.f}, m1 = m0;
#pragma unroll
            for (int ks = 0; ks < KS; ++ks) { const int a = *(const int*)(r0 + (long)ks * ks_stride + j * 256 + lane * 4), c = *(const int*)(r1 + (long)ks * ks_stride + j * 256 + lane * 4);
                const f32x2_ a0 = __builtin_amdgcn_cvt_pk_f32_fp8(a, false), a1 = __builtin_amdgcn_cvt_pk_f32_fp8(a, true), c0 = __builtin_amdgcn_cvt_pk_f32_fp8(c, false), c1 = __builtin_amdgcn_cvt_pk_f32_fp8(c, true);
                m0 += (f32x4){a0[0], a0[1], a1[0], a1[1]}; m1 += (f32x4){c0[0], c0[1], c1[0], c1[1]}; }
            v[j] = x * ALPHA + m0 * h0 + m1 * h1;
            s += (v[j][0] + v[j][1]) + (v[j][2] + v[j][3]); }
        const float mean = wave_sum(s) * (1.f / DM); float s2 = 0.f;
#pragma unroll
        for (int j = 0; j < 8; ++j) { v[j] = v[j] - mean; s2 += (v[j][0] * v[j][0] + v[j][1] * v[j][1]) + (v[j][2] * v[j][2] + v[j][3] * v[j][3]); }
        const float rstd = 1.f / sqrtf(wave_sum(s2) * (1.f / DM) + LN_EPS);
#pragma unroll
        for (int j = 0; j < 8; ++j) { const f32x4 gg = *(const f32x4*)(g + j * 256 + lane * 4), bb = *(const f32x4*)(b + j * 256 + lane * 4);
            *(f32x4*)(out + (size_t)row * DM + j * 256 + lane * 4) = v[j] * rstd * gg + bb; }
    }
}

constexpr int MOE_TA = 2 * M / 256;
#ifndef MOE_KS
#define MOE_KS 2
#endif
struct Args { const float* in[28]; float* out; unsigned char* ws; int ph_lo, ph_hi, li, pad; };
__global__ void __launch_bounds__(NWAVES * 64, 2) mk_fwd(Args args) {
    extern __shared__ __attribute__((aligned(16))) unsigned char lds[];
    LAS unsigned char* L = (LAS unsigned char*)lds;
    volatile LAS unsigned* MISC = (volatile LAS unsigned*)(L + MISC_OFF);
    const int tid = threadIdx.x, wave = __builtin_amdgcn_readfirstlane(tid >> 6);
#define lane ({ int l_ = (int)threadIdx.x & 63; asm volatile("" : "+v"(l_)); l_; })
    const int G = gridDim.x; const int bx = blockIdx.x; const int vcu = (G % 8 == 0) ? (bx % 8) * (G / 8) + bx / 8 : bx;
    const int gw = vcu * NWAVES + wave, NGW = G * NWAVES;
    unsigned char* ws = args.ws;
    gu32* ctl = (gu32*)(ws + WS_CTL);
    for (int u = tid; u < (LDS_BYTES - LDSCTL_OFF) / 4; u += NWAVES * 64) ((LAS unsigned*)(L + LDSCTL_OFF))[u] = 0u;
    __syncthreads();
    XcdBarrier bar = xcd_barrier_post((unsigned*)(ctl + CW_BAR) + args.li * XCD_BAR_WORDS, MISC + 8);
    const int lo = args.ph_lo, hi = args.ph_hi;
#define IN(k) (lo <= (k) && (k) < hi)
#ifndef PROBE_DUP
#define PROBE_DUP -1
#endif
#define REP(k) _Pragma("unroll") for (int rep_ = 0; rep_ < ((PROBE_DUP == (k)) ? 2 : 1); ++rep_)
#define SEAM(k) do { if (IN(k) && IN((k) + 1)) xcd_barrier(bar); } while (0)
    const float* const* in; { const void* kp_ = (const void*)__builtin_amdgcn_kernarg_segment_ptr(); asm volatile("" : "+s"(kp_)); in = (const float* const*)kp_; }
    bf16* XF = (bf16*)(ws + WS_XF); bf16* Y = (bf16*)(ws + WS_Y); bf16* XBF = (bf16*)(ws + WS_XBF);
    bf16 *PU = (bf16*)(ws + WS_PU), *Q = (bf16*)(ws + WS_Q), *K = (bf16*)(ws + WS_K), *V = (bf16*)(ws + WS_V), *PLD = (bf16*)(ws + WS_PLD), *O2 = (bf16*)(ws + WS_O2), *CAT = (bf16*)(ws + WS_CAT);
    bf16 *H = (bf16*)(ws + WS_H), *BG = (bf16*)(ws + WS_BG), *Z = (bf16*)(ws + WS_Z), *V1 = (bf16*)(ws + WS_V1); unsigned char *OS = ws + WS_OS, *HM8 = ws + WS_HM;
    constexpr long OS_KS_STRIDE = (long)WS_OS1 - (long)WS_OS;
    int* perm = (int*)(ws + WS_PERM); int* tok = (int*)(ws + WS_TOK); unsigned* cnt = (unsigned*)(ws + WS_CTL) + CW_CNT;
    float* RS = (float*)(ws + WS_RS); float* RSG = (float*)(ws + WS_RSG); unsigned char* XGS = ws + WS_XGS;
    constexpr bool AL = true, SP = true;

    if (IN(0)) { REP(0) { p0_prologue(in, ws, L, gw, NGW, wave, lane); } SEAM(0); }
    if (IN(1)) { REP(1) { pg8::Gemm g{XBF, (const bf16*)(ws + WS_W0IN), DM, DM, DM, 0, RS}; pg8::StaticOrder S; S.init(M / 256, 4096 / 256, G, bx);
        pg8::EpiQkv E{PU, (size_t)(WS_Q - WS_PU) / 2, C2, DWI};
        pg8::gemm_phase<pg8::EpiQkv, pg8::StaticOrder, AL, SP, 1, true, true>(L + RING_OFF, g, S, E); } SEAM(1); }
    if (IN(2)) { REP(2) { pooled_rows(PU, PLD, gw, NGW, lane);
        const bool split = (G & 15) == 0, grpA = !split || (bx & 4) == 0;
        const int cw = split ? ((((bx >> 3) << 2) | (bx & 3)) * NWAVES + wave) : gw, cn = split ? NGW / 2 : NGW;
        if (grpA) p0_range(in, ws, P0_FIRST, split ? P0_MID : P0_EARLY, cw, cn, lane);
        VM_WAIT(); __syncthreads();
        const attn_body::AttnTensors AT{(const attn_body::bf16*)Q, (const attn_body::bf16*)K, (const attn_body::bf16*)V, (attn_body::bf16*)O2};
        static_assert(attn_body::ATTN128_LDS_BYTES <= RING_BYTES, "attention scratch fits the stage region");
        const attn_body::StaticOrder128 S(G, bx);
        attn_body::attn_phase128<attn_body::StaticOrder128>((char*)lds + RING_OFF, AT, S);
        if (!grpA) p0_range(in, ws, P0_MID, P0_EARLY, cw, cn, lane); } SEAM(2); }
    if (IN(3)) { REP(3) { pg8::Gemm g{PLD, (const bf16*)(ws + WS_WPOOL), PW, PG, PG, 0, nullptr}; pg8::PoolOrder S; S.init(M / 256, NPG, G, bx);
        pg8::EpiPool E{CAT, in[3], DM, 0};
        pg8::gemm_phase<pg8::EpiPool, pg8::PoolOrder, AL, SP>(L + RING_OFF, g, S, E);
        xcd_barrier(bar);
        combine_rows_q(O2, CAT, ws + WS_PLD, RS, in[4], in[5], in[6], in[7], in[8], gw, NGW, lane); } SEAM(3); }
    if (IN(4)) { REP(4) { pg8::Gemm g{(const bf16*)(ws + WS_PLD), (const bf16*)(ws + WS_W0OUT), DM, DM, DM, 0, RS}; pg8::StaticOrder S; S.init(M / 256, DM / 256, G, bx);
        pg8::EpiResid<false> E{Y, in[0], DM, ALPHA, 0.5f * DWI, 0};
        pg8::gemm_phase<pg8::EpiResid<false>, pg8::StaticOrder, AL, SP, 1, true, true>(L + RING_OFF, g, S, E); } SEAM(4); }
    if (IN(5)) { REP(5) { ln_rows_q(Y, in[10], in[11], XF, (unsigned char*)XBF, RS, gw, NGW, lane); } SEAM(5); }
    if (IN(6)) { REP(6) { pg8::Gemm g{XBF, (const bf16*)(ws + WS_WGU), DM, DM, DM, 0, RS}; pg8::StaticOrder S; S.init(M / 256, 2 * DFF / 256, G, bx);
        pg8::EpiSwigluF8 E{(unsigned char*)H, DFF, DWI, SH8};
        pg8::gemm_phase<pg8::EpiSwigluF8, pg8::StaticOrder, AL, SP, 1, true, true>(L + RING_OFF, g, S, E); } SEAM(6); }
    if (IN(7)) { REP(7) { pg8::Gemm g{H, (const bf16*)(ws + WS_WD), DFF, DFF, DFF, 0, nullptr}; pg8::StaticOrder S; S.init(M / 256, DM / 256, G, bx);
        pg8::EpiResid<true> E{Y, XF, DM, ALPHA, 1.f / (SH8 * SWD), 0};
        pg8::gemm_phase<pg8::EpiResid<true>, pg8::StaticOrder, AL, SP, 1>(L + RING_OFF, g, S, E); } SEAM(7); }
    if (IN(8)) { REP(8) { ln_rows_q(Y, in[15], in[16], XF, (unsigned char*)XBF, RS, gw, NGW, lane); } SEAM(8); }
    if (IN(9)) { REP(9) { pg8::Gemm g{XBF, (const bf16*)(ws + WS_W1IN), DM, DM, DM, 0, RS}; pg8::StaticOrder S; S.init(M / 256, 3 * DM / 256, G, bx);
        pg8::EpiL1in E{Z, BG, DWI, 0};
        pg8::gemm_phase<pg8::EpiL1in, pg8::StaticOrder, AL, SP, 1, true, true>(L + RING_OFF, g, S, E); } SEAM(9); }
    if (IN(10)) { REP(10) { conv_rows(BG, Z, in[18], V1, gw, NGW, lane); } SEAM(10); }
    if (IN(11)) { REP(11) { pg8::Gemm g{V1, (const bf16*)(ws + WS_W1OUT), DM, DM, DM, 0, nullptr}; pg8::StaticOrder S; S.init(M / 256, DM / 256, G, bx);
        pg8::EpiResid<true> E{Y, XF, DM, ALPHA, 1.f, 0};
        pg8::gemm_phase<pg8::EpiResid<true>, pg8::StaticOrder, AL, SP>(L + RING_OFF, g, S, E); } SEAM(11); }
    if (IN(12)) { ln_route_rows(Y, in[20], in[21], XF, XGS, RSG, in[22], cnt, tok, gw, NGW, lane, (LAS float*)(L + RING_OFF), in, ws); SEAM(12); }
    if (IN(14) || IN(15)) {
        int ts[NE + 1]; { int base = 0;
#pragma unroll
            for (int e = 0; e < NE; ++e) { ts[e] = base; base += (__builtin_amdgcn_readfirstlane((int)cnt[64 * e]) + 255) >> 8; } ts[NE] = base; }
        if (IN(14)) { REP(14) { pg8::Gemm g{(const bf16*)XGS, (const bf16*)(ws + WS_EGU), DM, DM, DM, 0, RSG}; typedef pg8::MoeOrderX<2 * EFF / 256> OrdGU; OrdGU S; S.init(ts[NE], 2 * EFF / 256, G, bx);
            S.ts1 = ts[1]; S.ts2 = ts[2]; S.ts3 = ts[3]; S.ts4 = ts[4]; S.ts5 = ts[5]; S.ts6 = ts[6]; S.ts7 = ts[7];
            pg8::EpiSwigluF8 E{HM8, EFF, DWI, SH8};
            pg8::gemm_phase<pg8::EpiSwigluF8, OrdGU, AL, SP, 1, true, true>(L + RING_OFF, g, S, E); } SEAM(14); }
        if (IN(15)) { REP(15) { pg8::Gemm g{(const bf16*)HM8, (const bf16*)(ws + WS_ED), EFF, EFF, EFF / MOE_KS, 0, nullptr}; typedef pg8::MoeOrder<DM / 256, MOE_KS, EFF / MOE_KS> OrdD; OrdD S;
            const int T = ts[NE]; const bool tsplit = T > MOE_TA && (T - MOE_TA) * (MOE_KS * DM / 256) < G; const int TA = tsplit ? MOE_TA : T;
            S.init(TA, MOE_KS * DM / 256, G, bx);
            S.ts1 = ts[1]; S.ts2 = ts[2]; S.ts3 = ts[3]; S.ts4 = ts[4]; S.ts5 = ts[5]; S.ts6 = ts[6]; S.ts7 = ts[7];
            pg8::EpiOut8 E{OS, OS_KS_STRIDE, DM, SO8 / (SH8 * SWD)};
            pg8::gemm_phase<pg8::EpiOut8, OrdD, AL, SP, 1>(L + RING_OFF, g, S, E);
            if (tsplit) {
                xcd_barrier(bar);
                const int ntail = (T - MOE_TA) * (MOE_KS * DM / 256);
                if (bx < ntail) { typedef pg8::MoeTail<DM / 256, MOE_KS, EFF / MOE_KS> OrdT; OrdT St; St.t0 = MOE_TA; St.nT = T - MOE_TA; St.c = bx;
                    St.ts1 = ts[1]; St.ts2 = ts[2]; St.ts3 = ts[3]; St.ts4 = ts[4]; St.ts5 = ts[5]; St.ts6 = ts[6]; St.ts7 = ts[7];
                    pg8::gemm_phase<pg8::EpiOut8, OrdT, AL, SP, 1, false, false, true>(L + RING_OFF, g, St, E); }
                else final_rows<MOE_KS>(XF, OS, OS_KS_STRIDE, 1.f / SO8, tok, cnt, in[26], in[27], args.out, (bx - ntail) * NWAVES + wave, (G - ntail) * NWAVES, lane, 1, MOE_TA);
            } } SEAM(15); }
    }
    if (IN(16)) { REP(16) { int T = 0;
#pragma unroll
        for (int e = 0; e < NE; ++e) T += (__builtin_amdgcn_readfirstlane((int)cnt[64 * e]) + 255) >> 8;
        const bool tsplit = T > MOE_TA && (T - MOE_TA) * (MOE_KS * DM / 256) < G;
        final_rows<MOE_KS>(XF, OS, OS_KS_STRIDE, 1.f / SO8, tok, cnt, in[26], in[27], args.out, gw, NGW, lane, tsplit ? 2 : 0, MOE_TA); } }
#undef IN
#undef SEAM
#undef lane
}

#ifndef MK_OPT_MASK
#define MK_OPT_MASK 0x1FFFF
#endif
static_assert(MK_OPT_MASK == 0x1FFFF, "the naive fallbacks no longer match the buffer formats of the persistent kernel (fp8 paths, bf16 Y)");
extern "C" void kernel_launch(void* const* d_in, const int* in_sizes, int n_in, void* d_out, int out_size, void* d_ws, size_t ws_size, hipStream_t stream) {
    static int grid = 0;
    if (grid == 0) {
        if (n_in != 28 || out_size != M * DM || in_sizes[0] != M * DM || ws_size < WS_RSG + (size_t)NE * M * 4) { fprintf(stderr, "kernel_launch: unexpected shapes: n_in %d out %d ws %zu (need %zu); nothing launched\n", n_in, out_size, ws_size, (size_t)(WS_RSG + (size_t)NE * M * 4)); grid = -1; return; }
        int dev = 0, cus = 0, per_cu = 0;
        if (hipGetDevice(&dev) != hipSuccess || hipDeviceGetAttribute(&cus, hipDeviceAttributeMultiprocessorCount, dev) != hipSuccess) { fprintf(stderr, "kernel_launch: device query failed\n"); grid = -1; return; }
        if (hipFuncSetAttribute((const void*)mk_fwd, hipFuncAttributeMaxDynamicSharedMemorySize, LDS_BYTES) != hipSuccess) { fprintf(stderr, "kernel_launch: hipFuncSetAttribute failed\n"); grid = -1; return; }
        if (hipOccupancyMaxActiveBlocksPerMultiprocessor(&per_cu, (const void*)mk_fwd, NWAVES * 64, LDS_BYTES) != hipSuccess || per_cu < 1)
            fprintf(stderr, "kernel_launch: note: occupancy query reports %d workgroups per CU\n", per_cu);
        (void)hipGetLastError();
        grid = cus;
    }
    if (grid < 0) return;
    const float* in[28]; for (int i = 0; i < 28; ++i) in[i] = (const float*)d_in[i];
    unsigned char* ws = (unsigned char*)d_ws; float* out = (float*)d_out;
    if (hipMemsetAsync(ws + WS_CTL, 0, CTL_ZERO_BYTES, stream) != hipSuccess) { fprintf(stderr, "kernel_launch: memset failed\n"); return; }
    Args a{}; for (int i = 0; i < 28; ++i) a.in[i] = in[i]; a.out = out; a.ws = ws;
    int li = 0;
#if defined(PROBE_A_END)
    a.ph_lo = 0; a.ph_hi = PROBE_A_END; a.li = 0; hipLaunchKernelGGL(mk_fwd, dim3(grid), dim3(NWAVES * 64), LDS_BYTES, stream, a);
    a.ph_lo = PROBE_B_BEGIN; a.ph_hi = NPHASE; a.li = 1; hipLaunchKernelGGL(mk_fwd, dim3(grid), dim3(NWAVES * 64), LDS_BYTES, stream, a);
    return;
#endif
    for (int p = 0; p < NPHASE;) {
        if ((MK_OPT_MASK >> p) & 1) {
            int q = p; while (q < NPHASE && ((MK_OPT_MASK >> q) & 1)) ++q;
            a.ph_lo = p; a.ph_hi = q; a.li = li++;
            hipLaunchKernelGGL(mk_fwd, dim3(grid), dim3(NWAVES * 64), LDS_BYTES, stream, a);
            const hipError_t le = hipPeekAtLastError();
            if (le != hipSuccess) { fprintf(stderr, "kernel_launch: launch failed: %s\n", hipGetErrorName(le)); return; }
            p = q; continue;
        }
        fprintf(stderr, "kernel_launch: phase %d has no fallback\n", p); return;
    }
}
```

```cpp
#include <hip/hip_runtime.h>
#include <cstdio>
#include <cstdint>

constexpr int BATCH = 4, SEQ = 4096, DM = 2048, M = BATCH * SEQ;
constexpr int PW = 1024, NPG = 4, PG = 256;
constexpr int NH = 8, HD = 64, AW = 1024;
constexpr int DFF = 5632, NE = 8, EFF = 7168;
constexpr float LN_EPS = 1e-5f, RMS_EPS = 1e-5f;
constexpr float ALPHA = 1.41421356237309515f;
constexpr float LAM_INIT0 = 0.2f;
constexpr float C2 = 0.125f * 1.4426950408889634f;
constexpr int MAXRT = 136;
constexpr int SLOTS = MAXRT * 256;

typedef unsigned short bf16;
typedef float f32x4 __attribute__((ext_vector_type(4)));

__device__ __forceinline__ float bf2f(bf16 v) { return __uint_as_float(((unsigned)v) << 16); }
__device__ __forceinline__ bf16 f2bf(float f) { unsigned u = __float_as_uint(f); return (bf16)((u + 0x7fffu + ((u >> 16) & 1u)) >> 16); }

constexpr size_t MiB = 1u << 20;
constexpr size_t WS_CTL = 0, CTL_ZERO_BYTES = 1 * MiB;
constexpr size_t WS_XF = 796 * MiB, WS_Y = 924 * MiB, WS_XBF = 1052 * MiB, WS_HM = 1116 * MiB, WS_OS = 1592 * MiB, WS_PERM = 1728 * MiB;
constexpr size_t WS_TOK = WS_PERM + 1 * MiB;
constexpr size_t WS_END = WS_TOK + 1 * MiB;
constexpr size_t WS_PU = WS_HM, WS_Q = WS_HM + 32 * MiB, WS_K = WS_HM + 64 * MiB, WS_V = WS_HM + 96 * MiB, WS_PLD = WS_HM + 128 * MiB,
                 WS_O2 = WS_HM + 160 * MiB, WS_CAT = WS_HM + 224 * MiB;
constexpr size_t WS_H = WS_HM;
constexpr size_t WS_BG = WS_HM, WS_Z = WS_HM + 64 * MiB, WS_V1 = WS_HM + 128 * MiB;
constexpr int CW_CNT = 64;

__device__ __forceinline__ float wave_sum(float v) {
#pragma unroll
    for (int o = 1; o < 64; o <<= 1) v += __shfl_xor(v, o);
    return v;
}
__device__ __forceinline__ float lambda_full(const float* q1, const float* k1, const float* q2, const float* k2, int lane) {
    const float a = wave_sum(q1[lane] * k1[lane]), b = wave_sum(q2[lane] * k2[lane]);
    return expf(a) - expf(b) + LAM_INIT0;
}
__device__ __forceinline__ unsigned pk4_fp8_(float a, float b, float c, float d);
__device__ __forceinline__ void ln_row(const float* y, const float* g, const float* b, float* xf, bf16* xb, int lane, f32x4 (&v)[8], unsigned char* x8 = nullptr, float s8 = 1.f, const bf16* yb = nullptr) {
    float s = 0.f;
#pragma unroll
    for (int j = 0; j < 8; ++j) {
        if (yb) { const unsigned long long w = *(const unsigned long long*)(yb + j * 256 + lane * 4); v[j] = (f32x4){__uint_as_float((unsigned)w << 16), __uint_as_float((unsigned)w & 0xffff0000u), __uint_as_float((unsigned)(w >> 32) << 16), __uint_as_float((unsigned)(w >> 32) & 0xffff0000u)}; }
        else v[j] = *(const f32x4*)(y + j * 256 + lane * 4);
        s += (v[j][0] + v[j][1]) + (v[j][2] + v[j][3]); }
    const float mean = wave_sum(s) * (1.f / DM); float s2 = 0.f;
#pragma unroll
    for (int j = 0; j < 8; ++j) { v[j] = v[j] - mean; s2 += (v[j][0] * v[j][0] + v[j][1] * v[j][1]) + (v[j][2] * v[j][2] + v[j][3] * v[j][3]); }
    const float rstd = 1.f / sqrtf(wave_sum(s2) * (1.f / DM) + LN_EPS);
#pragma unroll
    for (int j = 0; j < 8; ++j) { const f32x4 gg = *(const f32x4*)(g + j * 256 + lane * 4), bb = *(const f32x4*)(b + j * 256 + lane * 4);
        v[j] = v[j] * rstd * gg + bb;
        if (xf) *(f32x4*)(xf + j * 256 + lane * 4) = v[j];
        if (x8) *(unsigned*)(x8 + j * 256 + lane * 4) = pk4_fp8_(v[j][0] * s8, v[j][1] * s8, v[j][2] * s8, v[j][3] * s8);
        if (xb) { unsigned long long w = (unsigned long long)f2bf(v[j][0]) | ((unsigned long long)f2bf(v[j][1]) << 16) | ((unsigned long long)f2bf(v[j][2]) << 32) | ((unsigned long long)f2bf(v[j][3]) << 48);
            *(unsigned long long*)(xb + j * 256 + lane * 4) = w; } }
}


namespace pg8 {
#define PG8_LAS __attribute__((address_space(3)))
typedef unsigned short bf16_t;
typedef short bf16x8 __attribute__((ext_vector_type(8)));
typedef float f32x4 __attribute__((ext_vector_type(4)));
typedef unsigned u32x4 __attribute__((ext_vector_type(4)));
typedef int i32x4 __attribute__((ext_vector_type(4)));
typedef unsigned u32x2 __attribute__((ext_vector_type(2)));
constexpr int BM = 256, BK = 64, HALF = 128, HTB = HALF * BK * 2  , STAGE_BYTES = 8 * HTB, NXCD = 8, WGM = 8;

__host__ __device__ __forceinline__ int lds_byte(int r, int c) { const int st = (r >> 4) * 2 + (c >> 5), rr = r & 15, cc = c & 31, ob = rr * 64 + cc * 2; return st * 1024 + (ob ^ (((ob >> 9) & 1) << 5)); }
__host__ __device__ __forceinline__ void stage_rc(int b, int& R, int& C) { const int st = b / 1024, sb = b % 1024, swz = sb ^ (((sb >> 9) & 1) << 5); R = (st >> 1) * 16 + swz / 64; C = (st & 1) * 32 + (swz % 64) / 2; }
__host__ __device__ __forceinline__ int perm32(int rho) { const int n = rho >> 4, i = rho & 15; return 8 * (i >> 2) + 4 * n + (i & 3); }

struct Unit { int pm, pn, bt, acol, bcol, sel, am; };
struct Gemm { const bf16_t* A; const bf16_t* Bt; int lda, ldb, K; int pad; const float* rs; };

struct StaticOrder {
    int nM, nN, nwg, G, c;
    __device__ void init(int nM_, int nN_, int G_, int c_) { nM = nM_; nN = nN_; nwg = nM * nN; G = G_; c = c_; }
    __device__ __forceinline__ bool tile(int i, int& pm, int& pn) const {
        const int L = i * G + c; if (L >= nwg) return false;
        int wgid = L; { const int q = nwg / NXCD, r = nwg % NXCD, xcd = wgid % NXCD, off = wgid / NXCD; wgid = (xcd < r ? xcd * (q + 1) : r * (q + 1) + (xcd - r) * q) + off; }
        const int nig = WGM * nN, gid = wgid / nig, fm = gid * WGM, gsz = (nM - fm) < WGM ? (nM - fm) : WGM;
        pm = fm + ((wgid % nig) % gsz); pn = (wgid % nig) / gsz; return true;
    }
    __device__ __forceinline__ bool next(int i, Unit& u) const { int pm, pn; if (!tile(i, pm, pn)) return false; u.pm = pm; u.am = pm; u.pn = pn; u.bt = pn; u.acol = 0; u.bcol = 0; u.sel = 0; return true; }
    __device__ __forceinline__ void a_ready(const Unit&) const {}
    __device__ __forceinline__ void done(const Unit&) const {}
};
struct PoolOrder : StaticOrder {
    __device__ __forceinline__ bool next(int i, Unit& u) const { int pm, pn; if (!tile(i, pm, pn)) return false; u.pm = pm; u.am = pm; u.pn = pn; u.bt = pn; u.acol = 256 * pn; u.bcol = 0; u.sel = 0; return true; }
};
template <int NBT, int KS, int KLEN> struct MoeOrder : StaticOrder {
    int ts1, ts2, ts3, ts4, ts5, ts6, ts7;
    __device__ __forceinline__ int expert(int pm) const { return (pm >= ts1) + (pm >= ts2) + (pm >= ts3) + (pm >= ts4) + (pm >= ts5) + (pm >= ts6) + (pm >= ts7); }
    __device__ __forceinline__ bool next(int i, Unit& u) const { int pm, pn; if (!tile(i, pm, pn)) return false;
        const int kslice = pn % KS, pc = pn / KS; u.pm = pm; u.am = pm; u.pn = pc; u.bt = expert(pm) * NBT + pc; u.acol = kslice * KLEN; u.bcol = kslice * KLEN; u.sel = kslice; return true; }
};

template <int NBT> struct MoeOrderX : StaticOrder {
    int ts1, ts2, ts3, ts4, ts5, ts6, ts7;
    __device__ __forceinline__ int expert(int pm) const { return (pm >= ts1) + (pm >= ts2) + (pm >= ts3) + (pm >= ts4) + (pm >= ts5) + (pm >= ts6) + (pm >= ts7); }
    __device__ __forceinline__ bool next(int i, Unit& u) const {
        constexpr int CW = NBT / NXCD; const int x = c % NXCD, j = c / NXCD, per = G / NXCD;
        const int n = i * per + j, r = n / CW, cc = n % CW; if (r >= nM) return false;
        const int e = expert(r); const int tse = e == 0 ? 0 : e == 1 ? ts1 : e == 2 ? ts2 : e == 3 ? ts3 : e == 4 ? ts4 : e == 5 ? ts5 : e == 6 ? ts6 : ts7;
        u.pm = r; u.am = e * (16384 / BM) + (r - tse); u.pn = x * CW + cc; u.bt = e * NBT + u.pn; u.acol = 0; u.bcol = 0; u.sel = 0; return true; }
};
__device__ __forceinline__ unsigned cvt_pk_bf16(float lo, float hi) { unsigned r; asm volatile("v_cvt_pk_bf16_f32 %0, %1, %2" : "=v"(r) : "v"(lo), "v"(hi)); return r; }
__device__ __forceinline__ float fast_silu(float v) { return v * __builtin_amdgcn_rcpf(1.0f + __builtin_amdgcn_exp2f(-1.4426950408889634f * v)); }

#define PG8_PACK8(v0, v1) ({ u32x4 w_; w_.x = cvt_pk_bf16((v0)[0], (v0)[1]); w_.y = cvt_pk_bf16((v0)[2], (v0)[3]); w_.z = cvt_pk_bf16((v1)[0], (v1)[1]); w_.w = cvt_pk_bf16((v1)[2], (v1)[3]); w_; })
struct EpiQkv {
    static constexpr bool PERM = true, AFTER_DRAIN = false;
    bf16_t* O0; size_t stride; float qscale; float inv;
    __device__ __forceinline__ void operator()(const f32x4 (&acc)[2][2][4][2], const Unit& u, int wr, int wc, int fr, int fq, const PG8_LAS float* rsl = nullptr) const {
        const int t = u.pn >> 2; bf16_t* base = O0 + (size_t)t * stride; const float sc0 = (t == 1) ? qscale * inv : inv;
        const int row0 = u.pm * BM + wr * 64 + fr, col0 = (u.pn & 3) * BM + wc * 32 + 8 * fq;
#pragma unroll
        for (int ai = 0; ai < 2; ++ai)
#pragma unroll
            for (int m = 0; m < 4; ++m) { bf16_t* rowp = base + (size_t)(row0 + ai * HALF + m * 16) * 1024 + col0; const float sc = rsl ? rsl[ai * HALF + wr * 64 + m * 16 + fr] * sc0 : sc0;
#pragma unroll
                for (int bj = 0; bj < 2; ++bj) { const f32x4 v0 = acc[ai][bj][m][0] * sc, v1 = acc[ai][bj][m][1] * sc; *(u32x4*)(rowp + bj * HALF) = PG8_PACK8(v0, v1); } }
    }
};
struct EpiPool {
    static constexpr bool PERM = true, AFTER_DRAIN = false;
    bf16_t* O; const float* scale; int ldc; int pad;
    __device__ __forceinline__ void operator()(const f32x4 (&acc)[2][2][4][2], const Unit& u, int wr, int wc, int fr, int fq, const PG8_LAS float* rsl = nullptr) const {
        const int row0 = u.pm * BM + wr * 64 + fr, col0 = u.pn * BM + wc * 32 + 8 * fq;
        f32x4 sv[2][2];
#pragma unroll
        for (int bj = 0; bj < 2; ++bj)
#pragma unroll
            for (int n = 0; n < 2; ++n) sv[bj][n] = *(const f32x4*)(scale + col0 + bj * HALF + 4 * n);
#pragma unroll
        for (int ai = 0; ai < 2; ++ai)
#pragma unroll
            for (int m = 0; m < 4; ++m) { bf16_t* rowp = O + (size_t)(row0 + ai * HALF + m * 16) * ldc + col0;
#pragma unroll
                for (int bj = 0; bj < 2; ++bj) { const f32x4 v0 = acc[ai][bj][m][0] * sv[bj][0], v1 = acc[ai][bj][m][1] * sv[bj][1]; *(u32x4*)(rowp + bj * HALF) = PG8_PACK8(v0, v1); } }
    }
};
template <bool XB16> struct EpiResid {
    static constexpr bool PERM = true, AFTER_DRAIN = false;
    bf16_t* Y; const void* X; int ldc; float alpha; float scale; int pad;
    __device__ __forceinline__ void operator()(const f32x4 (&acc)[2][2][4][2], const Unit& u, int wr, int wc, int fr, int fq, const PG8_LAS float* rsl = nullptr) const {
        const int row0 = u.pm * BM + wr * 64 + fr, col0 = u.pn * BM + wc * 32 + 8 * fq;
#pragma unroll
        for (int ai = 0; ai < 2; ++ai)
#pragma unroll
            for (int m = 0; m < 4; ++m) { const size_t off = (size_t)(row0 + ai * HALF + m * 16) * ldc + col0;
                f32x4 xv[2][2];
#pragma unroll
                for (int bj = 0; bj < 2; ++bj)
#pragma unroll
                    for (int n = 0; n < 2; ++n) {
                        if constexpr (XB16) { const u32x2 w = *(const u32x2*)((const bf16_t*)X + off + bj * HALF + n * 4); xv[bj][n] = (f32x4){__uint_as_float(w.x << 16), __uint_as_float(w.x & 0xffff0000u), __uint_as_float(w.y << 16), __uint_as_float(w.y & 0xffff0000u)}; }
                        else xv[bj][n] = *(const f32x4*)((const float*)X + off + bj * HALF + n * 4); }
                const float sc = rsl ? rsl[ai * HALF + wr * 64 + m * 16 + fr] * scale : scale;
#pragma unroll
                for (int bj = 0; bj < 2; ++bj) { const f32x4 v0 = xv[bj][0] * alpha + acc[ai][bj][m][0] * sc, v1 = xv[bj][1] * alpha + acc[ai][bj][m][1] * sc; *(u32x4*)(Y + off + bj * HALF) = PG8_PACK8(v0, v1); } }
    }
};
struct EpiSwiglu {
    static constexpr bool PERM = true, AFTER_DRAIN = false;
    bf16_t* H; int ldh; float inv;
    __device__ __forceinline__ void operator()(const f32x4 (&acc)[2][2][4][2], const Unit& u, int wr, int wc, int fr, int fq, const PG8_LAS float* rsl = nullptr) const {
        const int row0 = u.pm * BM + wr * 64 + fr, col0 = u.pn * HALF + wc * 32 + 8 * fq;
#pragma unroll
        for (int ai = 0; ai < 2; ++ai)
#pragma unroll
            for (int m = 0; m < 4; ++m) { f32x4 v0, v1; const float ri = rsl ? rsl[ai * HALF + wr * 64 + m * 16 + fr] * inv : inv;
#pragma unroll
                for (int j = 0; j < 4; ++j) { v0[j] = fast_silu(acc[ai][0][m][0][j] * ri) * (acc[ai][1][m][0][j] * ri); v1[j] = fast_silu(acc[ai][0][m][1][j] * ri) * (acc[ai][1][m][1][j] * ri); }
                *(u32x4*)(H + (size_t)(row0 + ai * HALF + m * 16) * ldh + col0) = PG8_PACK8(v0, v1); }
    }
};
struct EpiL1in {
    static constexpr bool PERM = true, AFTER_DRAIN = false;
    bf16_t* Z; bf16_t* BG; float inv; int pad;
    __device__ __forceinline__ void operator()(const f32x4 (&acc)[2][2][4][2], const Unit& u, int wr, int wc, int fr, int fq, const PG8_LAS float* rsl = nullptr) const {
        const int row0 = u.pm * BM + wr * 64 + fr;
        if (u.pn < 16) { const int col0 = u.pn * HALF + wc * 32 + 8 * fq;
#pragma unroll
            for (int ai = 0; ai < 2; ++ai)
#pragma unroll
                for (int m = 0; m < 4; ++m) { const float ri = rsl ? rsl[ai * HALF + wr * 64 + m * 16 + fr] * inv : inv, r2 = ri * ri;
                    const f32x4 v0 = acc[ai][0][m][0] * acc[ai][1][m][0] * r2, v1 = acc[ai][0][m][1] * acc[ai][1][m][1] * r2;
                    *(u32x4*)(Z + (size_t)(row0 + ai * HALF + m * 16) * 2048 + col0) = PG8_PACK8(v0, v1); }
        } else { const int col0 = (u.pn - 16) * BM + wc * 32 + 8 * fq;
#pragma unroll
            for (int ai = 0; ai < 2; ++ai)
#pragma unroll
                for (int m = 0; m < 4; ++m) { bf16_t* rowp = BG + (size_t)(row0 + ai * HALF + m * 16) * 2048 + col0; const float ri = rsl ? rsl[ai * HALF + wr * 64 + m * 16 + fr] * inv : inv;
#pragma unroll
                    for (int bj = 0; bj < 2; ++bj) { const f32x4 v0 = acc[ai][bj][m][0] * ri, v1 = acc[ai][bj][m][1] * ri; *(u32x4*)(rowp + bj * HALF) = PG8_PACK8(v0, v1); } }
        }
    }
};
struct EpiBf16 {
    static constexpr bool PERM = true, AFTER_DRAIN = false;
    bf16_t* O; long sel_stride; int ldc; float scale;
    __device__ __forceinline__ void operator()(const f32x4 (&acc)[2][2][4][2], const Unit& u, int wr, int wc, int fr, int fq, const PG8_LAS float* rsl = nullptr) const {
        const int row0 = u.pm * BM + wr * 64 + fr, col0 = u.pn * BM + wc * 32 + 8 * fq; bf16_t* base = O + (long)u.sel * sel_stride;
#pragma unroll
        for (int ai = 0; ai < 2; ++ai)
#pragma unroll
            for (int m = 0; m < 4; ++m) { bf16_t* rowp = base + (size_t)(row0 + ai * HALF + m * 16) * ldc + col0;
#pragma unroll
                for (int bj = 0; bj < 2; ++bj) { const f32x4 v0 = acc[ai][bj][m][0] * scale, v1 = acc[ai][bj][m][1] * scale; *(u32x4*)(rowp + bj * HALF) = PG8_PACK8(v0, v1); } }
    }
};

__device__ __forceinline__ unsigned pk4_fp8(float a, float b, float c, float d) {
    a = __builtin_amdgcn_fmed3f(a, -448.f, 448.f); b = __builtin_amdgcn_fmed3f(b, -448.f, 448.f); c = __builtin_amdgcn_fmed3f(c, -448.f, 448.f); d = __builtin_amdgcn_fmed3f(d, -448.f, 448.f);
    int w = __builtin_amdgcn_cvt_pk_fp8_f32(a, b, 0, false); w = __builtin_amdgcn_cvt_pk_fp8_f32(c, d, w, true); return (unsigned)w;
}
struct EpiOut8 {
    static constexpr bool PERM = true, AFTER_DRAIN = false;
    unsigned char* O; long sel_stride; int ldc; float scale;
    __device__ __forceinline__ void operator()(const f32x4 (&acc)[2][2][4][2], const Unit& u, int wr, int wc, int fr, int fq, const PG8_LAS float* rsl = nullptr) const {
        const int row0 = u.pm * BM + wr * 64 + fr, col0 = u.pn * BM + wc * 32 + 8 * fq; unsigned char* base = O + (long)u.sel * sel_stride;
#pragma unroll
        for (int ai = 0; ai < 2; ++ai)
#pragma unroll
            for (int m = 0; m < 4; ++m) { unsigned char* rowp = base + (size_t)(row0 + ai * HALF + m * 16) * ldc + col0;
#pragma unroll
                for (int bj = 0; bj < 2; ++bj) { const f32x4 v0 = acc[ai][bj][m][0] * scale, v1 = acc[ai][bj][m][1] * scale;
                    u32x2 w; w.x = pk4_fp8(v0[0], v0[1], v0[2], v0[3]); w.y = pk4_fp8(v1[0], v1[1], v1[2], v1[3]); *(u32x2*)(rowp + bj * HALF) = w; } }
    }
};
__device__ __forceinline__ unsigned pk4_i8(float a, float b, float c, float d) {
    const float MG = 12582912.f;
    const unsigned ua = __float_as_uint(__builtin_amdgcn_fmed3f(a, -127.f, 127.f) + MG), ub = __float_as_uint(__builtin_amdgcn_fmed3f(b, -127.f, 127.f) + MG);
    const unsigned uc = __float_as_uint(__builtin_amdgcn_fmed3f(c, -127.f, 127.f) + MG), ud = __float_as_uint(__builtin_amdgcn_fmed3f(d, -127.f, 127.f) + MG);
    return __builtin_amdgcn_perm(ub, ua, 0x0c0c0400u) | __builtin_amdgcn_perm(ud, uc, 0x04000c0cu);
}
struct EpiSwigluF8 {
    static constexpr bool PERM = true, AFTER_DRAIN = false;
    unsigned char* H; int ldh; float inv, hscale;
    __device__ __forceinline__ void operator()(const f32x4 (&acc)[2][2][4][2], const Unit& u, int wr, int wc, int fr, int fq, const PG8_LAS float* rsl = nullptr) const {
        const int row0 = u.pm * BM + wr * 64 + fr, col0 = u.pn * HALF + wc * 32 + 8 * fq;
#pragma unroll
        for (int ai = 0; ai < 2; ++ai)
#pragma unroll
            for (int m = 0; m < 4; ++m) { const float ri = rsl ? rsl[ai * HALF + wr * 64 + m * 16 + fr] * inv : inv, ce = ri * -1.4426950408889634f, ics = __builtin_amdgcn_rcpf(ri * ri * hscale);
                f32x4 t0 = acc[ai][0][m][0] * ce, t1 = acc[ai][0][m][1] * ce, p0 = acc[ai][0][m][0] * acc[ai][1][m][0], p1 = acc[ai][0][m][1] * acc[ai][1][m][1], v0, v1;
#pragma unroll
                for (int j = 0; j < 4; ++j) { v0[j] = p0[j] * __builtin_amdgcn_rcpf(__builtin_fmaf(__builtin_amdgcn_exp2f(t0[j]), ics, ics)); v1[j] = p1[j] * __builtin_amdgcn_rcpf(__builtin_fmaf(__builtin_amdgcn_exp2f(t1[j]), ics, ics)); }
                u32x2 w; w.x = pk4_fp8(v0[0], v0[1], v0[2], v0[3]); w.y = pk4_fp8(v1[0], v1[1], v1[2], v1[3]);
                *(u32x2*)(H + (size_t)(row0 + ai * HALF + m * 16) * ldh + col0) = w; }
    }
};
__device__ __forceinline__ void glds_s(const void* sbase, unsigned voff, unsigned lds_dst) {
    unsigned keep;
    asm volatile("s_mov_b32 %0, m0\n\ts_mov_b32 m0, %3\n\ts_nop 0\n\tglobal_load_lds_dwordx4 %1, %2\n\ts_mov_b32 m0, %0" : "=&s"(keep) : "v"(voff), "s"(sbase), "s"(lds_dst) : "memory");
}
__device__ __forceinline__ void glds_s4(const void* sbase, unsigned voff, unsigned lds_dst) {
    unsigned keep;
    asm volatile("s_mov_b32 %0, m0\n\ts_mov_b32 m0, %3\n\ts_nop 0\n\tglobal_load_lds_dword %1, %2\n\ts_mov_b32 m0, %0" : "=&s"(keep) : "v"(voff), "s"(sbase), "s"(lds_dst) : "memory");
}
template <class Epi, class Sched, bool ALIGN_EPI = false, bool SP2 = false, int ESZ = 2, bool I8 = false, bool RSC = false>
__device__ __forceinline__ void gemm_phase(PG8_LAS unsigned char* lds, const Gemm g, const Sched& S, const Epi& E) {
    const int tid = threadIdx.x, wid = __builtin_amdgcn_readfirstlane(tid >> 6), lane = tid & 63, wr = wid >> 2, wc = wid & 3, fr = lane & 15, fq = lane >> 4;
    const int K = g.K, nt = K * ESZ / (BK * 2);
    unsigned voffA[2], voffB[2];
#pragma unroll
    for (int i = 0; i < 2; ++i) { int R, C; stage_rc(tid * 16 + i * 8192, R, C); const int Rb = Epi::PERM ? ((R & ~31) + perm32(R & 31)) : R;
        voffA[i] = (unsigned)(R * g.lda * ESZ + C * 2); voffB[i] = (unsigned)(Rb * g.ldb * ESZ + C * 2); }
    const size_t kstep = (size_t)(BK * 2);
    const size_t hstepA = (size_t)HALF * g.lda * ESZ, hstepB = (size_t)HALF * g.ldb * ESZ;
    const unsigned ldsbase = (unsigned)(size_t)lds + (unsigned)wid * 1024u;
    const int aoff = lds_byte(wr * 64 + fr, fq * 8), boff = lds_byte(wc * 32 + fr, fq * 8);
#define PG8_SA(b, h) (((b) * 2 + (h)) * HTB)
#define PG8_SB(b, h) ((4 + (b) * 2 + (h)) * HTB)
#define PG8_UA(u) ((const char*)g.A + ((size_t)(u).am * BM * g.lda + (u).acol) * ESZ)
#define PG8_UB(u) ((const char*)g.Bt + ((size_t)(u).bt * BM * g.ldb + (u).bcol) * ESZ)
#define PG8_STAGE(bufoff, gbase, voff) do { _Pragma("unroll") for (int _i = 0; _i < 2; ++_i) glds_s((gbase), (voff)[_i], ldsbase + (unsigned)((bufoff) + _i * 8192)); } while (0)
#define PG8_LDA(dst, b, h) do { _Pragma("unroll") for (int m = 0; m < 4; ++m) _Pragma("unroll") for (int k = 0; k < 2; ++k) dst[m][k] = *(const PG8_LAS bf16x8*)(lds + PG8_SA(b, h) + aoff + m * 2048 + k * 1024); } while (0)
#define PG8_LDB(dst, b, h) do { _Pragma("unroll") for (int n = 0; n < 2; ++n) _Pragma("unroll") for (int k = 0; k < 2; ++k) dst[n][k] = *(const PG8_LAS bf16x8*)(lds + PG8_SB(b, h) + boff + n * 2048 + k * 1024); } while (0)
#define PG8_CAT8(x, y) __builtin_shufflevector(__builtin_bit_cast(i32x4, (x)), __builtin_bit_cast(i32x4, (y)), 0, 1, 2, 3, 4, 5, 6, 7)
#define PG8_MMA(ai, bj, At, Bt) do { __builtin_amdgcn_s_setprio(1); \
        if constexpr (ESZ == 2) { _Pragma("unroll") for (int m = 0; m < 4; ++m) _Pragma("unroll") for (int n = 0; n < 2; ++n) _Pragma("unroll") for (int k = 0; k < 2; ++k) \
            acc[ai][bj][m][n] = __builtin_amdgcn_mfma_f32_16x16x32_bf16(Bt[n][k], At[m][k], acc[ai][bj][m][n], 0, 0, 0); } \
        else if constexpr (I8) { _Pragma("unroll") for (int m = 0; m < 4; ++m) _Pragma("unroll") for (int n = 0; n < 2; ++n) _Pragma("unroll") for (int k = 0; k < 2; ++k) \
            acc[ai][bj][m][n] = __builtin_bit_cast(f32x4, __builtin_amdgcn_mfma_i32_16x16x64_i8(__builtin_bit_cast(i32x4, Bt[n][k]), __builtin_bit_cast(i32x4, At[m][k]), __builtin_bit_cast(i32x4, acc[ai][bj][m][n]), 0, 0, 0)); } \
        else { _Pragma("unroll") for (int m = 0; m < 4; ++m) _Pragma("unroll") for (int n = 0; n < 2; ++n) \
            acc[ai][bj][m][n] = __builtin_amdgcn_mfma_scale_f32_16x16x128_f8f6f4(PG8_CAT8(Bt[n][0], Bt[n][1]), PG8_CAT8(At[m][0], At[m][1]), acc[ai][bj][m][n], 0, 0, 0, 0, 0, 0); } \
        __builtin_amdgcn_s_setprio(0); } while (0)
#define PG8_WAIT_V(n) asm volatile("s_waitcnt vmcnt(" #n ")" ::: "memory")
#define PG8_WAIT_L(n) asm volatile("s_waitcnt lgkmcnt(" #n ")" ::: "memory")
#define PG8_BAR __builtin_amdgcn_s_barrier()
#define PG8_SCHED __builtin_amdgcn_sched_barrier(0)
    Unit cur, nxt; int ui = 0;
    if (!S.next(0, cur)) return;
    f32x4 acc[2][2][4][2];
#pragma unroll
    for (int a = 0; a < 2; ++a)
#pragma unroll
        for (int b = 0; b < 2; ++b)
#pragma unroll
            for (int m = 0; m < 4; ++m)
#pragma unroll
                for (int n = 0; n < 2; ++n) acc[a][b][m][n] = (f32x4){0.f, 0.f, 0.f, 0.f};
    bf16x8 At[4][2], B0[2][2], B1[2][2];
    const char* cA = PG8_UA(cur); const char* cB = PG8_UB(cur);
    S.a_ready(cur);
    if constexpr (SP2) {
        PG8_STAGE(PG8_SB(0, 0), cB, voffB); PG8_STAGE(PG8_SB(0, 1), cB + hstepB, voffB); PG8_STAGE(PG8_SA(0, 0), cA, voffA); PG8_STAGE(PG8_SA(0, 1), cA + hstepA, voffA);
        if (wr == 1) PG8_BAR;
        PG8_WAIT_V(2); PG8_BAR;
        PG8_STAGE(PG8_SB(1, 0), cB + kstep, voffB); PG8_STAGE(PG8_SA(1, 0), cA + kstep, voffA); PG8_STAGE(PG8_SB(1, 1), cB + hstepB + kstep, voffB);
        PG8_WAIT_V(6); PG8_BAR;
    } else {
        PG8_STAGE(PG8_SB(0, 0), cB, voffB); PG8_STAGE(PG8_SA(0, 0), cA, voffA); PG8_STAGE(PG8_SB(0, 1), cB + hstepB, voffB); PG8_STAGE(PG8_SA(0, 1), cA + hstepA, voffA);
        if (wr == 1) PG8_BAR;
        PG8_WAIT_V(4); PG8_BAR;
        PG8_STAGE(PG8_SB(1, 0), cB + kstep, voffB); PG8_STAGE(PG8_SA(1, 0), cA + kstep, voffA); PG8_STAGE(PG8_SB(1, 1), cB + hstepB + kstep, voffB);
        PG8_WAIT_V(6); PG8_BAR;
    }
    const unsigned rs_lds = (unsigned)(size_t)lds + (unsigned)STAGE_BYTES + 1024u;
    for (;;) {
        if constexpr (RSC) { if (wid < 4) glds_s4(g.rs + (size_t)cur.am * BM, (unsigned)(wid * 256 + lane * 4), rs_lds + (unsigned)((ui & 1) * 1024 + wid * 256)); }
        const bool has_next = S.next(ui + 1, nxt);
        const char* nA = has_next ? PG8_UA(nxt) : cA; const char* nB = has_next ? PG8_UB(nxt) : cB;
        for (int t = 0; t < nt; t += 2) {
            const bool last = (t == nt - 2);
            const char* a1 = cA + (size_t)(t + 1) * kstep;
            const char* a2 = last ? nA : cA + (size_t)(t + 2) * kstep; const char* b2 = last ? nB : cB + (size_t)(t + 2) * kstep;
            const char* a3 = a2 + kstep; const char* b3 = b2 + kstep;
            if (last && has_next) S.a_ready(nxt);
            if constexpr (SP2) {
            PG8_LDB(B0, 0, 0); PG8_LDB(B1, 0, 1); PG8_SCHED; PG8_LDA(At, 0, 0); PG8_STAGE(PG8_SA(1, 1), a1 + hstepA, voffA);
            PG8_WAIT_V(8); PG8_WAIT_L(0); PG8_BAR; PG8_MMA(0, 0, At, B0); PG8_MMA(0, 1, At, B1); PG8_BAR; PG8_SCHED;
            PG8_LDA(At, 0, 1); PG8_STAGE(PG8_SB(0, 0), b2, voffB); PG8_STAGE(PG8_SB(0, 1), b2 + hstepB, voffB); PG8_STAGE(PG8_SA(0, 0), a2, voffA);
            PG8_WAIT_V(8); PG8_WAIT_L(0); PG8_BAR; PG8_MMA(1, 0, At, B0); PG8_MMA(1, 1, At, B1); PG8_BAR; PG8_SCHED;
            PG8_LDB(B0, 1, 0); PG8_LDB(B1, 1, 1); PG8_SCHED; PG8_LDA(At, 1, 0); PG8_STAGE(PG8_SA(0, 1), a2 + hstepA, voffA);
            PG8_WAIT_V(8); PG8_WAIT_L(0); PG8_BAR; PG8_MMA(0, 0, At, B0); PG8_MMA(0, 1, At, B1); PG8_BAR; PG8_SCHED;
            PG8_LDA(At, 1, 1); PG8_STAGE(PG8_SB(1, 0), b3, voffB); PG8_STAGE(PG8_SB(1, 1), b3 + hstepB, voffB); PG8_STAGE(PG8_SA(1, 0), a3, voffA);
            PG8_WAIT_V(8); PG8_WAIT_L(0); PG8_BAR; PG8_MMA(1, 0, At, B0); PG8_MMA(1, 1, At, B1); PG8_BAR; PG8_SCHED;
            } else {
            PG8_LDB(B0, 0, 0); PG8_SCHED; PG8_LDA(At, 0, 0); PG8_STAGE(PG8_SA(1, 1), a1 + hstepA, voffA);
            PG8_WAIT_L(8); PG8_BAR; PG8_WAIT_L(0); PG8_MMA(0, 0, At, B0); PG8_BAR; PG8_SCHED;
            PG8_LDB(B1, 0, 1); PG8_STAGE(PG8_SB(0, 0), b2, voffB);
            PG8_BAR; PG8_WAIT_L(0); PG8_MMA(0, 1, At, B1); PG8_BAR;
            PG8_LDA(At, 0, 1); PG8_STAGE(PG8_SA(0, 0), a2, voffA);
            PG8_BAR; PG8_WAIT_L(0); PG8_MMA(1, 0, At, B0); PG8_BAR; PG8_SCHED;
            PG8_STAGE(PG8_SB(0, 1), b2 + hstepB, voffB);
            PG8_WAIT_V(6); PG8_BAR; PG8_MMA(1, 1, At, B1); PG8_BAR;
            PG8_LDB(B0, 1, 0); PG8_SCHED; PG8_LDA(At, 1, 0); PG8_STAGE(PG8_SA(0, 1), a2 + hstepA, voffA);
            PG8_WAIT_L(8); PG8_BAR; PG8_WAIT_L(0); PG8_MMA(0, 0, At, B0); PG8_BAR; PG8_SCHED;
            PG8_LDB(B1, 1, 1); PG8_STAGE(PG8_SB(1, 0), b3, voffB);
            PG8_BAR; PG8_WAIT_L(0); PG8_MMA(0, 1, At, B1); PG8_BAR;
            PG8_LDA(At, 1, 1); PG8_STAGE(PG8_SA(1, 0), a3, voffA);
            PG8_BAR; PG8_WAIT_L(0); PG8_MMA(1, 0, At, B0); PG8_BAR; PG8_SCHED;
            PG8_STAGE(PG8_SB(1, 1), b3 + hstepB, voffB);
            PG8_WAIT_V(6); PG8_BAR; PG8_MMA(1, 1, At, B1); PG8_BAR;
            }
        }
        if constexpr (ALIGN_EPI) { if (wr == 0) PG8_BAR; }
        if constexpr (I8) {
#pragma unroll
            for (int a = 0; a < 2; ++a)
#pragma unroll
                for (int b = 0; b < 2; ++b)
#pragma unroll
                    for (int m = 0; m < 4; ++m)
#pragma unroll
                        for (int n = 0; n < 2; ++n) acc[a][b][m][n] = __builtin_convertvector(__builtin_bit_cast(i32x4, acc[a][b][m][n]), f32x4); }
        if constexpr (!Epi::AFTER_DRAIN) { E(acc, cur, wr, wc, fr, fq, RSC ? (const PG8_LAS float*)(lds + STAGE_BYTES + 1024 + (ui & 1) * 1024) : (const PG8_LAS float*)nullptr); S.done(cur); }
        if (!has_next) break;
#pragma unroll
        for (int a = 0; a < 2; ++a)
#pragma unroll
            for (int b = 0; b < 2; ++b)
#pragma unroll
                for (int m = 0; m < 4; ++m)
#pragma unroll
                    for (int n = 0; n < 2; ++n) acc[a][b][m][n] = (f32x4){0.f, 0.f, 0.f, 0.f};
        cur = nxt; cA = nA; cB = nB; ++ui;
        if constexpr (ALIGN_EPI) { if (wr == 1) PG8_BAR; }
    }
    PG8_WAIT_V(0);
    if constexpr (!ALIGN_EPI) { if (wr == 0) PG8_BAR; }
    PG8_BAR;
    if constexpr (Epi::AFTER_DRAIN) { E.fused(acc, cur, wr, wc, fr, fq, lds, wid, lane); S.done(cur); }
#undef PG8_SA
#undef PG8_SB
#undef PG8_UA
#undef PG8_UB
#undef PG8_STAGE
#undef PG8_LDA
#undef PG8_LDB
#undef PG8_MMA
#undef PG8_CAT8
#undef PG8_WAIT_V
#undef PG8_WAIT_L
#undef PG8_BAR
#undef PG8_SCHED
}
}

#include <hip/hip_bf16.h>
#include <cmath>
namespace attn_body {
using bf16=__hip_bfloat16;
using bf16x8=__attribute__((ext_vector_type(8)))short;
using s16x4=__attribute__((ext_vector_type(4)))short;
using f32x16=__attribute__((ext_vector_type(16)))float;
using u32x4=__attribute__((ext_vector_type(4)))unsigned;
constexpr int BATCH=4,SEQ=4096,D=64,DM=1024;
constexpr int NW=8,QBLK=32,QB=QBLK*NW,KVBLK=64,NQB=SEQ/QB;
constexpr int ATTN_PITCH=DM, ATTN_UNIT_ROWS=QB;
static_assert(NQB==16,"attention order assumes 16 query blocks");
__device__ __forceinline__ int crow(int r,int hi){return (r&3)+8*(r>>2)+4*hi;}
#define SBAR() __builtin_amdgcn_sched_barrier(0)
__device__ __forceinline__ void cmask(f32x16&p0,f32x16&p1,int jb,int qrel,int hi){
  const float NEG=-INFINITY; int kb=64*jb+4*hi;
  #pragma unroll
  for(int r=0;r<16;++r){int kv=kb+(r&3)+8*(r>>2); if(kv>qrel)p0[r]=NEG; if(kv+32>qrel)p1[r]=NEG;}
}

constexpr int NSLOT=3, SLOTB=8192;
constexpr int LDS_K=0, LDS_V=NSLOT*SLOTB, LDS_WS=2*NSLOT*SLOTB, LDS_OST=LDS_WS+NW*64*4, LDS_BYTES=LDS_OST+NW*4096;
constexpr float C2=0.125f*1.4426950408889634f;
__device__ __forceinline__ void glds16(const void*gsrc,unsigned lds_dst){unsigned keep;
  asm volatile("s_mov_b32 %0, m0\n\ts_mov_b32 m0, %2\n\ts_nop 0\n\tglobal_load_lds_dwordx4 %1, off\n\ts_mov_b32 m0, %0":"=&s"(keep):"v"(gsrc),"s"(lds_dst):"memory");}
__device__ __forceinline__ float max3f(float a,float b,float c){float r;asm("v_max3_f32 %0, %1, %2, %3":"=v"(r):"v"(a),"v"(b),"v"(c));return r;}
__device__ __forceinline__ float max2f(float a,float b){float r;asm("v_max_f32_e32 %0, %1, %2":"=v"(r):"v"(a),"v"(b));return r;}
__device__ __forceinline__ float fadd_s(float a,float b){float r;asm("v_add_f32_e32 %0, %1, %2":"=v"(r):"v"(a),"v"(b));return r;}
__device__ __forceinline__ float fsub_s(float a,float b){float r;asm("v_sub_f32_e32 %0, %1, %2":"=v"(r):"v"(a),"v"(b));return r;}
typedef float f32x2_t __attribute__((ext_vector_type(2))); typedef __bf16 bf16x2_t __attribute__((ext_vector_type(2)));
__device__ __forceinline__ unsigned cvtpk_s(float lo,float hi){f32x2_t v={lo,hi};bf16x2_t b=__builtin_convertvector(v,bf16x2_t);return __builtin_bit_cast(unsigned,b);}
#define WAIT_BAR(N) asm volatile("s_waitcnt vmcnt(" #N ") lgkmcnt(0)\n\ts_barrier":::"memory")

__device__ __forceinline__ void qkt(f32x16&p0,f32x16&p1,const char*Kslot,const bf16x8*qr,const f32x16&negm,int r32,int hi){
  const char*kb=Kslot+hi*1024+r32*16;
  #pragma unroll
  for(int d0=0;d0<4;++d0){
    const bf16x8 b0=*reinterpret_cast<const bf16x8*>(kb+d0*2048);
    const bf16x8 b1=*reinterpret_cast<const bf16x8*>(kb+d0*2048+512);
    if(d0==0){p0=__builtin_amdgcn_mfma_f32_32x32x16_bf16(b0,qr[0],negm,0,0,0);p1=__builtin_amdgcn_mfma_f32_32x32x16_bf16(b1,qr[0],negm,0,0,0);}
    else{p0=__builtin_amdgcn_mfma_f32_32x32x16_bf16(b0,qr[d0],p0,0,0,0);p1=__builtin_amdgcn_mfma_f32_32x32x16_bf16(b1,qr[d0],p1,0,0,0);}}
}
typedef __attribute__((address_space(3))) const char* lds_cptr;
typedef short v4i16_t __attribute__((ext_vector_type(4)));
__device__ __forceinline__ void kload8(bf16x8*kf,lds_cptr kp){
  kf[0]=*(const __attribute__((address_space(3))) bf16x8*)(kp);      kf[1]=*(const __attribute__((address_space(3))) bf16x8*)(kp+512);
  kf[2]=*(const __attribute__((address_space(3))) bf16x8*)(kp+2048); kf[3]=*(const __attribute__((address_space(3))) bf16x8*)(kp+2560);
  kf[4]=*(const __attribute__((address_space(3))) bf16x8*)(kp+4096); kf[5]=*(const __attribute__((address_space(3))) bf16x8*)(kp+4608);
  kf[6]=*(const __attribute__((address_space(3))) bf16x8*)(kp+6144); kf[7]=*(const __attribute__((address_space(3))) bf16x8*)(kp+6656);
}
__device__ __forceinline__ void kload2(bf16x8*kf,lds_cptr kp,int j){ kf[2*j]=*(const __attribute__((address_space(3))) bf16x8*)(kp+j*2048); kf[2*j+1]=*(const __attribute__((address_space(3))) bf16x8*)(kp+j*2048+512); }
__device__ __forceinline__ s16x4 vtr(lds_cptr p){ return __builtin_bit_cast(s16x4,__builtin_amdgcn_ds_read_tr16_b64_v4i16((__attribute__((address_space(3))) v4i16_t*)p)); }
__device__ __forceinline__ float rowmax(const f32x16&p0,const f32x16&p1){
  float a=max3f(p0[0],p0[1],p1[0]),b=max3f(p0[2],p0[3],p1[1]);a=max3f(a,p1[2],p1[3]);
  #pragma unroll
  for(int r=4;r<16;r+=4){a=max3f(a,p0[r],p0[r+1]);b=max3f(b,p0[r+2],p0[r+3]);a=max3f(a,p1[r],p1[r+1]);b=max3f(b,p1[r+2],p1[r+3]);}
  const float m=max2f(a,b);
  auto rr=__builtin_amdgcn_permlane32_swap(__float_as_uint(m),__float_as_uint(m),false,false);
  return max2f(__uint_as_float(rr[0]),__uint_as_float(rr[1]));
}
__device__ __forceinline__ void pv(f32x16*o,int vb,bf16x8 pa0,bf16x8 pa1,bf16x8 pa2,bf16x8 pa3){
  #pragma unroll
  for(int d0=0;d0<2;++d0){s16x4 lo[4],hi[4];
    #pragma unroll
    for(int ks=0;ks<4;++ks){
      asm volatile("ds_read_b64_tr_b16 %0,%1 offset:%c2":"=&v"(lo[ks]):"v"(vb),"i"(d0*4096+ks*1024):"memory");
      asm volatile("ds_read_b64_tr_b16 %0,%1 offset:%c2":"=&v"(hi[ks]):"v"(vb),"i"(d0*4096+ks*1024+512):"memory");}
    asm volatile("s_waitcnt lgkmcnt(0)":::"memory");SBAR();
    #define PK(k) (bf16x8){lo[k][0],lo[k][1],lo[k][2],lo[k][3],hi[k][0],hi[k][1],hi[k][2],hi[k][3]}
    o[d0]=__builtin_amdgcn_mfma_f32_32x32x16_bf16(pa0,PK(0),o[d0],0,0,0);
    o[d0]=__builtin_amdgcn_mfma_f32_32x32x16_bf16(pa1,PK(1),o[d0],0,0,0);
    o[d0]=__builtin_amdgcn_mfma_f32_32x32x16_bf16(pa2,PK(2),o[d0],0,0,0);
    o[d0]=__builtin_amdgcn_mfma_f32_32x32x16_bf16(pa3,PK(3),o[d0],0,0,0);
    #undef PK
  }
}

#ifndef ATTN_STORE16
#define ATTN_STORE16(p,v) (*(u32x4*)(p)=(v))
#endif
template<int THRL> __device__ __forceinline__ void attn_unit(int b,int qkcol,int vcol,int qb,const bf16*Q,const bf16*__restrict__ K,const bf16*__restrict__ V,bf16*O,char*shm){
  const int tid=threadIdx.x,lane=tid&63,r32=lane&31,hi=lane>>5; const int wid=__builtin_amdgcn_readfirstlane(tid>>6);
  const long rowbase=(long)b*SEQ; const int q0=qb*QB;
  const bf16*Qw=Q+(rowbase+q0+wid*QBLK)*DM+qkcol;
  const bf16*Kh=K+rowbase*DM+qkcol,*Vh=V+rowbase*DM+vcol;
  const unsigned lds0=(unsigned)(uintptr_t)shm;
  float*wsf=(float*)(shm+LDS_WS)+wid*64;
  const bf16*ksrc=Kh+(long)lane*DM+wid*8;
  const bf16*vsrc=Vh+(long)(16*(wid&3)+(lane>>2))*DM+(wid>>2)*32+(lane&3)*8;
  const unsigned kdst=lds0+LDS_K+wid*1024, vdst=lds0+LDS_V+wid*1024;
  #define DMA_K(t,slot) glds16(ksrc+(long)(t)*KVBLK*DM,(unsigned)__builtin_amdgcn_readfirstlane(kdst+(slot)))
  #define DMA_V(t,slot) glds16(vsrc+(long)(t)*KVBLK*DM,(unsigned)__builtin_amdgcn_readfirstlane(vdst+(slot)))
  const int vb0=(int)(lds0+LDS_V)+((lane>>4)&1)*32+(lane&3)*8+(4*hi+((lane&15)>>2))*64;
  const char*Kbase=shm+LDS_K; bf16x8 kf[8];
  const lds_cptr shm3=(lds_cptr)shm; const lds_cptr kp0=shm3+LDS_K+hi*1024+r32*16; const lds_cptr vp0=shm3+LDS_V+((lane>>4)&1)*32+(lane&3)*8+(4*hi+((lane&15)>>2))*64;
  const int NT=(q0+QB)/KVBLK;
  DMA_K(0,0);DMA_V(0,0);DMA_K(1,SLOTB);
  bf16x8 qr[4];
  #pragma unroll
  for(int d0=0;d0<4;++d0)qr[d0]=*reinterpret_cast<const bf16x8*>(&Qw[(long)r32*DM+d0*16+hi*8]);
  float mhat=0.f,l_reg=0.f;f32x16 o[2];o[0]=f32x16{};o[1]=f32x16{};f32x16 negm=f32x16{};asm volatile("":"+v"(negm));
  const int qrel=wid*QBLK+r32;
  #define CMASK(P0,P1,t) do{int jb_=(t)-(NT-4); if(jb_>=0)cmask(P0,P1,jb_,qrel,hi);}while(0)
  bool resc=false;
  #define START(P0,P1) do{ const float rm=rowmax(P0,P1); resc=false; \
    { const float dl=rm; mhat=fadd_s(mhat,dl); \
      _Pragma("unroll") for(int r=0;r<16;++r){P0[r]=fsub_s(P0[r],dl);P1[r]=fsub_s(P1[r],dl);} \
      _Pragma("unroll") for(int r=0;r<16;++r)negm[r]=-mhat; asm volatile("":"+v"(negm)); } \
    _Pragma("unroll") for(int r=0;r<16;++r)P0[r]=__builtin_amdgcn_exp2f(P0[r]); }while(0)
  #define RESC() do{ if(resc){ asm volatile("s_waitcnt lgkmcnt(0)":::"memory"); \
      _Pragma("unroll") for(int d_=0;d_<2;++d_) _Pragma("unroll") for(int r=0;r<16;++r)o[d_][r]*=wsf[crow(r,hi)]; } }while(0)
  f32x16 pA0,pA1,pB0,pB1;
  int sl_prev=0,sl_cur=0,sl_next=SLOTB;
  #define ROT() do{sl_prev=sl_cur;sl_cur=sl_next;sl_next=(sl_next==(NSLOT-1)*SLOTB)?0:sl_next+SLOTB;}while(0)
  DMA_K(2,2*SLOTB);
  WAIT_BAR(3);
  qkt(pA0,pA1,Kbase,qr,negm,r32,hi);asm volatile("s_nop 15\n\ts_nop 7":"+v"(pA0),"+v"(pA1));CMASK(pA0,pA1,0);
  START(pA0,pA1);
  _Pragma("unroll") for(int r=0;r<16;++r)pA1[r]=__builtin_amdgcn_exp2f(pA1[r]);
  WAIT_BAR(0);
  DMA_K(3,0);DMA_V(1,SLOTB);
  ROT();
  kload8(kf,kp0+sl_cur);
  WAIT_BAR(2);
  s16x4 vlo[8],vhi[8]; u32x4 pw0,pw1,pw2,pw3;
  #define PKW(P,B) cvtpk_s(P[B],P[B+1])
  #define PAF(k) __builtin_bit_cast(bf16x8,pw##k)
  #define VFR(i) (bf16x8){vlo[i][0],vlo[i][1],vlo[i][2],vlo[i][3],vhi[i][0],vhi[i][1],vhi[i][2],vhi[i][3]}
  #define PIN(x) asm volatile("":"+v"(x))
  #define MX3(a,b,c) __builtin_fmaxf(__builtin_fmaxf((a),(b)),(c))
  #define GAPA(MF,A0,A1,A2,A3,W0,W1,PW) do{ MF; sacc+=A0; sacc+=A1; sacc+=A2; sacc+=A3; PIN(sacc); W0; W1; PIN(PW); SBAR(); }while(0)
  #define EX(v) __builtin_amdgcn_exp2f(v)
  #define GAPB(MF,X,B) do{ MF; X[B]=EX(X[B]); X[B+1]=EX(X[B+1]); X[B+2]=EX(X[B+2]); X[B+3]=EX(X[B+3]); PIN(X); SBAR(); }while(0)
  #define VRD(i) do{ vlo[i]=vtr(vp_+(((i)>>2)*4096+((i)&3)*1024)); vhi[i]=vtr(vp_+(((i)>>2)*4096+((i)&3)*1024+512)); }while(0)
  #define KRD(G,j) do{ if(G){ kload2(kf,kp0+sl_next,j); SBAR(); } }while(0)
  #define STEP(C0,C1,P0,P1,t,GK,GV,GL) do{ SBAR(); \
    const lds_cptr vp_=vp0+sl_prev; \
    VRD(0); SBAR(); float sacc=(P0[0]+P0[1]); \
    GAPA(C0=__builtin_amdgcn_mfma_f32_32x32x16_bf16(kf[0],qr[0],negm,0,0,0), P0[2],P0[3],P0[4],P0[5],     pw0[0]=PKW(P0,0), pw0[1]=PKW(P0,2), pw0); \
    VRD(4); SBAR(); GAPA(C1=__builtin_amdgcn_mfma_f32_32x32x16_bf16(kf[1],qr[0],negm,0,0,0), P0[6],P0[7],P0[8],P0[9],     pw0[2]=PKW(P0,4), pw0[3]=PKW(P0,6), pw0); \
    VRD(1); SBAR(); GAPA(C0=__builtin_amdgcn_mfma_f32_32x32x16_bf16(kf[2],qr[1],C0,0,0,0),   P0[10],P0[11],P0[12],P0[13], pw1[0]=PKW(P0,8), pw1[1]=PKW(P0,10), pw1); \
    VRD(5); SBAR(); GAPA(C1=__builtin_amdgcn_mfma_f32_32x32x16_bf16(kf[3],qr[1],C1,0,0,0),   P0[14],P0[15],P1[0],P1[1],   pw1[2]=PKW(P0,12),pw1[3]=PKW(P0,14), pw1); \
    VRD(2); SBAR(); GAPA(C0=__builtin_amdgcn_mfma_f32_32x32x16_bf16(kf[4],qr[2],C0,0,0,0),   P1[2],P1[3],P1[4],P1[5],     pw2[0]=PKW(P1,0), pw2[1]=PKW(P1,2), pw2); \
    VRD(6); SBAR(); GAPA(C1=__builtin_amdgcn_mfma_f32_32x32x16_bf16(kf[5],qr[2],C1,0,0,0),   P1[6],P1[7],P1[8],P1[9],     pw2[2]=PKW(P1,4), pw2[3]=PKW(P1,6), pw2); \
    VRD(3); SBAR(); GAPA(C0=__builtin_amdgcn_mfma_f32_32x32x16_bf16(kf[6],qr[3],C0,0,0,0),   P1[10],P1[11],P1[12],P1[13], pw3[0]=PKW(P1,8), pw3[1]=PKW(P1,10), pw3); \
    VRD(7); SBAR(); GAPA(C1=__builtin_amdgcn_mfma_f32_32x32x16_bf16(kf[7],qr[3],C1,0,0,0),   P1[14],P1[15],0.f,0.f,       pw3[2]=PKW(P1,12),pw3[3]=PKW(P1,14), pw3); \
    l_reg+=sacc; \
    if(GK){DMA_K((t)+3,sl_cur);} if(GV){DMA_V((t)+1,sl_next);} \
    CMASK(C0,C1,t); \
    { float a=MX3(C0[0],C0[1],C1[0]),b=MX3(C0[2],C0[3],C1[1]); a=MX3(a,C1[2],C1[3]); \
      _Pragma("unroll") for(int r=4;r<16;r+=4){a=MX3(a,C0[r],C0[r+1]);b=MX3(b,C0[r+2],C0[r+3]);a=MX3(a,C1[r],C1[r+1]);b=MX3(b,C1[r+2],C1[r+3]);} \
      float rm=__builtin_fmaxf(a,b); { auto rr=__builtin_amdgcn_permlane32_swap(__float_as_uint(rm),__float_as_uint(rm),false,false); rm=__builtin_fmaxf(__uint_as_float(rr[0]),__uint_as_float(rr[1])); } \
      resc=false; \
      if(__builtin_expect(__any(rm>(float)THRL),0)){ const float dl=__builtin_fmaxf(rm,0.f); mhat+=dl; \
        _Pragma("unroll") for(int r=0;r<16;++r){C0[r]-=dl;C1[r]-=dl;} \
        _Pragma("unroll") for(int r=0;r<16;++r)negm[r]=-mhat; asm volatile("":"+v"(negm)); \
        const float f=__builtin_amdgcn_exp2f(-dl); l_reg*=f; if(hi==0)wsf[r32]=f; resc=true; } } \
    SBAR(); \
    GAPB(o[0]=__builtin_amdgcn_mfma_f32_32x32x16_bf16(PAF(0),VFR(0),o[0],0,0,0), C0,0); \
    GAPB(o[1]=__builtin_amdgcn_mfma_f32_32x32x16_bf16(PAF(0),VFR(4),o[1],0,0,0), C0,4); \
    KRD(GL,0); GAPB(o[0]=__builtin_amdgcn_mfma_f32_32x32x16_bf16(PAF(1),VFR(1),o[0],0,0,0), C0,8); \
    KRD(GL,1); GAPB(o[1]=__builtin_amdgcn_mfma_f32_32x32x16_bf16(PAF(1),VFR(5),o[1],0,0,0), C0,12); \
    KRD(GL,2); GAPB(o[0]=__builtin_amdgcn_mfma_f32_32x32x16_bf16(PAF(2),VFR(2),o[0],0,0,0), C1,0); \
    KRD(GL,3); GAPB(o[1]=__builtin_amdgcn_mfma_f32_32x32x16_bf16(PAF(2),VFR(6),o[1],0,0,0), C1,4); \
    GAPB(o[0]=__builtin_amdgcn_mfma_f32_32x32x16_bf16(PAF(3),VFR(3),o[0],0,0,0), C1,8); \
    GAPB(o[1]=__builtin_amdgcn_mfma_f32_32x32x16_bf16(PAF(3),VFR(7),o[1],0,0,0), C1,12); \
    }while(0)
  int t=1;
  #undef CMASK
  #define CMASK(P0,P1,t) do{}while(0)
  for(;t+5<NT;t+=2){
    STEP(pB0,pB1,pA0,pA1,t,true,true,true);     WAIT_BAR(2); RESC(); ROT();
    STEP(pA0,pA1,pB0,pB1,t+1,true,true,true);   WAIT_BAR(2); RESC(); ROT();
  }
  #undef CMASK
  #define CMASK(P0,P1,t) do{int jb_=(t)-(NT-4); if(jb_>=0)cmask(P0,P1,jb_,qrel,hi);}while(0)
  #define ENDW(tt) do{ if((tt)+3<NT){WAIT_BAR(2);} else if((tt)+2<NT){WAIT_BAR(1);} else {WAIT_BAR(0);} }while(0)
  for(;t+1<NT;t+=2){
    STEP(pB0,pB1,pA0,pA1,t,(t+3<NT),(t+1<NT),(t+1<NT));       ENDW(t);   RESC(); ROT();
    STEP(pA0,pA1,pB0,pB1,t+1,(t+4<NT),(t+2<NT),(t+2<NT));     ENDW(t+1); RESC(); ROT();
  }
  STEP(pB0,pB1,pA0,pA1,NT-1,false,false,false); RESC();
  { float sacc=pB0[0]+pB0[1]; _Pragma("unroll") for(int r=2;r<16;++r)sacc+=pB0[r]; _Pragma("unroll") for(int r=0;r<16;++r)sacc+=pB1[r]; l_reg+=sacc;
    pw0=(u32x4){PKW(pB0,0),PKW(pB0,2),PKW(pB0,4),PKW(pB0,6)};pw1=(u32x4){PKW(pB0,8),PKW(pB0,10),PKW(pB0,12),PKW(pB0,14)};pw2=(u32x4){PKW(pB1,0),PKW(pB1,2),PKW(pB1,4),PKW(pB1,6)};pw3=(u32x4){PKW(pB1,8),PKW(pB1,10),PKW(pB1,12),PKW(pB1,14)};
    SBAR(); pv(o,vb0+sl_cur,PAF(0),PAF(1),PAF(2),PAF(3)); }
  #undef PKW
  #undef PAF
  #undef VFR
  #undef PIN
  #undef MX3
  #undef GAPA
  #undef GAPB
  #undef EX
  #undef VRD
  #undef KRD
  #undef STEP
  #undef ENDW
  {auto rr=__builtin_amdgcn_permlane32_swap(__float_as_uint(l_reg),__float_as_uint(l_reg),false,false);l_reg=__uint_as_float(rr[0])+__uint_as_float(rr[1]);}
  if(hi==0)wsf[32+r32]=l_reg;asm volatile("s_waitcnt lgkmcnt(0)":::"memory");
  float rli[16];
  #pragma unroll
  for(int r=0;r<16;++r)rli[r]=__builtin_amdgcn_rcpf(wsf[32+crow(r,hi)]);
  bf16*Ow=O+(rowbase+q0+wid*QBLK)*DM+vcol;
  { bf16*stg=(bf16*)(shm+LDS_OST)+wid*2048;
    #pragma unroll
    for(int r=0;r<16;++r){const int orow=crow(r,hi);
      #pragma unroll
      for(int d0=0;d0<2;++d0)stg[orow*64+d0*32+r32]=__float2bfloat16(o[d0][r]*rli[r]);}
    asm volatile("s_waitcnt lgkmcnt(0)":::"memory");
    #pragma unroll
    for(int i=0;i<4;++i){const int row=i*8+(lane>>3),ch=lane&7; const u32x4 v=*(const u32x4*)(stg+row*64+ch*8); ATTN_STORE16(Ow+(long)row*DM+ch*8,v);} }
  asm volatile("s_waitcnt lgkmcnt(0)\n\ts_barrier":::"memory");
  #undef DMA_K
  #undef DMA_V
  #undef CMASK
  #undef START
  #undef RESC
  #undef ROT
}
constexpr int ATTN_LDS_BYTES=LDS_BYTES;
struct AttnTensors { const bf16* Q; const bf16* K; const bf16* V; bf16* O2; size_t o2cs; };
struct AttnUnit { int b, qkcol, vcol, comp, qb; };
struct StaticOrder {
  int vcu, G;
  __device__ __forceinline__ explicit StaticOrder(int grid,int block):vcu((grid%8==0)?(block%8)*(grid/8)+block/8:block),G(grid){}
  __device__ __forceinline__ bool next(int i,AttnUnit&u)const{
    const int L=(i>>3)*G+vcu; const int j=i&7;
    if(L>=256)return false;
    const int combo=L>>1, s=4*(L&1)+(j>>1); const int b=combo>>5, ph=combo&31, h=ph>>2, c=(ph>>1)&1, vh=ph&1;
    u.b=b; u.qkcol=(h*2+c)*64; u.vcol=h*128+vh*64; u.comp=c; u.qb=(j&1)?15-s:s; return true; }
  __device__ __forceinline__ void a_ready(const AttnUnit&)const{}
  __device__ __forceinline__ void done(const AttnUnit&)const{}
};
template<class Sched,int THRL=8> __device__ __forceinline__ void attn_phase(char*lds,const AttnTensors&T,const Sched&S){
  AttnUnit u;
  for(int i=0;S.next(i,u);++i){ S.a_ready(u); attn_unit<THRL>(u.b,u.qkcol,u.vcol,u.qb,T.Q,T.K,T.V,T.O2+(size_t)u.comp*((size_t)BATCH*SEQ*DM),lds); S.done(u); }
}
namespace v128 {
constexpr int SLOTK=8192, SLOTV=16384;
constexpr int XK=0, XV=NSLOT*SLOTK, XWS=XV+NSLOT*SLOTV, XQO=XWS+NW*64*4, XBYTES=XQO+NW*4096;
}
__device__ __forceinline__ void pv128(f32x16*o,int vb,bf16x8 pa0,bf16x8 pa1,bf16x8 pa2,bf16x8 pa3){
  #pragma unroll
  for(int d0=0;d0<4;++d0){s16x4 lo[4],hi[4];
    #pragma unroll
    for(int ks=0;ks<4;++ks){
      asm volatile("ds_read_b64_tr_b16 %0,%1 offset:%c2":"=&v"(lo[ks]):"v"(vb),"i"(d0*4096+ks*1024):"memory");
      asm volatile("ds_read_b64_tr_b16 %0,%1 offset:%c2":"=&v"(hi[ks]):"v"(vb),"i"(d0*4096+ks*1024+512):"memory");}
    asm volatile("s_waitcnt lgkmcnt(0)":::"memory");SBAR();
    #define PK(k) (bf16x8){lo[k][0],lo[k][1],lo[k][2],lo[k][3],hi[k][0],hi[k][1],hi[k][2],hi[k][3]}
    o[d0]=__builtin_amdgcn_mfma_f32_32x32x16_bf16(pa0,PK(0),o[d0],0,0,0);
    o[d0]=__builtin_amdgcn_mfma_f32_32x32x16_bf16(pa1,PK(1),o[d0],0,0,0);
    o[d0]=__builtin_amdgcn_mfma_f32_32x32x16_bf16(pa2,PK(2),o[d0],0,0,0);
    o[d0]=__builtin_amdgcn_mfma_f32_32x32x16_bf16(pa3,PK(3),o[d0],0,0,0);
    #undef PK
  }
}
template<int THRL> __device__ __forceinline__ void attn_unit128(int b,int qkcol,int vcol,int qb,const bf16*Q,const bf16*__restrict__ K,const bf16*__restrict__ V,bf16*O,char*shm){
  using namespace v128;
  int tid=threadIdx.x; asm volatile("":"+v"(tid));
  const int lane=tid&63,r32=lane&31,hi=lane>>5; const int wid=__builtin_amdgcn_readfirstlane(tid>>6);
  const long rowbase=(long)b*SEQ; const int q0=qb*QB;
  const bf16*Qw=Q+(rowbase+q0+wid*QBLK)*DM+qkcol;
  const bf16*Kh=K+rowbase*DM+qkcol,*Vh=V+rowbase*DM+vcol;
  const unsigned lds0=(unsigned)(uintptr_t)shm;
  float*wsf=(float*)(shm+XWS)+wid*64;
  const bf16*ksrc=Kh+(long)lane*DM+wid*8;
  const bf16*vsrc=Vh+(long)(16*(wid&3)+(lane>>2))*DM+(wid>>2)*32+(lane&3)*8;
  const unsigned kdst=lds0+XK+wid*1024, vdst=lds0+XV+wid*1024, qdst=lds0+XQO+wid*4096;
  #define DMA_K(t,slot) glds16(ksrc+(long)(t)*KVBLK*DM,(unsigned)__builtin_amdgcn_readfirstlane(kdst+(slot)))
  #define DMA_V(t,slot) do{ glds16(vsrc+(long)(t)*KVBLK*DM,(unsigned)__builtin_amdgcn_readfirstlane(vdst+2*(slot))); glds16(vsrc+64+(long)(t)*KVBLK*DM,(unsigned)__builtin_amdgcn_readfirstlane(vdst+2*(slot)+8192)); }while(0)
  const char*Kbase=shm+XK; bf16x8 kf[8];
  const lds_cptr shm3=(lds_cptr)shm; const lds_cptr kp0=shm3+XK+hi*1024+r32*16; const lds_cptr vp0=shm3+XV+((lane>>4)&1)*32+(lane&3)*8+(4*hi+((lane&15)>>2))*64;
  const lds_cptr qp0=shm3+XQO+wid*4096+lane*16;
  #define QLD(d0) (*(const __attribute__((address_space(3))) bf16x8*)(qp0+(d0)*1024))
  const int NT=(q0+QB)/KVBLK;
  #pragma unroll
  for(int d0=0;d0<4;++d0) glds16(Qw+(long)r32*DM+d0*16+hi*8,(unsigned)__builtin_amdgcn_readfirstlane(qdst+d0*1024));
  DMA_K(0,0);DMA_V(0,0);DMA_K(1,SLOTK);
  float mhat=0.f,l_reg=0.f;f32x16 o[4];o[0]=f32x16{};o[1]=f32x16{};o[2]=f32x16{};o[3]=f32x16{};f32x16 negm=f32x16{};asm volatile("":"+v"(negm));
  const int qrel=wid*QBLK+r32;
  #define CMASK(P0,P1,t) do{int jb_=(t)-(NT-4); if(jb_>=0)cmask(P0,P1,jb_,qrel,hi);}while(0)
  bool resc=false;
  #define START(P0,P1) do{ const float rm=rowmax(P0,P1); resc=false; \
    { const float dl=rm; mhat=fadd_s(mhat,dl); \
      _Pragma("unroll") for(int r=0;r<16;++r){P0[r]=fsub_s(P0[r],dl);P1[r]=fsub_s(P1[r],dl);} \
      _Pragma("unroll") for(int r=0;r<16;++r)negm[r]=-mhat; asm volatile("":"+v"(negm)); } \
    _Pragma("unroll") for(int r=0;r<16;++r)P0[r]=__builtin_amdgcn_exp2f(P0[r]); }while(0)
  #define RESC() do{ if(resc){ asm volatile("s_waitcnt lgkmcnt(0)":::"memory"); \
      _Pragma("unroll") for(int d_=0;d_<4;++d_) _Pragma("unroll") for(int r=0;r<16;++r)o[d_][r]*=wsf[crow(r,hi)]; } }while(0)
  f32x16 pA0,pA1,pB0,pB1;
  int sl_prev=0,sl_cur=0,sl_next=SLOTK;
  #define ROT() do{sl_prev=sl_cur;sl_cur=sl_next;sl_next=(sl_next==(NSLOT-1)*SLOTK)?0:sl_next+SLOTK;}while(0)
  DMA_K(2,2*SLOTK);
  WAIT_BAR(4);
  { bf16x8 q4[4]; q4[0]=QLD(0);q4[1]=QLD(1);q4[2]=QLD(2);q4[3]=QLD(3);
    qkt(pA0,pA1,Kbase,q4,negm,r32,hi);asm volatile("s_nop 15\n\ts_nop 7":"+v"(pA0),"+v"(pA1)); }
  CMASK(pA0,pA1,0);
  START(pA0,pA1);
  _Pragma("unroll") for(int r=0;r<16;++r)pA1[r]=__builtin_amdgcn_exp2f(pA1[r]);
  WAIT_BAR(0);
  DMA_K(3,0);DMA_V(1,SLOTK);
  ROT();
  kload8(kf,kp0+sl_cur);
  bf16x8 qa=QLD(0),qb_;
  WAIT_BAR(3);
  s16x4 vlo[16],vhi[16]; u32x4 pw0,pw1,pw2,pw3;
  #define PKW(P,B) cvtpk_s(P[B],P[B+1])
  #define PAF(k) __builtin_bit_cast(bf16x8,pw##k)
  #define VFR(i) (bf16x8){vlo[i][0],vlo[i][1],vlo[i][2],vlo[i][3],vhi[i][0],vhi[i][1],vhi[i][2],vhi[i][3]}
  #define PIN(x) asm volatile("":"+v"(x))
  #define MX3(a,b,c) __builtin_fmaxf(__builtin_fmaxf((a),(b)),(c))
  #define GAPA(MF,A0,A1,A2,A3,W0,W1,PW) do{ MF; sacc+=A0; sacc+=A1; sacc+=A2; sacc+=A3; PIN(sacc); W0; W1; PIN(PW); SBAR(); }while(0)
  #define EX(v) __builtin_amdgcn_exp2f(v)
  #define GAPB(MF,X,B) do{ MF; X[B]=EX(X[B]); X[B+1]=EX(X[B+1]); PIN(X); SBAR(); }while(0)
  #define VRD(i) do{ vlo[i]=vtr(vp_+(((i)>>2)*4096+((i)&3)*1024)); vhi[i]=vtr(vp_+(((i)>>2)*4096+((i)&3)*1024+512)); SBAR(); }while(0)
  #define KRD(G,j) do{ if(G){ kload2(kf,kp0+sl_next,j); SBAR(); } }while(0)
  #define PVM(db,ks) o[db]=__builtin_amdgcn_mfma_f32_32x32x16_bf16(PAF(ks),VFR(4*(db)+(ks)),o[db],0,0,0)
  #define STEP(C0,C1,P0,P1,t,GK,GV,GL) do{ SBAR(); \
    const lds_cptr vp_=vp0+2*sl_prev; \
    VRD(0); float sacc=(P0[0]+P0[1]); \
    qb_=QLD(1); SBAR(); \
    GAPA(C0=__builtin_amdgcn_mfma_f32_32x32x16_bf16(kf[0],qa,negm,0,0,0), P0[2],P0[3],P0[4],P0[5],     pw0[0]=PKW(P0,0), pw0[1]=PKW(P0,2), pw0); \
    VRD(4); GAPA(C1=__builtin_amdgcn_mfma_f32_32x32x16_bf16(kf[1],qa,negm,0,0,0), P0[6],P0[7],P0[8],P0[9],     pw0[2]=PKW(P0,4), pw0[3]=PKW(P0,6), pw0); \
    qa=QLD(2); SBAR(); \
    GAPA(C0=__builtin_amdgcn_mfma_f32_32x32x16_bf16(kf[2],qb_,C0,0,0,0),   P0[10],P0[11],P0[12],P0[13], pw1[0]=PKW(P0,8), pw1[1]=PKW(P0,10), pw1); \
    VRD(8); GAPA(C1=__builtin_amdgcn_mfma_f32_32x32x16_bf16(kf[3],qb_,C1,0,0,0),   P0[14],P0[15],P1[0],P1[1],   pw1[2]=PKW(P0,12),pw1[3]=PKW(P0,14), pw1); \
    qb_=QLD(3); SBAR(); \
    GAPA(C0=__builtin_amdgcn_mfma_f32_32x32x16_bf16(kf[4],qa,C0,0,0,0),   P1[2],P1[3],P1[4],P1[5],     pw2[0]=PKW(P1,0), pw2[1]=PKW(P1,2), pw2); \
    GAPA(C1=__builtin_amdgcn_mfma_f32_32x32x16_bf16(kf[5],qa,C1,0,0,0),   P1[6],P1[7],P1[8],P1[9],     pw2[2]=PKW(P1,4), pw2[3]=PKW(P1,6), pw2); \
    GAPA(C0=__builtin_amdgcn_mfma_f32_32x32x16_bf16(kf[6],qb_,C0,0,0,0),   P1[10],P1[11],P1[12],P1[13], pw3[0]=PKW(P1,8), pw3[1]=PKW(P1,10), pw3); \
    GAPA(C1=__builtin_amdgcn_mfma_f32_32x32x16_bf16(kf[7],qb_,C1,0,0,0),   P1[14],P1[15],0.f,0.f,       pw3[2]=PKW(P1,12),pw3[3]=PKW(P1,14), pw3); \
    l_reg+=sacc; \
    if(GK){DMA_K((t)+3,sl_cur);} if(GV){DMA_V((t)+1,sl_next);} \
    CMASK(C0,C1,t); \
    { float a=MX3(C0[0],C0[1],C1[0]),b=MX3(C0[2],C0[3],C1[1]); a=MX3(a,C1[2],C1[3]); \
      _Pragma("unroll") for(int r=4;r<16;r+=4){a=MX3(a,C0[r],C0[r+1]);b=MX3(b,C0[r+2],C0[r+3]);a=MX3(a,C1[r],C1[r+1]);b=MX3(b,C1[r+2],C1[r+3]);} \
      float rm=__builtin_fmaxf(a,b); { auto rr=__builtin_amdgcn_permlane32_swap(__float_as_uint(rm),__float_as_uint(rm),false,false); rm=__builtin_fmaxf(__uint_as_float(rr[0]),__uint_as_float(rr[1])); } \
      resc=false; \
      if(__builtin_expect(__any(rm>(float)THRL),0)){ const float dl=__builtin_fmaxf(rm,0.f); mhat+=dl; \
        _Pragma("unroll") for(int r=0;r<16;++r){C0[r]-=dl;C1[r]-=dl;} \
        _Pragma("unroll") for(int r=0;r<16;++r)negm[r]=-mhat; asm volatile("":"+v"(negm)); \
        const float f=__builtin_amdgcn_exp2f(-dl); l_reg*=f; if(hi==0)wsf[r32]=f; resc=true; } } \
    SBAR(); \
      \
    GAPB(PVM(0,0), C0,0);  VRD(12); \
    GAPB(PVM(1,0), C0,2);  VRD(1);  \
    GAPB(PVM(2,0), C0,4);  VRD(5);  \
    KRD(GL,0); GAPB(PVM(3,0), C0,6);  VRD(9);  \
    GAPB(PVM(0,1), C0,8);  VRD(13); \
    KRD(GL,1); GAPB(PVM(1,1), C0,10); VRD(2);  \
    GAPB(PVM(2,1), C0,12); VRD(6);  \
    KRD(GL,2); GAPB(PVM(3,1), C0,14); VRD(10); \
    GAPB(PVM(0,2), C1,0);  VRD(14); \
    KRD(GL,3); GAPB(PVM(1,2), C1,2);  VRD(3);  \
    GAPB(PVM(2,2), C1,4);  VRD(7);  \
    GAPB(PVM(3,2), C1,6);  VRD(11); \
    GAPB(PVM(0,3), C1,8);  VRD(15); \
    GAPB(PVM(1,3), C1,10); \
    qa=QLD(0); SBAR(); \
    GAPB(PVM(2,3), C1,12); \
    GAPB(PVM(3,3), C1,14); \
    }while(0)
  int t=1;
  #undef CMASK
  #define CMASK(P0,P1,t) do{}while(0)
  for(;t+5<NT;t+=2){
    STEP(pB0,pB1,pA0,pA1,t,true,true,true);     WAIT_BAR(3); RESC(); ROT();
    STEP(pA0,pA1,pB0,pB1,t+1,true,true,true);   WAIT_BAR(3); RESC(); ROT();
  }
  #undef CMASK
  #define CMASK(P0,P1,t) do{int jb_=(t)-(NT-4); if(jb_>=0)cmask(P0,P1,jb_,qrel,hi);}while(0)
  #define ENDW(tt) do{ if((tt)+3<NT){WAIT_BAR(3);} else if((tt)+2<NT){WAIT_BAR(2);} else {WAIT_BAR(0);} }while(0)
  for(;t+1<NT;t+=2){
    STEP(pB0,pB1,pA0,pA1,t,(t+3<NT),(t+1<NT),(t+1<NT));       ENDW(t);   RESC(); ROT();
    STEP(pA0,pA1,pB0,pB1,t+1,(t+4<NT),(t+2<NT),(t+2<NT));     ENDW(t+1); RESC(); ROT();
  }
  STEP(pB0,pB1,pA0,pA1,NT-1,false,false,false); RESC();
  { float sacc=pB0[0]+pB0[1]; _Pragma("unroll") for(int r=2;r<16;++r)sacc+=pB0[r]; _Pragma("unroll") for(int r=0;r<16;++r)sacc+=pB1[r]; l_reg+=sacc;
    pw0=(u32x4){PKW(pB0,0),PKW(pB0,2),PKW(pB0,4),PKW(pB0,6)};pw1=(u32x4){PKW(pB0,8),PKW(pB0,10),PKW(pB0,12),PKW(pB0,14)};pw2=(u32x4){PKW(pB1,0),PKW(pB1,2),PKW(pB1,4),PKW(pB1,6)};pw3=(u32x4){PKW(pB1,8),PKW(pB1,10),PKW(pB1,12),PKW(pB1,14)};
    SBAR(); pv128(o,(int)(unsigned)(size_t)vp0+2*sl_cur,PAF(0),PAF(1),PAF(2),PAF(3)); }
  #undef PKW
  #undef PAF
  #undef VFR
  #undef PIN
  #undef MX3
  #undef GAPA
  #undef GAPB
  #undef EX
  #undef VRD
  #undef KRD
  #undef PVM
  #undef STEP
  #undef ENDW
  {auto rr=__builtin_amdgcn_permlane32_swap(__float_as_uint(l_reg),__float_as_uint(l_reg),false,false);l_reg=__uint_as_float(rr[0])+__uint_as_float(rr[1]);}
  if(hi==0)wsf[32+r32]=l_reg;asm volatile("s_waitcnt lgkmcnt(0)":::"memory");
  float rli[16];
  #pragma unroll
  for(int r=0;r<16;++r)rli[r]=__builtin_amdgcn_rcpf(wsf[32+crow(r,hi)]);
  bf16*Ow=O+(rowbase+q0+wid*QBLK)*DM+vcol;
  { bf16*stg=(bf16*)(shm+XQO)+wid*2048;
    #pragma unroll
    for(int p=0;p<2;++p){
      #pragma unroll
      for(int r=0;r<16;++r){const int orow=crow(r,hi);
        #pragma unroll
        for(int d0=0;d0<2;++d0)stg[orow*64+d0*32+r32]=__float2bfloat16(o[2*p+d0][r]*rli[r]);}
      asm volatile("s_waitcnt lgkmcnt(0)":::"memory");
      #pragma unroll
      for(int i=0;i<4;++i){const int row=i*8+(lane>>3),ch=lane&7; const u32x4 v=*(const u32x4*)(stg+row*64+ch*8); ATTN_STORE16(Ow+(long)row*DM+p*64+ch*8,v);}
      asm volatile("s_waitcnt lgkmcnt(0)":::"memory");
    } }
  asm volatile("s_waitcnt lgkmcnt(0)\n\ts_barrier":::"memory");
  #undef DMA_K
  #undef DMA_V
  #undef QLD
  #undef CMASK
  #undef START
  #undef RESC
  #undef ROT
}
struct StaticOrder128 {
  int vcu, G;
  __device__ __forceinline__ explicit StaticOrder128(int grid,int block):vcu((grid%8==0)?(block%8)*(grid/8)+block/8:block),G(grid){}
  __device__ __forceinline__ bool next(int i,AttnUnit&u)const{
    const int L=(i>>2)*G+vcu; const int j=i&3;
    if(L>=256)return false;
    const int combo=L>>2, s=2*(L&3)+(j>>1); const int b=combo>>4, hc=combo&15, h=hc>>1, c=hc&1;
    u.b=b; u.qkcol=(h*2+c)*64; u.vcol=h*128; u.comp=c; u.qb=(j&1)?15-s:s; return true; }
  __device__ __forceinline__ void a_ready(const AttnUnit&)const{}
  __device__ __forceinline__ void done(const AttnUnit&)const{}
};
template<class Sched,int THRL=8> __device__ __forceinline__ void attn_phase128(char*lds,const AttnTensors&T,const Sched&S){
  AttnUnit u;
  for(int i=0;S.next(i,u);++i){ S.a_ready(u); attn_unit128<THRL>(u.b,u.qkcol,u.vcol,u.qb,T.Q,T.K,T.V,T.O2+(size_t)u.comp*T.o2cs,lds); S.done(u); }
}
constexpr int ATTN128_LDS_BYTES=v128::XBYTES;
#undef SBAR
#undef WAIT_BAR
}
constexpr float SX8 = 8.f, SWG = 256.f, SH8 = 4.f, SWD = 1024.f, SO8 = 64.f;
constexpr float WCLIP6 = 4.f * 0.02209708691f, SWI = 127.f / WCLIP6, DWI = WCLIP6 / 127.f;
constexpr int NWAVES = 8;
constexpr int NPHASE = 17;
constexpr size_t WS_W0IN = 1 * MiB, WS_WPOOL = 17 * MiB, WS_W0OUT = 18 * MiB, WS_WGU = 26 * MiB, WS_WD = 70 * MiB, WS_W1IN = 92 * MiB, WS_W1OUT = 116 * MiB,
                 WS_EGU = 124 * MiB, WS_ED = 572 * MiB;
static_assert(WS_ED + (size_t)NE * DM * EFF * 2 <= WS_XF, "weight copies end below the activation buffers");
static_assert(WS_OS + (size_t)SLOTS * DM * 2 <= WS_PERM && WS_HM + (size_t)SLOTS * EFF * 2 <= WS_OS && WS_CAT + (size_t)M * DM * 2 <= WS_OS && WS_H + (size_t)M * DFF * 2 <= WS_OS, "d_ws map");
constexpr size_t WS_RS = WS_TOK + 1 * MiB, WS_RSG = WS_RS + 1 * MiB;
static_assert(WS_RSG + (size_t)SLOTS * 4 <= 1792 * MiB, "d_ws map");
constexpr size_t WS_XGS = WS_HM + 240 * MiB;
static_assert(WS_XGS + (size_t)NE * M * DM <= WS_PERM && WS_HM + (size_t)SLOTS * EFF <= WS_XGS && WS_RSG + (size_t)NE * M * 4 <= 1792 * MiB, "d_ws map (sparse expert rows)");
constexpr size_t WS_OS1 = WS_HM + 240 * MiB;
static_assert(WS_HM + (size_t)SLOTS * EFF <= WS_OS1 && WS_OS1 + (size_t)SLOTS * DM * 2 <= WS_OS, "d_ws map (fp8 MoE)");
constexpr int CW_WRDY = 2112;
constexpr int CW_P3DONE = 2048;
constexpr int CW_BAR = 4096;
constexpr int RING_OFF = 0, RING_BYTES = 131072;
constexpr int LDSCTL_OFF = RING_BYTES, MISC_OFF = LDSCTL_OFF + 320;
constexpr int LDS_BYTES = 147456;

#define GAS __attribute__((address_space(1)))
#define LAS __attribute__((address_space(3)))
typedef unsigned v4u __attribute__((ext_vector_type(4)));
typedef GAS unsigned gu32;
#define RLX_AGENT __ATOMIC_RELAXED, __HIP_MEMORY_SCOPE_AGENT
#define LDS_WAIT() asm volatile("s_waitcnt lgkmcnt(0)" ::: "memory")
#define VM_WAIT() asm volatile("s_waitcnt vmcnt(0)" ::: "memory")
__device__ __forceinline__ unsigned pk2(float lo, float hi) { return (unsigned)f2bf(lo) | ((unsigned)f2bf(hi) << 16); }
__device__ __forceinline__ float bflo(unsigned w) { return __uint_as_float(w << 16); }
__device__ __forceinline__ float bfhi(unsigned w) { return __uint_as_float(w & 0xffff0000u); }

#define XB_TMO      128
#define XB_XCNT(j)  (256  + 64 * (j))
#define XB_XSUB(j)  (1280 + 64 * (j))
#define XB_XGEN(j)  (2304 + 64 * (j))
#define XB_TOP      3328
#define XB_TOPGEN   3392
#define XCD_BAR_WORDS 3456
#define XB_SPIN_CAP (1u << 18)

__device__ __forceinline__ unsigned xb_ld(unsigned* p)              { return __hip_atomic_load(p, __ATOMIC_RELAXED, __HIP_MEMORY_SCOPE_AGENT); }
__device__ __forceinline__ unsigned xb_add(unsigned* p, unsigned v) { return __hip_atomic_fetch_add(p, v, __ATOMIC_RELAXED, __HIP_MEMORY_SCOPE_AGENT); }
__device__ __forceinline__ unsigned xb_xcc_id() { return (unsigned)__builtin_amdgcn_s_getreg((3 << 11) | 20) & 0xFu; }
#define XB_SPIN(cond, bar) do { unsigned _sp = 0; while (cond) { __builtin_amdgcn_s_sleep(1); \
    if ((++_sp & 255u) == 0u) { if (xb_ld(&(bar)[XB_TMO])) break; if (_sp > XB_SPIN_CAP) { atomicAdd(&(bar)[XB_TMO], 1u); break; } } } } while (0)

struct XcdBarrier {
    unsigned* bar; unsigned x; unsigned expect;
    volatile LAS unsigned* st;
};

__device__ __forceinline__ XcdBarrier xcd_barrier_post(unsigned* bar, volatile LAS unsigned* st, unsigned expect = 0u) {
    XcdBarrier b; b.bar = bar; b.x = xb_xcc_id(); b.st = st; b.expect = expect;
    if (threadIdx.x == 0) (void)xb_add(&bar[XB_XCNT(b.x)], 1u);
    return b;
}
__device__ __forceinline__ void xcd_barrier_complete(unsigned* bar, unsigned x, unsigned& nloc, unsigned& nx, unsigned expect) {
    const unsigned G = expect ? expect : gridDim.x * gridDim.y * gridDim.z;
    unsigned sum, cnt, mine, sp = 0u;
    for (;;) {
        sum = 0u; cnt = 0u; mine = 0u;
#pragma unroll
        for (unsigned j = 0; j < 16; ++j) { const unsigned c = xb_ld(&bar[XB_XCNT(j)]); sum += c; cnt += (c > 0u) ? 1u : 0u; mine = (j == x) ? c : mine; }
        if (sum == G) break;
        __builtin_amdgcn_s_sleep(1);
        if ((++sp & 255u) == 0u) { if (xb_ld(&bar[XB_TMO])) break; if (sp > XB_SPIN_CAP) { atomicAdd(&bar[XB_TMO], 1u); break; } }
    }
    nloc = mine > 0u ? mine : 1u; nx = cnt > 0u ? cnt : 1u;
}

__device__ __forceinline__ void xcd_barrier(const XcdBarrier& b) {
    asm volatile("s_waitcnt vmcnt(0)" ::: "memory");
    __syncthreads();
    if (threadIdx.x == 0) {
        unsigned* bar = b.bar;
        __builtin_amdgcn_s_waitcnt(0);
        unsigned nloc = b.st[0], nx = b.st[1];
        if (nloc == 0u) { xcd_barrier_complete(bar, b.x, nloc, nx, b.expect); b.st[0] = nloc; b.st[1] = nx; }
        const unsigned old = xb_add(&bar[XB_XSUB(b.x)], 1u);
        const unsigned gen = old / nloc;
        if (old + 1u == (gen + 1u) * nloc) {
            __builtin_amdgcn_fence(__ATOMIC_RELEASE, "agent");
            asm volatile("s_waitcnt vmcnt(0)" ::: "memory");
            const unsigned og = xb_add(&bar[XB_TOP], 1u);
            const unsigned tg = og / nx;
            if (og + 1u == (tg + 1u) * nx) xb_add(&bar[XB_TOPGEN], 1u);
            else XB_SPIN(xb_ld(&bar[XB_TOPGEN]) == tg, bar);
            __builtin_amdgcn_fence(__ATOMIC_ACQUIRE, "agent");
            xb_add(&bar[XB_XGEN(b.x)], 1u);
            asm volatile("s_waitcnt vmcnt(0)" ::: "memory");
        } else {
            XB_SPIN(xb_ld(&bar[XB_XGEN(b.x)]) == gen, bar);
            __builtin_amdgcn_fence(__ATOMIC_ACQUIRE, "agent");
            asm volatile("s_waitcnt vmcnt(0)" ::: "memory");
        }
    }
    __syncthreads();
}

__device__ __forceinline__ float wave_max(float v) {
#pragma unroll
    for (int o = 1; o < 64; o <<= 1) v = fmaxf(v, __shfl_xor(v, o));
    return v;
}
__device__ __forceinline__ void quant_row_i8(const f32x4 (&v)[8], unsigned char* q, float* rs, int lane, unsigned char* q2 = nullptr, float* rs2 = nullptr) {
    float m = 0.f;
#pragma unroll
    for (int j = 0; j < 8; ++j) m = fmaxf(fmaxf(m, fmaxf(fabsf(v[j][0]), fabsf(v[j][1]))), fmaxf(fabsf(v[j][2]), fabsf(v[j][3])));
    m = wave_max(m);
    const float sc = m > 0.f ? m * (1.f / 127.f) : 1.f, inv = 1.f / sc;
#pragma unroll
    for (int j = 0; j < 8; ++j) { const unsigned w = pg8::pk4_i8(v[j][0] * inv, v[j][1] * inv, v[j][2] * inv, v[j][3] * inv); *(unsigned*)(q + j * 256 + lane * 4) = w; if (q2) *(unsigned*)(q2 + j * 256 + lane * 4) = w; }
    if (lane == 0) { *rs = sc; if (rs2) *rs2 = sc; }
}
struct P0Item { const float* W; unsigned char* WT; int ldw, k0, csrc, ldt, drow, mode; float sc; };
__device__ __forceinline__ int il_row(int n) { return ((n >> 7) << 8) + (n & 127); }
constexpr int I_W0IN = (DM / 128) * (4096 / 32), I_POOL1 = (PG / 128) * (PG / 32), I_POOL = NPG * I_POOL1, I_SQ = (DM / 128) * (DM / 32), I_FF = (DM / 128) * (DFF / 32), I_WD = (DFF / 128) * (DM / 32),
              I_W1IN = (DM / 128) * (3 * DM / 32), I_EG1 = (DM / 128) * (EFF / 32), I_ED1 = (EFF / 128) * (DM / 32);
constexpr int P0_NITEMS = I_W0IN + I_POOL + I_SQ + 2 * I_FF + I_WD + I_W1IN + I_SQ + 2 * NE * I_EG1 + NE * I_ED1;
constexpr int P0_LATE = 16384, P0_EARLY = P0_NITEMS - P0_LATE;
constexpr int P0_DENSE_END = P0_NITEMS - (2 * NE * I_EG1 + NE * I_ED1);
constexpr int P0_FIRST = I_W0IN, P0_MID = P0_FIRST + (P0_EARLY - P0_FIRST) / 2;
static_assert(P0_LATE <= NE * I_ED1, "late items are expert down-projection items only");
__device__ __forceinline__ bool p0_decode(int it, P0Item& d, const float* const* in, unsigned char* ws, int it_hi = P0_NITEMS) {
    if (it >= it_hi) return false;
    int r = it;
#define P0_SET(W_, ldw_, kb_, c_, WT_, ldt_, drow_, mode_, sc_) do { d.W = (W_); d.ldw = (ldw_); d.k0 = 128 * (kb_); d.csrc = (c_); d.WT = (unsigned char*)(WT_); d.ldt = (ldt_); d.drow = (drow_); d.mode = (mode_); d.sc = (sc_); return true; } while (0)
    if (r < I_W0IN) { const int kb = r / 128, nb = r % 128; P0_SET(in[1], 4096, kb, 32 * nb, ws + WS_W0IN, DM, 32 * nb, 2, SWI); } r -= I_W0IN;
    if (r < I_POOL) { const int g = r / I_POOL1, q = r % I_POOL1, kb = q / 8, nb = q % 8; P0_SET(in[2] + (size_t)g * PG * PG, PG, kb, 32 * nb, ws + WS_WPOOL + (size_t)g * PG * PG * 2, PG, 32 * nb, 0, 1.f); } r -= I_POOL;
    if (r < I_SQ) { const int kb = r / 64, nb = r % 64; P0_SET(in[9], DM, kb, 32 * nb, ws + WS_W0OUT, DM, 32 * nb, 2, 2.f * SWI); } r -= I_SQ;
    if (r < I_FF) { const int kb = r / 176, nb = r % 176; P0_SET(in[12], DFF, kb, 32 * nb, ws + WS_WGU, DM, il_row(32 * nb), 2, SWI); } r -= I_FF;
    if (r < I_FF) { const int kb = r / 176, nb = r % 176; P0_SET(in[13], DFF, kb, 32 * nb, ws + WS_WGU, DM, il_row(32 * nb) + 128, 2, SWI); } r -= I_FF;
    if (r < I_WD) { const int kb = r / 64, nb = r % 64; P0_SET(in[14], DM, kb, 32 * nb, ws + WS_WD, DFF, 32 * nb, 1, SWD); } r -= I_WD;
    if (r < I_W1IN) { const int kb = r / 192, nb = r % 192, n0 = 32 * nb, seg = n0 >> 11, nn = n0 & 2047;
        const int drow = seg == 0 ? 4096 + nn : il_row(nn) + (seg == 2 ? 128 : 0);
        P0_SET(in[17], 3 * DM, kb, n0, ws + WS_W1IN, DM, drow, 2, SWI); } r -= I_W1IN;
    if (r < I_SQ) { const int kb = r / 64, nb = r % 64; P0_SET(in[19], DM, kb, 32 * nb, ws + WS_W1OUT, DM, 32 * nb, 0, 1.f); } r -= I_SQ;
    if (r < NE * I_EG1) { const int e = r / I_EG1, q = r % I_EG1, kb = q / 224, nb = q % 224; P0_SET(in[23] + (size_t)e * DM * EFF, EFF, kb, 32 * nb, ws + WS_EGU + (size_t)e * 2 * EFF * DM, DM, il_row(32 * nb), 2, SWI); } r -= NE * I_EG1;
    if (r < NE * I_EG1) { const int e = r / I_EG1, q = r % I_EG1, kb = q / 224, nb = q % 224; P0_SET(in[24] + (size_t)e * DM * EFF, EFF, kb, 32 * nb, ws + WS_EGU + (size_t)e * 2 * EFF * DM, DM, il_row(32 * nb) + 128, 2, SWI); } r -= NE * I_EG1;
    { const int e = r / I_ED1, q = r % I_ED1, kb = q / 64, nb = q % 64; P0_SET(in[25] + (size_t)e * EFF * DM, DM, kb, 32 * nb, ws + WS_ED + (size_t)e * DM * EFF, EFF, 32 * nb, 1, SWD); }
#undef P0_SET
}
__device__ __forceinline__ void p0_load(const P0Item& d, f32x4 (&v)[16], int lane) {
    const int rg = lane >> 3, c4 = (lane & 7) * 4; const float* p = d.W + (size_t)(d.k0 + 16 * rg) * d.ldw + d.csrc + c4;
#pragma unroll
    for (int i = 0; i < 16; ++i) v[i] = __builtin_nontemporal_load((const GAS f32x4*)(p + (size_t)i * d.ldw));
}
__device__ __forceinline__ void p0_emit(const P0Item& d, const f32x4 (&v)[16], LAS float*, int lane) {
    const int rg = lane >> 3, c4 = (lane & 7) * 4; const float sc = d.sc;
#pragma unroll
    for (int c = 0; c < 4; ++c) {
        const size_t o = (size_t)(d.drow + c4 + c) * d.ldt + d.k0 + 16 * rg;
        if (d.mode == 0) { v4u w0, w1; w0.x = pk2(v[0][c], v[1][c]); w0.y = pk2(v[2][c], v[3][c]); w0.z = pk2(v[4][c], v[5][c]); w0.w = pk2(v[6][c], v[7][c]);
            w1.x = pk2(v[8][c], v[9][c]); w1.y = pk2(v[10][c], v[11][c]); w1.z = pk2(v[12][c], v[13][c]); w1.w = pk2(v[14][c], v[15][c]);
            __builtin_nontemporal_store(w0, (GAS v4u*)((bf16*)d.WT + o)); __builtin_nontemporal_store(w1, (GAS v4u*)((bf16*)d.WT + o + 8)); }
        else if (d.mode == 2) { v4u w; w.x = pg8::pk4_i8(v[0][c] * sc, v[1][c] * sc, v[2][c] * sc, v[3][c] * sc); w.y = pg8::pk4_i8(v[4][c] * sc, v[5][c] * sc, v[6][c] * sc, v[7][c] * sc);
            w.z = pg8::pk4_i8(v[8][c] * sc, v[9][c] * sc, v[10][c] * sc, v[11][c] * sc); w.w = pg8::pk4_i8(v[12][c] * sc, v[13][c] * sc, v[14][c] * sc, v[15][c] * sc); __builtin_nontemporal_store(w, (GAS v4u*)(d.WT + o)); }
        else { v4u w; w.x = pg8::pk4_fp8(v[0][c] * sc, v[1][c] * sc, v[2][c] * sc, v[3][c] * sc); w.y = pg8::pk4_fp8(v[4][c] * sc, v[5][c] * sc, v[6][c] * sc, v[7][c] * sc);
            w.z = pg8::pk4_fp8(v[8][c] * sc, v[9][c] * sc, v[10][c] * sc, v[11][c] * sc); w.w = pg8::pk4_fp8(v[12][c] * sc, v[13][c] * sc, v[14][c] * sc, v[15][c] * sc); __builtin_nontemporal_store(w, (GAS v4u*)(d.WT + o)); }
    }
}
__device__ __forceinline__ void p0_range(const float* const* in, unsigned char* ws, int lo, int hi, int widx, int nw, int lane) {
    P0Item d0, d1, d2; f32x4 v0[16], v1[16], v2[16];
    int it = lo + widx; bool h0 = p0_decode(it, d0, in, ws, hi), h1 = false, h2 = false;
    if (h0) p0_load(d0, v0, lane);
    it += nw; h1 = p0_decode(it, d1, in, ws, hi); if (h1) p0_load(d1, v1, lane);
    while (h0) {
        it += nw; h2 = p0_decode(it, d2, in, ws, hi); if (h2) p0_load(d2, v2, lane);
        p0_emit(d0, v0, nullptr, lane);
        if (!h1) break;
        it += nw; h0 = p0_decode(it, d0, in, ws, hi); if (h0) p0_load(d0, v0, lane);
        p0_emit(d1, v1, nullptr, lane);
        if (!h2) break;
        it += nw; h1 = p0_decode(it, d1, in, ws, hi); if (h1) p0_load(d1, v1, lane);
        p0_emit(d2, v2, nullptr, lane);
    }
}
__device__ __forceinline__ void p0_prologue(const float* const* in, unsigned char* ws, LAS unsigned char* lds, int gw, int NGW, int wave, int lane) {
    p0_range(in, ws, 0, P0_FIRST, gw, NGW, lane);
    const float* x = in[0]; unsigned char* XI8 = ws + WS_XBF; float* RS = (float*)(ws + WS_RS);
    f32x4 va[8], vb[8]; int row = gw;
    if (row < M) {
#pragma unroll
        for (int j = 0; j < 8; ++j) va[j] = *(const f32x4*)(x + (size_t)row * DM + j * 256 + lane * 4); }
    while (row < M) {
        const int r2 = row + NGW;
        if (r2 < M) {
#pragma unroll
            for (int j = 0; j < 8; ++j) vb[j] = *(const f32x4*)(x + (size_t)r2 * DM + j * 256 + lane * 4); }
        __builtin_amdgcn_sched_barrier(0);
        quant_row_i8(va, XI8 + (size_t)row * DM, RS + row, lane);
        if (!(r2 < M)) break;
        const int r3 = r2 + NGW;
        if (r3 < M) {
#pragma unroll
            for (int j = 0; j < 8; ++j) va[j] = *(const f32x4*)(x + (size_t)r3 * DM + j * 256 + lane * 4); }
        __builtin_amdgcn_sched_barrier(0);
        quant_row_i8(vb, XI8 + (size_t)r2 * DM, RS + r2, lane);
        row = r3;
    }
}
__device__ __forceinline__ void pooled_ld16(const bf16* p, float (&v)[16]) {
    const v4u a = *(const v4u*)p, b = *(const v4u*)(p + 8);
    v[0] = bflo(a.x); v[1] = bfhi(a.x); v[2] = bflo(a.y); v[3] = bfhi(a.y); v[4] = bflo(a.z); v[5] = bfhi(a.z); v[6] = bflo(a.w); v[7] = bfhi(a.w);
    v[8] = bflo(b.x); v[9] = bfhi(b.x); v[10] = bflo(b.y); v[11] = bfhi(b.y); v[12] = bflo(b.z); v[13] = bfhi(b.z); v[14] = bflo(b.w); v[15] = bfhi(b.w);
}
__device__ __forceinline__ void pooled_rows(const bf16* PU, bf16* PLD, int gw, int NGW, int lane, int rend = M) {
    const int g = lane >> 4, w = 2 << g;
    for (int blk = gw; blk < rend / 8; blk += NGW) {
        const int t0 = blk * 8, pos0 = t0 & (SEQ - 1);
        float acc[16];
#pragma unroll
        for (int i = 0; i < 16; ++i) acc[i] = 0.f;
#pragma unroll
        for (int j = 1; j < 16; ++j) if (j < w && j <= pos0) { float v[16]; pooled_ld16(PU + (size_t)(t0 - j) * PW + lane * 16, v);
#pragma unroll
            for (int i = 0; i < 16; ++i) acc[i] += v[i]; }
#pragma unroll
        for (int r = 0; r < 8; ++r) {
            const int row = t0 + r, pos = pos0 + r, cnt = (pos + 1 < w) ? pos + 1 : w;
            float cur[16]; pooled_ld16(PU + (size_t)row * PW + lane * 16, cur);
#pragma unroll
            for (int i = 0; i < 16; ++i) acc[i] += cur[i];
            if (r > 0 && pos >= w) { float old[16]; pooled_ld16(PU + (size_t)(row - w) * PW + lane * 16, old);
#pragma unroll
                for (int i = 0; i < 16; ++i) acc[i] -= old[i]; }
            const float rc = 1.f / (float)cnt;
            v4u o0, o1;
            o0.x = pk2(acc[0] * rc - cur[0], acc[1] * rc - cur[1]); o0.y = pk2(acc[2] * rc - cur[2], acc[3] * rc - cur[3]); o0.z = pk2(acc[4] * rc - cur[4], acc[5] * rc - cur[5]); o0.w = pk2(acc[6] * rc - cur[6], acc[7] * rc - cur[7]);
            o1.x = pk2(acc[8] * rc - cur[8], acc[9] * rc - cur[9]); o1.y = pk2(acc[10] * rc - cur[10], acc[11] * rc - cur[11]); o1.z = pk2(acc[12] * rc - cur[12], acc[13] * rc - cur[13]); o1.w = pk2(acc[14] * rc - cur[14], acc[15] * rc - cur[15]);
            *(v4u*)(PLD + (size_t)row * PW + lane * 16) = o0; *(v4u*)(PLD + (size_t)row * PW + lane * 16 + 8) = o1;
        }
    }
}
__device__ __forceinline__ void combine_rows_q(const bf16* O2, const bf16* CAT, unsigned char* CATQ, float* RS, const float* q1, const float* k1, const float* q2, const float* k2, const float* subg, int gw, int NGW, int lane, int rend = M, size_t o2cs = (size_t)M * AW) {
    const float lam = lambda_full(q1, k1, q2, k2, lane);
    const int cg = (lane & 7) * 16;
    float gg[16];
#pragma unroll
    for (int i = 0; i < 16; ++i) gg[i] = subg[cg + i] * (1.f - LAM_INIT0);
    for (int row = gw; row < rend; row += NGW) {
        const bf16* p1 = O2 + (size_t)row * AW + lane * 16; const bf16* p2 = p1 + o2cs; const bf16* pa = CAT + (size_t)row * DM + lane * 16;
        const v4u a0 = *(const v4u*)p1, a1 = *(const v4u*)(p1 + 8), b0 = *(const v4u*)p2, b1 = *(const v4u*)(p2 + 8), c0 = *(const v4u*)pa, c1 = *(const v4u*)(pa + 8);
        const float x[16] = {bflo(a0.x), bfhi(a0.x), bflo(a0.y), bfhi(a0.y), bflo(a0.z), bfhi(a0.z), bflo(a0.w), bfhi(a0.w), bflo(a1.x), bfhi(a1.x), bflo(a1.y), bfhi(a1.y), bflo(a1.z), bfhi(a1.z), bflo(a1.w), bfhi(a1.w)};
        const float y[16] = {bflo(b0.x), bfhi(b0.x), bflo(b0.y), bfhi(b0.y), bflo(b0.z), bfhi(b0.z), bflo(b0.w), bfhi(b0.w), bflo(b1.x), bfhi(b1.x), bflo(b1.y), bfhi(b1.y), bflo(b1.z), bfhi(b1.z), bflo(b1.w), bfhi(b1.w)};
        const float pa_[16] = {bflo(c0.x), bfhi(c0.x), bflo(c0.y), bfhi(c0.y), bflo(c0.z), bfhi(c0.z), bflo(c0.w), bfhi(c0.w), bflo(c1.x), bfhi(c1.x), bflo(c1.y), bfhi(c1.y), bflo(c1.z), bfhi(c1.z), bflo(c1.w), bfhi(c1.w)};
        float o[16], ss = 0.f;
#pragma unroll
        for (int i = 0; i < 16; ++i) { o[i] = x[i] - lam * y[i]; ss += o[i] * o[i]; }
        ss += __shfl_xor(ss, 1); ss += __shfl_xor(ss, 2); ss += __shfl_xor(ss, 4);
        const float r = 1.f / sqrtf(ss * (1.f / 128.f) + RMS_EPS);
        float m = 0.f;
#pragma unroll
        for (int i = 0; i < 16; ++i) { o[i] = o[i] * r * gg[i]; m = fmaxf(m, fmaxf(fabsf(o[i]), fabsf(pa_[i]))); }
        m = wave_max(m);
        const float sc = m > 0.f ? m * (1.f / 127.f) : 1.f, inv = 1.f / sc;
        v4u wa, wo;
        wa.x = pg8::pk4_i8(pa_[0] * inv, pa_[1] * inv, pa_[2] * inv, pa_[3] * inv); wa.y = pg8::pk4_i8(pa_[4] * inv, pa_[5] * inv, pa_[6] * inv, pa_[7] * inv);
        wa.z = pg8::pk4_i8(pa_[8] * inv, pa_[9] * inv, pa_[10] * inv, pa_[11] * inv); wa.w = pg8::pk4_i8(pa_[12] * inv, pa_[13] * inv, pa_[14] * inv, pa_[15] * inv);
        wo.x = pg8::pk4_i8(o[0] * inv, o[1] * inv, o[2] * inv, o[3] * inv); wo.y = pg8::pk4_i8(o[4] * inv, o[5] * inv, o[6] * inv, o[7] * inv);
        wo.z = pg8::pk4_i8(o[8] * inv, o[9] * inv, o[10] * inv, o[11] * inv); wo.w = pg8::pk4_i8(o[12] * inv, o[13] * inv, o[14] * inv, o[15] * inv);
        unsigned char* d = CATQ + (size_t)row * DM + lane * 16; *(v4u*)d = wa; *(v4u*)(d + PW) = wo;
        if (lane == 0) RS[row] = sc;
    }
}
__device__ __forceinline__ unsigned pk4_fp8_(float a, float b, float c, float d) { return pg8::pk4_fp8(a, b, c, d); }
__device__ __forceinline__ void ln_rows(const bf16* Y, const float* g, const float* b, float* XF, bf16* XBF, int gw, int NGW, int lane) {
    for (int row = gw; row < M; row += NGW) { f32x4 v[8]; ln_row(nullptr, g, b, XF + (size_t)row * DM, XBF + (size_t)row * DM, lane, v, nullptr, 1.f, Y + (size_t)row * DM); }
}
__device__ __forceinline__ void row_load_bf16(const bf16* y, int lane, unsigned long long (&raw)[8]) {
#pragma unroll
    for (int j = 0; j < 8; ++j) raw[j] = __builtin_nontemporal_load((const unsigned long long*)(y + j * 256 + lane * 4));
}
__device__ __forceinline__ void ln_row_raw(const unsigned long long (&raw)[8], const f32x4 (&gg)[8], const f32x4 (&bb)[8], bf16* xf, int lane, f32x4 (&v)[8]) {
    float s = 0.f;
#pragma unroll
    for (int j = 0; j < 8; ++j) { const unsigned long long w = raw[j]; v[j] = (f32x4){__uint_as_float((unsigned)w << 16), __uint_as_float((unsigned)w & 0xffff0000u), __uint_as_float((unsigned)(w >> 32) << 16), __uint_as_float((unsigned)(w >> 32) & 0xffff0000u)};
        s += (v[j][0] + v[j][1]) + (v[j][2] + v[j][3]); }
    const float mean = wave_sum(s) * (1.f / DM); float s2 = 0.f;
#pragma unroll
    for (int j = 0; j < 8; ++j) { v[j] = v[j] - mean; s2 += (v[j][0] * v[j][0] + v[j][1] * v[j][1]) + (v[j][2] * v[j][2] + v[j][3] * v[j][3]); }
    const float rstd = 1.f / sqrtf(wave_sum(s2) * (1.f / DM) + LN_EPS);
#pragma unroll
    for (int j = 0; j < 8; ++j) { v[j] = v[j] * rstd * gg[j] + bb[j];
        const unsigned long long w = (unsigned long long)f2bf(v[j][0]) | ((unsigned long long)f2bf(v[j][1]) << 16) | ((unsigned long long)f2bf(v[j][2]) << 32) | ((unsigned long long)f2bf(v[j][3]) << 48);
        *(unsigned long long*)(xf + j * 256 + lane * 4) = w; }
}
__device__ __forceinline__ void ln_rows_q(const bf16* Y, const float* g, const float* b, bf16* XF, unsigned char* XI8, float* RS, int gw, int NGW, int lane, int rend = M) {
    f32x4 gg[8], bb[8];
#pragma unroll
    for (int j = 0; j < 8; ++j) { gg[j] = *(const f32x4*)(g + j * 256 + lane * 4); bb[j] = *(const f32x4*)(b + j * 256 + lane * 4); }
    unsigned long long cur[8], nxt[8];
    int row = gw; if (row < rend) row_load_bf16(Y + (size_t)row * DM, lane, cur);
    for (; row < rend; row += NGW) {
        const int nr = row + NGW; if (nr < rend) row_load_bf16(Y + (size_t)nr * DM, lane, nxt);
        __builtin_amdgcn_sched_barrier(0);
        f32x4 v[8]; ln_row_raw(cur, gg, bb, XF + (size_t)row * DM, lane, v);
        quant_row_i8(v, XI8 + (size_t)row * DM, RS + row, lane);
#pragma unroll
        for (int j = 0; j < 8; ++j) cur[j] = nxt[j];
    }
}
__device__ __forceinline__ void ln_rows8(const bf16* Y, const float* g, const float* b, float* XF, unsigned char* X8, float s8, int gw, int NGW, int lane) {
    for (int row = gw; row < M; row += NGW) { f32x4 v[8]; ln_row(nullptr, g, b, XF + (size_t)row * DM, nullptr, lane, v, X8 + (size_t)row * DM, s8, Y + (size_t)row * DM); }
}
__device__ __forceinline__ void conv_rows(const bf16* BG, const bf16* Z, const float* cw, bf16* V1, int gw, int NGW, int lane, int rend = M) {
    for (int row = gw; row < rend; row += NGW) {
        const int pos = row & (SEQ - 1);
#pragma unroll
        for (int q = 0; q < 4; ++q) {
            const int c0 = q * 512 + lane * 8; const size_t o = (size_t)row * DM + c0;
            const v4u z0 = *(const v4u*)(Z + o), bg = *(const v4u*)(BG + o);
            v4u z1 = (v4u){0u, 0u, 0u, 0u}, z2 = (v4u){0u, 0u, 0u, 0u};
            if (pos >= 1) z1 = *(const v4u*)(Z + o - DM);
            if (pos >= 2) z2 = *(const v4u*)(Z + o - 2 * DM);
            const f32x4 w0a = *(const f32x4*)(cw + c0), w0b = *(const f32x4*)(cw + c0 + 4), w1a = *(const f32x4*)(cw + DM + c0), w1b = *(const f32x4*)(cw + DM + c0 + 4),
                        w2a = *(const f32x4*)(cw + 2 * DM + c0), w2b = *(const f32x4*)(cw + 2 * DM + c0 + 4);
            const float zz0[8] = {bflo(z0.x), bfhi(z0.x), bflo(z0.y), bfhi(z0.y), bflo(z0.z), bfhi(z0.z), bflo(z0.w), bfhi(z0.w)};
            const float zz1[8] = {bflo(z1.x), bfhi(z1.x), bflo(z1.y), bfhi(z1.y), bflo(z1.z), bfhi(z1.z), bflo(z1.w), bfhi(z1.w)};
            const float zz2[8] = {bflo(z2.x), bfhi(z2.x), bflo(z2.y), bfhi(z2.y), bflo(z2.z), bfhi(z2.z), bflo(z2.w), bfhi(z2.w)};
            const float bb[8] = {bflo(bg.x), bfhi(bg.x), bflo(bg.y), bfhi(bg.y), bflo(bg.z), bfhi(bg.z), bflo(bg.w), bfhi(bg.w)};
            const float k0[8] = {w0a[0], w0a[1], w0a[2], w0a[3], w0b[0], w0b[1], w0b[2], w0b[3]}, k1[8] = {w1a[0], w1a[1], w1a[2], w1a[3], w1b[0], w1b[1], w1b[2], w1b[3]},
                        k2[8] = {w2a[0], w2a[1], w2a[2], w2a[3], w2b[0], w2b[1], w2b[2], w2b[3]};
            float y[8];
#pragma unroll
            for (int i = 0; i < 8; ++i) y[i] = bb[i] * (k0[i] * zz2[i] + k1[i] * zz1[i] + k2[i] * zz0[i]);
            v4u w; w.x = pk2(y[0], y[1]); w.y = pk2(y[2], y[3]); w.z = pk2(y[4], y[5]); w.w = pk2(y[6], y[7]);
            *(v4u*)(V1 + o) = w;
        }
    }
}
__device__ __forceinline__ void ln_route_rows(const bf16* Y, const float* g, const float* b, bf16* XF, unsigned char* XGS, float* RSGS, const float* wr, unsigned* cnt, int* tok, int gw, int NGW, int lane, LAS float* wl, const float* const* in, unsigned char* ws, int rend = M, int cgw = -1, int cngw = 0) {
    for (int i = threadIdx.x; i < DM * NE; i += NWAVES * 64) wl[(i & 7) * DM + (i >> 3)] = wr[i];
    __syncthreads();
    f32x4 gg[8], bb[8];
#pragma unroll
    for (int j = 0; j < 8; ++j) { gg[j] = *(const f32x4*)(g + j * 256 + lane * 4); bb[j] = *(const f32x4*)(b + j * 256 + lane * 4); }
    unsigned long long cur[8], nxt[8];
    int row = gw; if (row < rend) row_load_bf16(Y + (size_t)row * DM, lane, cur);
    if (cgw < 0) { cgw = gw; cngw = NGW; }
    int cit = P0_EARLY + cgw;
    for (; row < rend; row += NGW) {
        const int nr = row + NGW; if (nr < rend) row_load_bf16(Y + (size_t)nr * DM, lane, nxt);
        P0Item cd; f32x4 cv[16]; const bool chave = p0_decode(cit, cd, in, ws); if (chave) p0_load(cd, cv, lane); cit += cngw;
        __builtin_amdgcn_sched_barrier(0);
        f32x4 v[8]; ln_row_raw(cur, gg, bb, XF + (size_t)row * DM, lane, v);
        float lg[NE];
#pragma unroll
        for (int e = 0; e < NE; ++e) { float a = 0.f;
#pragma unroll
            for (int j = 0; j < 8; ++j) { const f32x4 w = *(const LAS f32x4*)(wl + e * DM + j * 256 + lane * 4); a += (v[j][0] * w[0] + v[j][1] * w[1]) + (v[j][2] * w[2] + v[j][3] * w[3]); }
            lg[e] = wave_sum(a); }
        int i1 = 0; float v1 = lg[0];
#pragma unroll
        for (int e = 1; e < NE; ++e) if (lg[e] > v1) { v1 = lg[e]; i1 = e; }
        int i2 = -1; float v2 = -3.0e38f;
#pragma unroll
        for (int e = 0; e < NE; ++e) if (e != i1 && lg[e] > v2) { v2 = lg[e]; i2 = e; }
        int p1 = 0, p2 = 0;
        if (lane == 0) {
            const float g1 = 1.f / (1.f + expf(v2 - v1)), g2 = 1.f - g1;
            p1 = (int)__hip_atomic_fetch_add(cnt + 64 * i1, 1u, RLX_AGENT); p2 = (int)__hip_atomic_fetch_add(cnt + 64 * i2, 1u, RLX_AGENT);
            int* t = tok + (size_t)row * 8; t[0] = i1; t[1] = i2; t[2] = p1; t[3] = p2; ((float*)t)[4] = g1; ((float*)t)[5] = g2;
        }
        p1 = __builtin_amdgcn_readfirstlane(p1); p2 = __builtin_amdgcn_readfirstlane(p2);
        const size_t s1 = (size_t)i1 * M + p1, s2 = (size_t)i2 * M + p2;
        quant_row_i8(v, XGS + s1 * DM, RSGS + s1, lane, XGS + s2 * DM, RSGS + s2);
        if (chave) p0_emit(cd, cv, nullptr, lane);
#pragma unroll
        for (int j = 0; j < 8; ++j) cur[j] = nxt[j];
    }
    for (; cit < P0_NITEMS; cit += cngw) { P0Item cd; f32x4 cv[16]; if (p0_decode(cit, cd, in, ws)) { p0_load(cd, cv, lane); p0_emit(cd, cv, nullptr, lane); } }
}
__device__ __forceinline__ void gather_rows(const float* XF, unsigned char* XG8, float* RSG, const int* perm, const unsigned* cnt, int gw, int NGW, int lane) {
    int base = 0;
    for (int e = 0; e < NE; ++e) {
        const int n = (int)cnt[64 * e], nt = (n + 255) >> 8;
        for (int pos = gw; pos < nt * 256; pos += NGW) {
            const int tk = pos < n ? perm[e * M + pos] : 0; const size_t slot = (size_t)base * 256 + pos;
            f32x4 v[8];
#pragma unroll
            for (int j = 0; j < 8; ++j) v[j] = *(const f32x4*)(XF + (size_t)tk * DM + j * 256 + lane * 4);
            quant_row_i8(v, XG8 + slot * DM, RSG + slot, lane);
        }
        base += nt;
    }
}
typedef float f32x2_ __attribute__((ext_vector_type(2)));
template <int KS> __device__ __forceinline__ void final_rows(const bf16* XF, const unsigned char* OS, long ks_stride, float os_inv, const int* tok, const unsigned* cnt, const float* g, const float* b, float* out, int gw, int NGW, int lane) {
    int tb[NE + 1]; { int base = 0;
#pragma unroll
        for (int e = 0; e < NE; ++e) { tb[e] = base; base += ((int)cnt[64 * e] + 255) >> 8; } tb[NE] = base; }
    for (int row = gw; row < M; row += NGW) {
        const int* t = tok + (size_t)row * 8; const int e0 = t[0], e1 = t[1], p0 = t[2], p1 = t[3]; const float g0 = ((const float*)t)[4], g1 = ((const float*)t)[5];
        int b0 = 0, b1 = 0;
#pragma unroll
        for (int e = 0; e < NE; ++e) { if (e == e0) b0 = tb[e]; if (e == e1) b1 = tb[e]; }
        const unsigned char* r0 = OS + ((size_t)b0 * 256 + p0) * DM; const unsigned char* r1 = OS + ((size_t)b1 * 256 + p1) * DM; const float h0 = g0 * os_inv, h1 = g1 * os_inv;
        f32x4 v[8]; float s = 0.f;
#pragma unroll
        for (int j = 0; j < 8; ++j) { const unsigned long long xw = *(const unsigned long long*)(XF + (size_t)row * DM + j * 256 + lane * 4);
            const f32x4 x = (f32x4){bflo((unsigned)xw), bfhi((unsigned)xw), bflo((unsigned)(xw >> 32)), bfhi((unsigned)(xw >> 32))};
            f32x4 m0 = (f32x4){0.f, 0.f, 0.f, 0.f}, m1 = m0;
#pragma unroll
            for (int ks = 0; ks < KS; ++ks) { const int a = *(const int*)(r0 + (long)ks * ks_stride + j * 256 + lane * 4), c = *(const int*)(r1 + (long)ks * ks_stride + j * 256 + lane * 4);
                const f32x2_ a0 = __builtin_amdgcn_cvt_pk_f32_fp8(a, false), a1 = __builtin_amdgcn_cvt_pk_f32_fp8(a, true), c0 = __builtin_amdgcn_cvt_pk_f32_fp8(c, false), c1 = __builtin_amdgcn_cvt_pk_f32_fp8(c, true);
                m0 += (f32x4){a0[0], a0[1], a1[0], a1[1]}; m1 += (f32x4){c0[0], c0[1], c1[0], c1[1]}; }
            v[j] = x * ALPHA + m0 * h0 + m1 * h1;
            s += (v[j][0] + v[j][1]) + (v[j][2] + v[j][3]); }
        const float mean = wave_sum(s) * (1.f / DM); float s2 = 0.f;
#pragma unroll
        for (int j = 0; j < 8; ++j) { v[j] = v[j] - mean; s2 += (v[j][0] * v[j][0] + v[j][1] * v[j][1]) + (v[j][2] * v[j][2] + v[j][3] * v[j][3]); }
        const float rstd = 1.f / sqrtf(wave_sum(s2) * (1.f / DM) + LN_EPS);
#pragma unroll
        for (int j = 0; j < 8; ++j) { const f32x4 gg = *(const f32x4*)(g + j * 256 + lane * 4), bb = *(const f32x4*)(b + j * 256 + lane * 4);
            *(f32x4*)(out + (size_t)row * DM + j * 256 + lane * 4) = v[j] * rstd * gg + bb; }
    }
}

#ifndef MOE_KS
#define MOE_KS 2
#endif
struct Args { const float* in[28]; float* out; unsigned char* ws; int ph_lo, ph_hi, li, pad; };
__global__ void __launch_bounds__(NWAVES * 64, 2) mk_fwd(Args args) {
    extern __shared__ __attribute__((aligned(16))) unsigned char lds[];
    LAS unsigned char* L = (LAS unsigned char*)lds;
    volatile LAS unsigned* MISC = (volatile LAS unsigned*)(L + MISC_OFF);
    const int tid = threadIdx.x, wave = __builtin_amdgcn_readfirstlane(tid >> 6);
#define lane ({ int l_ = (int)threadIdx.x; asm volatile("" : "+v"(l_)); l_ & 63; })
    const int G = gridDim.x; const int bx = blockIdx.x; const int vcu = (G % 8 == 0) ? (bx % 8) * (G / 8) + bx / 8 : bx;
    const int gw = vcu * NWAVES + wave, NGW = G * NWAVES;
    unsigned char* ws = args.ws;
    gu32* ctl = (gu32*)(ws + WS_CTL);
    for (int u = tid; u < (LDS_BYTES - LDSCTL_OFF) / 4; u += NWAVES * 64) ((LAS unsigned*)(L + LDSCTL_OFF))[u] = 0u;
    __syncthreads();
    XcdBarrier bar = xcd_barrier_post((unsigned*)(ctl + CW_BAR) + args.li * XCD_BAR_WORDS, MISC + 8);
    const bool two = (G == 256); const int hh = (two && vcu >= G / 2) ? 1 : 0;
    const int r0 = two ? hh * (M / 2) : 0, rend = two ? r0 + M / 2 : M, gwl = two ? gw - hh * (NGW / 2) : gw, NGWL = two ? NGW / 2 : NGW;
    XcdBarrier barh = xcd_barrier_post((unsigned*)(ctl + CW_BAR) + (2 + 2 * args.li + hh) * XCD_BAR_WORDS, MISC + 12, two ? (unsigned)(G / 2) : 0u);
    const int lo = args.ph_lo, hi = args.ph_hi;
#define IN(k) (lo <= (k) && (k) < hi)
#ifndef PROBE_DUP
#define PROBE_DUP -1
#endif
#define REP(k) _Pragma("unroll") for (int rep_ = 0; rep_ < ((PROBE_DUP == (k)) ? 2 : 1); ++rep_)
#define SEAM(k) do { if (IN(k) && IN((k) + 1)) xcd_barrier(bar); } while (0)
#define SEAMH(k) do { if (IN(k) && IN((k) + 1)) xcd_barrier(barh); } while (0)
    const float* const* in; { const void* kp_ = (const void*)__builtin_amdgcn_kernarg_segment_ptr(); asm volatile("" : "+s"(kp_)); in = (const float* const*)kp_; }
    bf16* XF = (bf16*)(ws + WS_XF); bf16* Y = (bf16*)(ws + WS_Y); bf16* XBF = (bf16*)(ws + WS_XBF);
#define HTP(off_full, off_half, pitch) (two ? ws + WS_HM + (size_t)hh * (144 * MiB) + (size_t)(off_half) * MiB - (size_t)hh * (M / 2) * (size_t)(pitch) : ws + WS_HM + (size_t)(off_full) * MiB)
    bf16 *PU = (bf16*)HTP(0, 0, 2048), *Q = (bf16*)HTP(32, 16, 2048), *K = (bf16*)HTP(64, 32, 2048), *V = (bf16*)HTP(96, 48, 2048), *PLD = (bf16*)HTP(128, 64, 2048), *O2 = (bf16*)HTP(160, 80, 2048), *CAT = (bf16*)HTP(224, 112, 4096);
    bf16 *H = (bf16*)HTP(0, 0, DFF), *BG = (bf16*)HTP(0, 0, 4096), *Z = (bf16*)HTP(64, 32, 4096), *V1 = (bf16*)HTP(128, 64, 4096); unsigned char *OS = ws + WS_OS, *HM8 = ws + WS_HM;
    const size_t qkv_stride = two ? (size_t)(16 * MiB) / 2 : (size_t)(WS_Q - WS_PU) / 2, o2cs = two ? (size_t)(16 * MiB) / 2 : (size_t)M * 1024;
#undef HTP
    constexpr long OS_KS_STRIDE = (long)WS_OS1 - (long)WS_OS;
    int* perm = (int*)(ws + WS_PERM); int* tok = (int*)(ws + WS_TOK); unsigned* cnt = (unsigned*)(ws + WS_CTL) + CW_CNT;
    float* RS = (float*)(ws + WS_RS); float* RSG = (float*)(ws + WS_RSG); unsigned char* XGS = ws + WS_XGS;
    constexpr bool AL = true, SP = true;

    if (IN(0)) { REP(0) { p0_prologue(in, ws, L, gw, NGW, wave, lane); } SEAM(0); }
    if (IN(1)) { REP(1) { pg8::Gemm g{XBF, (const bf16*)(ws + WS_W0IN), DM, DM, DM, 0, RS}; pg8::StaticOrder S; S.init(M / 256, 4096 / 256, G, bx);
        pg8::EpiQkv E{PU, qkv_stride, C2, DWI};
        pg8::gemm_phase<pg8::EpiQkv, pg8::StaticOrder, AL, SP, 1, true, true>(L + RING_OFF, g, S, E); } SEAMH(1); }
    if (IN(2)) { REP(2) { pooled_rows(PU, PLD, r0 / 8 + gwl, NGWL, lane, rend);
        const bool split = (G & 15) == 0, grpA = !split || (bx & 4) == 0;
        const int cw = split ? ((((bx >> 3) << 2) | (bx & 3)) * NWAVES + wave) : gw, cn = split ? NGW / 2 : NGW;
        if (grpA) p0_range(in, ws, P0_FIRST, (split && two) ? P0_DENSE_END : split ? P0_MID : P0_EARLY, cw, cn, lane);
        VM_WAIT(); __syncthreads();
        if (two && hh == 0 && tid == 0) { __builtin_amdgcn_fence(__ATOMIC_RELEASE, "agent"); asm volatile("s_waitcnt vmcnt(0)" ::: "memory"); __hip_atomic_fetch_add(ctl + CW_WRDY + 64 * args.li, 1u, RLX_AGENT); }
        if (grpA && split && two) { p0_range(in, ws, P0_DENSE_END, P0_MID, cw, cn, lane); VM_WAIT(); __syncthreads(); }
        const attn_body::AttnTensors AT{(const attn_body::bf16*)Q, (const attn_body::bf16*)K, (const attn_body::bf16*)V, (attn_body::bf16*)O2, o2cs};
        static_assert(attn_body::ATTN128_LDS_BYTES <= RING_BYTES, "attention scratch fits the stage region");
        const attn_body::StaticOrder128 S(G, bx);
        attn_body::attn_phase128<attn_body::StaticOrder128>((char*)lds + RING_OFF, AT, S);
        if (!grpA && !two) p0_range(in, ws, P0_MID, P0_EARLY, cw, cn, lane); } SEAMH(2); }
    if (IN(3)) {
        if (two && hh == 1) { if (tid == 0) { unsigned* tb_ = (unsigned*)(ctl + CW_BAR) + args.li * XCD_BAR_WORDS; XB_SPIN(xb_ld((unsigned*)(ctl + CW_WRDY + 64 * args.li)) < (unsigned)(G / 2), tb_);
                __builtin_amdgcn_fence(__ATOMIC_ACQUIRE, "agent"); asm volatile("s_waitcnt vmcnt(0)" ::: "memory"); } __syncthreads(); }
        REP(3) { pg8::Gemm g{PLD, (const bf16*)(ws + WS_WPOOL), PW, PG, PG, 0, nullptr}; pg8::PoolOrder S; S.init(M / 256, NPG, G, bx);
        pg8::EpiPool E{CAT, in[3], DM, 0};
        pg8::gemm_phase<pg8::EpiPool, pg8::PoolOrder, AL, SP>(L + RING_OFF, g, S, E);
        xcd_barrier(barh);
        combine_rows_q(O2, CAT, (unsigned char*)PLD, RS, in[4], in[5], in[6], in[7], in[8], r0 + gwl, NGWL, lane, rend, o2cs); } SEAMH(3);
        if (two && hh == 1 && tid == 0) __hip_atomic_fetch_add(ctl + CW_P3DONE + 64 * args.li, 1u, RLX_AGENT); }
    if (IN(4)) { REP(4) { pg8::Gemm g{(const bf16*)PLD, (const bf16*)(ws + WS_W0OUT), DM, DM, DM, 0, RS}; pg8::StaticOrder S; S.init(M / 256, DM / 256, G, bx);
        pg8::EpiResid<false> E{Y, in[0], DM, ALPHA, 0.5f * DWI, 0};
        pg8::gemm_phase<pg8::EpiResid<false>, pg8::StaticOrder, AL, SP, 1, true, true>(L + RING_OFF, g, S, E); } SEAMH(4); }
    if (IN(5)) { REP(5) { ln_rows_q(Y, in[10], in[11], XF, (unsigned char*)XBF, RS, r0 + gwl, NGWL, lane, rend); } SEAMH(5); }
    if (IN(6)) { REP(6) { pg8::Gemm g{XBF, (const bf16*)(ws + WS_WGU), DM, DM, DM, 0, RS}; pg8::StaticOrder S; S.init(M / 256, 2 * DFF / 256, G, bx);
        pg8::EpiSwigluF8 E{(unsigned char*)H, DFF, DWI, SH8};
        pg8::gemm_phase<pg8::EpiSwigluF8, pg8::StaticOrder, AL, SP, 1, true, true>(L + RING_OFF, g, S, E); } SEAMH(6); }
    if (IN(7)) { REP(7) { pg8::Gemm g{H, (const bf16*)(ws + WS_WD), DFF, DFF, DFF, 0, nullptr}; pg8::StaticOrder S; S.init(M / 256, DM / 256, G, bx);
        pg8::EpiResid<true> E{Y, XF, DM, ALPHA, 1.f / (SH8 * SWD), 0};
        pg8::gemm_phase<pg8::EpiResid<true>, pg8::StaticOrder, AL, SP, 1>(L + RING_OFF, g, S, E); } SEAMH(7); }
    if (IN(8)) { REP(8) { ln_rows_q(Y, in[15], in[16], XF, (unsigned char*)XBF, RS, r0 + gwl, NGWL, lane, rend); } SEAMH(8); }
    if (IN(9)) { REP(9) { pg8::Gemm g{XBF, (const bf16*)(ws + WS_W1IN), DM, DM, DM, 0, RS}; pg8::StaticOrder S; S.init(M / 256, 3 * DM / 256, G, bx);
        pg8::EpiL1in E{Z, BG, DWI, 0};
        pg8::gemm_phase<pg8::EpiL1in, pg8::StaticOrder, AL, SP, 1, true, true>(L + RING_OFF, g, S, E); } SEAMH(9); }
    if (IN(10)) { REP(10) { conv_rows(BG, Z, in[18], V1, r0 + gwl, NGWL, lane, rend); } SEAMH(10); }
    if (IN(11)) { REP(11) { pg8::Gemm g{V1, (const bf16*)(ws + WS_W1OUT), DM, DM, DM, 0, nullptr}; pg8::StaticOrder S; S.init(M / 256, DM / 256, G, bx);
        pg8::EpiResid<true> E{Y, XF, DM, ALPHA, 1.f, 0};
        pg8::gemm_phase<pg8::EpiResid<true>, pg8::StaticOrder, AL, SP>(L + RING_OFF, g, S, E); } SEAMH(11); }
    if (IN(12)) {
        if (two && hh == 0) { if (tid == 0) { unsigned* tb_ = (unsigned*)(ctl + CW_BAR) + args.li * XCD_BAR_WORDS; XB_SPIN(xb_ld((unsigned*)(ctl + CW_P3DONE + 64 * args.li)) < (unsigned)(G / 2), tb_); } __syncthreads(); }
        ln_route_rows(Y, in[20], in[21], XF, XGS, RSG, in[22], cnt, tok, r0 + gwl, NGWL, lane, (LAS float*)(L + RING_OFF), in, ws, rend, gw, NGW);
        if (two && hh == 1) p0_range(in, ws, P0_MID, P0_EARLY, gwl, NGWL, lane);
        SEAM(12); }
    if (IN(14) || IN(15)) {
        int ts[NE + 1]; { int base = 0;
#pragma unroll
            for (int e = 0; e < NE; ++e) { ts[e] = base; base += (__builtin_amdgcn_readfirstlane((int)cnt[64 * e]) + 255) >> 8; } ts[NE] = base; }
        if (IN(14)) { REP(14) { pg8::Gemm g{(const bf16*)XGS, (const bf16*)(ws + WS_EGU), DM, DM, DM, 0, RSG}; typedef pg8::MoeOrderX<2 * EFF / 256> OrdGU; OrdGU S; S.init(ts[NE], 2 * EFF / 256, G, bx);
            S.ts1 = ts[1]; S.ts2 = ts[2]; S.ts3 = ts[3]; S.ts4 = ts[4]; S.ts5 = ts[5]; S.ts6 = ts[6]; S.ts7 = ts[7];
            pg8::EpiSwigluF8 E{HM8, EFF, DWI, SH8};
            pg8::gemm_phase<pg8::EpiSwigluF8, OrdGU, AL, SP, 1, true, true>(L + RING_OFF, g, S, E); } SEAM(14); }
        if (IN(15)) { REP(15) { pg8::Gemm g{(const bf16*)HM8, (const bf16*)(ws + WS_ED), EFF, EFF, EFF / MOE_KS, 0, nullptr}; typedef pg8::MoeOrder<DM / 256, MOE_KS, EFF / MOE_KS> OrdD; OrdD S; S.init(ts[NE], MOE_KS * DM / 256, G, bx);
            S.ts1 = ts[1]; S.ts2 = ts[2]; S.ts3 = ts[3]; S.ts4 = ts[4]; S.ts5 = ts[5]; S.ts6 = ts[6]; S.ts7 = ts[7];
            pg8::EpiOut8 E{OS, OS_KS_STRIDE, DM, SO8 / (SH8 * SWD)};
            pg8::gemm_phase<pg8::EpiOut8, OrdD, AL, SP, 1>(L + RING_OFF, g, S, E); } SEAM(15); }
    }
    if (IN(16)) { REP(16) { final_rows<MOE_KS>(XF, OS, OS_KS_STRIDE, 1.f / SO8, tok, cnt, in[26], in[27], args.out, gw, NGW, lane); } }
#undef IN
#undef SEAM
#undef lane
}

#ifndef MK_OPT_MASK
#define MK_OPT_MASK 0x1FFFF
#endif
static_assert(MK_OPT_MASK == 0x1FFFF, "the naive fallbacks no longer match the buffer formats of the persistent kernel (fp8 paths, bf16 Y)");
extern "C" void kernel_launch(void* const* d_in, const int* in_sizes, int n_in, void* d_out, int out_size, void* d_ws, size_t ws_size, hipStream_t stream) {
    static int grid = 0;
    if (grid == 0) {
        if (n_in != 28 || out_size != M * DM || in_sizes[0] != M * DM || ws_size < WS_RSG + (size_t)NE * M * 4) { fprintf(stderr, "kernel_launch: unexpected shapes: n_in %d out %d ws %zu (need %zu); nothing launched\n", n_in, out_size, ws_size, (size_t)(WS_RSG + (size_t)NE * M * 4)); grid = -1; return; }
        int dev = 0, cus = 0, per_cu = 0;
        if (hipGetDevice(&dev) != hipSuccess || hipDeviceGetAttribute(&cus, hipDeviceAttributeMultiprocessorCount, dev) != hipSuccess) { fprintf(stderr, "kernel_launch: device query failed\n"); grid = -1; return; }
        if (hipFuncSetAttribute((const void*)mk_fwd, hipFuncAttributeMaxDynamicSharedMemorySize, LDS_BYTES) != hipSuccess) { fprintf(stderr, "kernel_launch: hipFuncSetAttribute failed\n"); grid = -1; return; }
        if (hipOccupancyMaxActiveBlocksPerMultiprocessor(&per_cu, (const void*)mk_fwd, NWAVES * 64, LDS_BYTES) != hipSuccess || per_cu < 1)
            fprintf(stderr, "kernel_launch: note: occupancy query reports %d workgroups per CU\n", per_cu);
        (void)hipGetLastError();
        grid = cus;
    }
    if (grid < 0) return;
    const float* in[28]; for (int i = 0; i < 28; ++i) in[i] = (const float*)d_in[i];
    unsigned char* ws = (unsigned char*)d_ws; float* out = (float*)d_out;
    if (hipMemsetAsync(ws + WS_CTL, 0, CTL_ZERO_BYTES, stream) != hipSuccess) { fprintf(stderr, "kernel_launch: memset failed\n"); return; }
    Args a{}; for (int i = 0; i < 28; ++i) a.in[i] = in[i]; a.out = out; a.ws = ws;
    int li = 0;
#if defined(PROBE_A_END)
    a.ph_lo = 0; a.ph_hi = PROBE_A_END; a.li = 0; hipLaunchKernelGGL(mk_fwd, dim3(grid), dim3(NWAVES * 64), LDS_BYTES, stream, a);
    a.ph_lo = PROBE_B_BEGIN; a.ph_hi = NPHASE; a.li = 1; hipLaunchKernelGGL(mk_fwd, dim3(grid), dim3(NWAVES * 64), LDS_BYTES, stream, a);
    return;
#endif
    for (int p = 0; p < NPHASE;) {
        if ((MK_OPT_MASK >> p) & 1) {
            int q = p; while (q < NPHASE && ((MK_OPT_MASK >> q) & 1)) ++q;
            a.ph_lo = p; a.ph_hi = q; a.li = li++;
            hipLaunchKernelGGL(mk_fwd, dim3(grid), dim3(NWAVES * 64), LDS_BYTES, stream, a);
            const hipError_t le = hipPeekAtLastError();
            if (le != hipSuccess) { fprintf(stderr, "kernel_launch: launch failed: %s\n", hipGetErrorName(le)); return; }
            p = q; continue;
        }
        fprintf(stderr, "kernel_launch: phase %d has no fallback\n", p); return;
    }
}
```

```cpp
#include <hip/hip_runtime.h>
#include <cstdio>
#include <cstdint>

constexpr int BATCH = 4, SEQ = 4096, DM = 2048, M = BATCH * SEQ;
constexpr int PW = 1024, NPG = 4, PG = 256;
constexpr int NH = 8, HD = 64, AW = 1024;
constexpr int DFF = 5632, NE = 8, EFF = 7168;
constexpr float LN_EPS = 1e-5f, RMS_EPS = 1e-5f;
constexpr float ALPHA = 1.41421356237309515f;
constexpr float LAM_INIT0 = 0.2f;
constexpr float C2 = 0.125f * 1.4426950408889634f;
constexpr int MAXRT = 136;
constexpr int SLOTS = MAXRT * 256;

typedef unsigned short bf16;
typedef float f32x4 __attribute__((ext_vector_type(4)));

__device__ __forceinline__ float bf2f(bf16 v) { return __uint_as_float(((unsigned)v) << 16); }
__device__ __forceinline__ bf16 f2bf(float f) { unsigned u = __float_as_uint(f); return (bf16)((u + 0x7fffu + ((u >> 16) & 1u)) >> 16); }

constexpr size_t MiB = 1u << 20;
constexpr size_t WS_CTL = 0, CTL_ZERO_BYTES = 1 * MiB;
constexpr size_t WS_XF = 796 * MiB, WS_Y = 924 * MiB, WS_XBF = 1052 * MiB, WS_HM = 1116 * MiB, WS_OS = 1592 * MiB, WS_PERM = 1728 * MiB;
constexpr size_t WS_TOK = WS_PERM + 1 * MiB;
constexpr size_t WS_END = WS_TOK + 1 * MiB;
constexpr size_t WS_PU = WS_HM, WS_Q = WS_HM + 32 * MiB, WS_K = WS_HM + 64 * MiB, WS_V = WS_HM + 96 * MiB, WS_PLD = WS_HM + 128 * MiB,
                 WS_O2 = WS_HM + 160 * MiB, WS_CAT = WS_HM + 224 * MiB;
constexpr size_t WS_H = WS_HM;
constexpr size_t WS_BG = WS_HM, WS_Z = WS_HM + 64 * MiB, WS_V1 = WS_HM + 128 * MiB;
constexpr int CW_CNT = 64;

__device__ __forceinline__ float wave_sum(float v) {
#pragma unroll
    for (int o = 1; o < 64; o <<= 1) v += __shfl_xor(v, o);
    return v;
}
__device__ __forceinline__ float lambda_full(const float* q1, const float* k1, const float* q2, const float* k2, int lane) {
    const float a = wave_sum(q1[lane] * k1[lane]), b = wave_sum(q2[lane] * k2[lane]);
    return expf(a) - expf(b) + LAM_INIT0;
}
__device__ __forceinline__ unsigned pk4_fp8_(float a, float b, float c, float d);
__device__ __forceinline__ void ln_row(const float* y, const float* g, const float* b, float* xf, bf16* xb, int lane, f32x4 (&v)[8], unsigned char* x8 = nullptr, float s8 = 1.f, const bf16* yb = nullptr) {
    float s = 0.f;
#pragma unroll
    for (int j = 0; j < 8; ++j) {
        if (yb) { const unsigned long long w = *(const unsigned long long*)(yb + j * 256 + lane * 4); v[j] = (f32x4){__uint_as_float((unsigned)w << 16), __uint_as_float((unsigned)w & 0xffff0000u), __uint_as_float((unsigned)(w >> 32) << 16), __uint_as_float((unsigned)(w >> 32) & 0xffff0000u)}; }
        else v[j] = *(const f32x4*)(y + j * 256 + lane * 4);
        s += (v[j][0] + v[j][1]) + (v[j][2] + v[j][3]); }
    const float mean = wave_sum(s) * (1.f / DM); float s2 = 0.f;
#pragma unroll
    for (int j = 0; j < 8; ++j) { v[j] = v[j] - mean; s2 += (v[j][0] * v[j][0] + v[j][1] * v[j][1]) + (v[j][2] * v[j][2] + v[j][3] * v[j][3]); }
    const float rstd = 1.f / sqrtf(wave_sum(s2) * (1.f / DM) + LN_EPS);
#pragma unroll
    for (int j = 0; j < 8; ++j) { const f32x4 gg = *(const f32x4*)(g + j * 256 + lane * 4), bb = *(const f32x4*)(b + j * 256 + lane * 4);
        v[j] = v[j] * rstd * gg + bb;
        if (xf) *(f32x4*)(xf + j * 256 + lane * 4) = v[j];
        if (x8) *(unsigned*)(x8 + j * 256 + lane * 4) = pk4_fp8_(v[j][0] * s8, v[j][1] * s8, v[j][2] * s8, v[j][3] * s8);
        if (xb) { unsigned long long w = (unsigned long long)f2bf(v[j][0]) | ((unsigned long long)f2bf(v[j][1]) << 16) | ((unsigned long long)f2bf(v[j][2]) << 32) | ((unsigned long long)f2bf(v[j][3]) << 48);
            *(unsigned long long*)(xb + j * 256 + lane * 4) = w; } }
}


namespace pg8 {
#define PG8_LAS __attribute__((address_space(3)))
typedef unsigned short bf16_t;
typedef short bf16x8 __attribute__((ext_vector_type(8)));
typedef float f32x4 __attribute__((ext_vector_type(4)));
typedef unsigned u32x4 __attribute__((ext_vector_type(4)));
typedef int i32x4 __attribute__((ext_vector_type(4)));
typedef unsigned u32x2 __attribute__((ext_vector_type(2)));
constexpr int BM = 256, BK = 64, HALF = 128, HTB = HALF * BK * 2  , STAGE_BYTES = 8 * HTB, NXCD = 8, WGM = 4;

__host__ __device__ __forceinline__ int lds_byte(int r, int c) { const int st = (r >> 4) * 2 + (c >> 5), rr = r & 15, cc = c & 31, ob = rr * 64 + cc * 2; return st * 1024 + (ob ^ (((ob >> 9) & 1) << 5)); }
__host__ __device__ __forceinline__ void stage_rc(int b, int& R, int& C) { const int st = b / 1024, sb = b % 1024, swz = sb ^ (((sb >> 9) & 1) << 5); R = (st >> 1) * 16 + swz / 64; C = (st & 1) * 32 + (swz % 64) / 2; }
__host__ __device__ __forceinline__ int perm32(int rho) { const int n = rho >> 4, i = rho & 15; return 8 * (i >> 2) + 4 * n + (i & 3); }

struct Unit { int pm, pn, bt, acol, bcol, sel, am; };
struct Gemm { const bf16_t* A; const bf16_t* Bt; int lda, ldb, K; int pad; const float* rs; };

struct StaticOrder {
    int nM, nN, nwg, G, c;
    __device__ void init(int nM_, int nN_, int G_, int c_) { nM = nM_; nN = nN_; nwg = nM * nN; G = G_; c = c_; }
    __device__ __forceinline__ bool tile(int i, int& pm, int& pn) const {
        const int L = i * G + c; if (L >= nwg) return false;
        int wgid = L; { const int q = nwg / NXCD, r = nwg % NXCD, xcd = wgid % NXCD, off = wgid / NXCD; wgid = (xcd < r ? xcd * (q + 1) : r * (q + 1) + (xcd - r) * q) + off; }
        const int nig = WGM * nN, gid = wgid / nig, fm = gid * WGM, gsz = (nM - fm) < WGM ? (nM - fm) : WGM;
        pm = fm + ((wgid % nig) % gsz); pn = (wgid % nig) / gsz; return true;
    }
    __device__ __forceinline__ bool next(int i, Unit& u) const { int pm, pn; if (!tile(i, pm, pn)) return false; u.pm = pm; u.am = pm; u.pn = pn; u.bt = pn; u.acol = 0; u.bcol = 0; u.sel = 0; return true; }
    __device__ __forceinline__ void a_ready(const Unit&) const {}
    __device__ __forceinline__ void done(const Unit&) const {}
};
struct PoolOrder : StaticOrder {
    __device__ __forceinline__ bool next(int i, Unit& u) const { int pm, pn; if (!tile(i, pm, pn)) return false; u.pm = pm; u.am = pm; u.pn = pn; u.bt = pn; u.acol = 256 * pn; u.bcol = 0; u.sel = 0; return true; }
};
template <int NBT, int KS, int KLEN> struct MoeOrder : StaticOrder {
    int ts1, ts2, ts3, ts4, ts5, ts6, ts7;
    __device__ __forceinline__ int expert(int pm) const { return (pm >= ts1) + (pm >= ts2) + (pm >= ts3) + (pm >= ts4) + (pm >= ts5) + (pm >= ts6) + (pm >= ts7); }
    __device__ __forceinline__ bool next(int i, Unit& u) const { int pm, pn; if (!tile(i, pm, pn)) return false;
        const int kslice = pn % KS, pc = pn / KS; u.pm = pm; u.am = pm; u.pn = pc; u.bt = expert(pm) * NBT + pc; u.acol = kslice * KLEN; u.bcol = kslice * KLEN; u.sel = kslice; return true; }
};

template <int NBT> struct MoeOrderX : StaticOrder {
    int ts1, ts2, ts3, ts4, ts5, ts6, ts7;
    __device__ __forceinline__ int expert(int pm) const { return (pm >= ts1) + (pm >= ts2) + (pm >= ts3) + (pm >= ts4) + (pm >= ts5) + (pm >= ts6) + (pm >= ts7); }
    __device__ __forceinline__ bool next(int i, Unit& u) const {
        constexpr int CW = NBT / NXCD; const int x = c % NXCD, j = c / NXCD, per = G / NXCD;
        const int n = i * per + j, r = n / CW, cc = n % CW; if (r >= nM) return false;
        const int e = expert(r); const int tse = e == 0 ? 0 : e == 1 ? ts1 : e == 2 ? ts2 : e == 3 ? ts3 : e == 4 ? ts4 : e == 5 ? ts5 : e == 6 ? ts6 : ts7;
        u.pm = r; u.am = e * (16384 / BM) + (r - tse); u.pn = x * CW + cc; u.bt = e * NBT + u.pn; u.acol = 0; u.bcol = 0; u.sel = 0; return true; }
};
__device__ __forceinline__ unsigned cvt_pk_bf16(float lo, float hi) { unsigned r; asm volatile("v_cvt_pk_bf16_f32 %0, %1, %2" : "=v"(r) : "v"(lo), "v"(hi)); return r; }
__device__ __forceinline__ float fast_silu(float v) { return v * __builtin_amdgcn_rcpf(1.0f + __builtin_amdgcn_exp2f(-1.4426950408889634f * v)); }

#define PG8_PACK8(v0, v1) ({ u32x4 w_; w_.x = cvt_pk_bf16((v0)[0], (v0)[1]); w_.y = cvt_pk_bf16((v0)[2], (v0)[3]); w_.z = cvt_pk_bf16((v1)[0], (v1)[1]); w_.w = cvt_pk_bf16((v1)[2], (v1)[3]); w_; })
struct EpiQkv {
    static constexpr bool PERM = true, AFTER_DRAIN = false;
    bf16_t* O0; size_t stride; float qscale; float inv;
    __device__ __forceinline__ void operator()(const f32x4 (&acc)[2][2][4][2], const Unit& u, int wr, int wc, int fr, int fq, const PG8_LAS float* rsl = nullptr) const {
        const int t = u.pn >> 2; bf16_t* base = O0 + (size_t)t * stride; const float sc0 = (t == 1) ? qscale * inv : inv;
        const int row0 = u.pm * BM + wr * 64 + fr, col0 = (u.pn & 3) * BM + wc * 32 + 8 * fq;
#pragma unroll
        for (int ai = 0; ai < 2; ++ai)
#pragma unroll
            for (int m = 0; m < 4; ++m) { bf16_t* rowp = base + (size_t)(row0 + ai * HALF + m * 16) * 1024 + col0; const float sc = rsl ? rsl[ai * HALF + wr * 64 + m * 16 + fr] * sc0 : sc0;
#pragma unroll
                for (int bj = 0; bj < 2; ++bj) { const f32x4 v0 = acc[ai][bj][m][0] * sc, v1 = acc[ai][bj][m][1] * sc; *(u32x4*)(rowp + bj * HALF) = PG8_PACK8(v0, v1); } }
    }
};
struct EpiPool {
    static constexpr bool PERM = true, AFTER_DRAIN = false;
    bf16_t* O; const float* scale; int ldc; int pad;
    __device__ __forceinline__ void operator()(const f32x4 (&acc)[2][2][4][2], const Unit& u, int wr, int wc, int fr, int fq, const PG8_LAS float* rsl = nullptr) const {
        const int row0 = u.pm * BM + wr * 64 + fr, col0 = u.pn * BM + wc * 32 + 8 * fq;
        f32x4 sv[2][2];
#pragma unroll
        for (int bj = 0; bj < 2; ++bj)
#pragma unroll
            for (int n = 0; n < 2; ++n) sv[bj][n] = *(const f32x4*)(scale + col0 + bj * HALF + 4 * n);
#pragma unroll
        for (int ai = 0; ai < 2; ++ai)
#pragma unroll
            for (int m = 0; m < 4; ++m) { bf16_t* rowp = O + (size_t)(row0 + ai * HALF + m * 16) * ldc + col0;
#pragma unroll
                for (int bj = 0; bj < 2; ++bj) { const f32x4 v0 = acc[ai][bj][m][0] * sv[bj][0], v1 = acc[ai][bj][m][1] * sv[bj][1]; *(u32x4*)(rowp + bj * HALF) = PG8_PACK8(v0, v1); } }
    }
};
template <bool XB16> struct EpiResid {
    static constexpr bool PERM = true, AFTER_DRAIN = false;
    bf16_t* Y; const void* X; int ldc; float alpha; float scale; int pad;
    __device__ __forceinline__ void operator()(const f32x4 (&acc)[2][2][4][2], const Unit& u, int wr, int wc, int fr, int fq, const PG8_LAS float* rsl = nullptr) const {
        const int row0 = u.pm * BM + wr * 64 + fr, col0 = u.pn * BM + wc * 32 + 8 * fq;
#pragma unroll
        for (int ai = 0; ai < 2; ++ai)
#pragma unroll
            for (int m = 0; m < 4; ++m) { const size_t off = (size_t)(row0 + ai * HALF + m * 16) * ldc + col0;
                f32x4 xv[2][2];
#pragma unroll
                for (int bj = 0; bj < 2; ++bj)
#pragma unroll
                    for (int n = 0; n < 2; ++n) {
                        if constexpr (XB16) { const u32x2 w = *(const u32x2*)((const bf16_t*)X + off + bj * HALF + n * 4); xv[bj][n] = (f32x4){__uint_as_float(w.x << 16), __uint_as_float(w.x & 0xffff0000u), __uint_as_float(w.y << 16), __uint_as_float(w.y & 0xffff0000u)}; }
                        else xv[bj][n] = *(const f32x4*)((const float*)X + off + bj * HALF + n * 4); }
                const float sc = rsl ? rsl[ai * HALF + wr * 64 + m * 16 + fr] * scale : scale;
#pragma unroll
                for (int bj = 0; bj < 2; ++bj) { const f32x4 v0 = xv[bj][0] * alpha + acc[ai][bj][m][0] * sc, v1 = xv[bj][1] * alpha + acc[ai][bj][m][1] * sc; *(u32x4*)(Y + off + bj * HALF) = PG8_PACK8(v0, v1); } }
    }
};
struct EpiSwiglu {
    static constexpr bool PERM = true, AFTER_DRAIN = false;
    bf16_t* H; int ldh; float inv;
    __device__ __forceinline__ void operator()(const f32x4 (&acc)[2][2][4][2], const Unit& u, int wr, int wc, int fr, int fq, const PG8_LAS float* rsl = nullptr) const {
        const int row0 = u.pm * BM + wr * 64 + fr, col0 = u.pn * HALF + wc * 32 + 8 * fq;
#pragma unroll
        for (int ai = 0; ai < 2; ++ai)
#pragma unroll
            for (int m = 0; m < 4; ++m) { f32x4 v0, v1; const float ri = rsl ? rsl[ai * HALF + wr * 64 + m * 16 + fr] * inv : inv;
#pragma unroll
                for (int j = 0; j < 4; ++j) { v0[j] = fast_silu(acc[ai][0][m][0][j] * ri) * (acc[ai][1][m][0][j] * ri); v1[j] = fast_silu(acc[ai][0][m][1][j] * ri) * (acc[ai][1][m][1][j] * ri); }
                *(u32x4*)(H + (size_t)(row0 + ai * HALF + m * 16) * ldh + col0) = PG8_PACK8(v0, v1); }
    }
};
struct EpiL1in {
    static constexpr bool PERM = true, AFTER_DRAIN = false;
    bf16_t* Z; bf16_t* BG; float inv; int pad;
    __device__ __forceinline__ void operator()(const f32x4 (&acc)[2][2][4][2], const Unit& u, int wr, int wc, int fr, int fq, const PG8_LAS float* rsl = nullptr) const {
        const int row0 = u.pm * BM + wr * 64 + fr;
        if (u.pn < 16) { const int col0 = u.pn * HALF + wc * 32 + 8 * fq;
#pragma unroll
            for (int ai = 0; ai < 2; ++ai)
#pragma unroll
                for (int m = 0; m < 4; ++m) { const float ri = rsl ? rsl[ai * HALF + wr * 64 + m * 16 + fr] * inv : inv, r2 = ri * ri;
                    const f32x4 v0 = acc[ai][0][m][0] * acc[ai][1][m][0] * r2, v1 = acc[ai][0][m][1] * acc[ai][1][m][1] * r2;
                    *(u32x4*)(Z + (size_t)(row0 + ai * HALF + m * 16) * 2048 + col0) = PG8_PACK8(v0, v1); }
        } else { const int col0 = (u.pn - 16) * BM + wc * 32 + 8 * fq;
#pragma unroll
            for (int ai = 0; ai < 2; ++ai)
#pragma unroll
                for (int m = 0; m < 4; ++m) { bf16_t* rowp = BG + (size_t)(row0 + ai * HALF + m * 16) * 2048 + col0; const float ri = rsl ? rsl[ai * HALF + wr * 64 + m * 16 + fr] * inv : inv;
#pragma unroll
                    for (int bj = 0; bj < 2; ++bj) { const f32x4 v0 = acc[ai][bj][m][0] * ri, v1 = acc[ai][bj][m][1] * ri; *(u32x4*)(rowp + bj * HALF) = PG8_PACK8(v0, v1); } }
        }
    }
};
struct EpiBf16 {
    static constexpr bool PERM = true, AFTER_DRAIN = false;
    bf16_t* O; long sel_stride; int ldc; float scale;
    __device__ __forceinline__ void operator()(const f32x4 (&acc)[2][2][4][2], const Unit& u, int wr, int wc, int fr, int fq, const PG8_LAS float* rsl = nullptr) const {
        const int row0 = u.pm * BM + wr * 64 + fr, col0 = u.pn * BM + wc * 32 + 8 * fq; bf16_t* base = O + (long)u.sel * sel_stride;
#pragma unroll
        for (int ai = 0; ai < 2; ++ai)
#pragma unroll
            for (int m = 0; m < 4; ++m) { bf16_t* rowp = base + (size_t)(row0 + ai * HALF + m * 16) * ldc + col0;
#pragma unroll
                for (int bj = 0; bj < 2; ++bj) { const f32x4 v0 = acc[ai][bj][m][0] * scale, v1 = acc[ai][bj][m][1] * scale; *(u32x4*)(rowp + bj * HALF) = PG8_PACK8(v0, v1); } }
    }
};

__device__ __forceinline__ unsigned pk4_fp8(float a, float b, float c, float d) {
    a = __builtin_amdgcn_fmed3f(a, -448.f, 448.f); b = __builtin_amdgcn_fmed3f(b, -448.f, 448.f); c = __builtin_amdgcn_fmed3f(c, -448.f, 448.f); d = __builtin_amdgcn_fmed3f(d, -448.f, 448.f);
    int w = __builtin_amdgcn_cvt_pk_fp8_f32(a, b, 0, false); w = __builtin_amdgcn_cvt_pk_fp8_f32(c, d, w, true); return (unsigned)w;
}
struct EpiOut8 {
    static constexpr bool PERM = true, AFTER_DRAIN = false;
    unsigned char* O; long sel_stride; int ldc; float scale;
    __device__ __forceinline__ void operator()(const f32x4 (&acc)[2][2][4][2], const Unit& u, int wr, int wc, int fr, int fq, const PG8_LAS float* rsl = nullptr) const {
        const int row0 = u.pm * BM + wr * 64 + fr, col0 = u.pn * BM + wc * 32 + 8 * fq; unsigned char* base = O + (long)u.sel * sel_stride;
#pragma unroll
        for (int ai = 0; ai < 2; ++ai)
#pragma unroll
            for (int m = 0; m < 4; ++m) { unsigned char* rowp = base + (size_t)(row0 + ai * HALF + m * 16) * ldc + col0;
#pragma unroll
                for (int bj = 0; bj < 2; ++bj) { const f32x4 v0 = acc[ai][bj][m][0] * scale, v1 = acc[ai][bj][m][1] * scale;
                    u32x2 w; w.x = pk4_fp8(v0[0], v0[1], v0[2], v0[3]); w.y = pk4_fp8(v1[0], v1[1], v1[2], v1[3]); *(u32x2*)(rowp + bj * HALF) = w; } }
    }
};
__device__ __forceinline__ unsigned pk4_i8(float a, float b, float c, float d) {
    const float MG = 12582912.f;
    const unsigned ua = __float_as_uint(__builtin_amdgcn_fmed3f(a, -127.f, 127.f) + MG), ub = __float_as_uint(__builtin_amdgcn_fmed3f(b, -127.f, 127.f) + MG);
    const unsigned uc = __float_as_uint(__builtin_amdgcn_fmed3f(c, -127.f, 127.f) + MG), ud = __float_as_uint(__builtin_amdgcn_fmed3f(d, -127.f, 127.f) + MG);
    return __builtin_amdgcn_perm(ub, ua, 0x0c0c0400u) | __builtin_amdgcn_perm(ud, uc, 0x04000c0cu);
}
struct EpiSwigluF8 {
    static constexpr bool PERM = true, AFTER_DRAIN = false;
    unsigned char* H; int ldh; float inv, hscale;
    __device__ __forceinline__ void operator()(const f32x4 (&acc)[2][2][4][2], const Unit& u, int wr, int wc, int fr, int fq, const PG8_LAS float* rsl = nullptr) const {
        const int row0 = u.pm * BM + wr * 64 + fr, col0 = u.pn * HALF + wc * 32 + 8 * fq;
#pragma unroll
        for (int ai = 0; ai < 2; ++ai)
#pragma unroll
            for (int m = 0; m < 4; ++m) { const float ri = rsl ? rsl[ai * HALF + wr * 64 + m * 16 + fr] * inv : inv, ce = ri * -1.4426950408889634f, ics = __builtin_amdgcn_rcpf(ri * ri * hscale);
                f32x4 t0 = acc[ai][0][m][0] * ce, t1 = acc[ai][0][m][1] * ce, p0 = acc[ai][0][m][0] * acc[ai][1][m][0], p1 = acc[ai][0][m][1] * acc[ai][1][m][1], v0, v1;
#pragma unroll
                for (int j = 0; j < 4; ++j) { v0[j] = p0[j] * __builtin_amdgcn_rcpf(__builtin_fmaf(__builtin_amdgcn_exp2f(t0[j]), ics, ics)); v1[j] = p1[j] * __builtin_amdgcn_rcpf(__builtin_fmaf(__builtin_amdgcn_exp2f(t1[j]), ics, ics)); }
                u32x2 w; w.x = pk4_fp8(v0[0], v0[1], v0[2], v0[3]); w.y = pk4_fp8(v1[0], v1[1], v1[2], v1[3]);
                *(u32x2*)(H + (size_t)(row0 + ai * HALF + m * 16) * ldh + col0) = w; }
    }
};
__device__ __forceinline__ void glds_s(const void* sbase, unsigned voff, unsigned lds_dst) {
    unsigned keep;
    asm volatile("s_mov_b32 %0, m0\n\ts_mov_b32 m0, %3\n\ts_nop 0\n\tglobal_load_lds_dwordx4 %1, %2\n\ts_mov_b32 m0, %0" : "=&s"(keep) : "v"(voff), "s"(sbase), "s"(lds_dst) : "memory");
}
__device__ __forceinline__ void glds_s4(const void* sbase, unsigned voff, unsigned lds_dst) {
    unsigned keep;
    asm volatile("s_mov_b32 %0, m0\n\ts_mov_b32 m0, %3\n\ts_nop 0\n\tglobal_load_lds_dword %1, %2\n\ts_mov_b32 m0, %0" : "=&s"(keep) : "v"(voff), "s"(sbase), "s"(lds_dst) : "memory");
}
template <class Epi, class Sched, bool ALIGN_EPI = false, bool SP2 = false, int ESZ = 2, bool I8 = false, bool RSC = false>
__device__ __forceinline__ void gemm_phase(PG8_LAS unsigned char* lds, const Gemm g, const Sched& S, const Epi& E) {
    const int tid = threadIdx.x, wid = __builtin_amdgcn_readfirstlane(tid >> 6), lane = tid & 63, wr = wid >> 2, wc = wid & 3, fr = lane & 15, fq = lane >> 4;
    const int K = g.K, nt = K * ESZ / (BK * 2);
    unsigned voffA[2], voffB[2];
#pragma unroll
    for (int i = 0; i < 2; ++i) { int R, C; stage_rc(tid * 16 + i * 8192, R, C); const int Rb = Epi::PERM ? ((R & ~31) + perm32(R & 31)) : R;
        voffA[i] = (unsigned)(R * g.lda * ESZ + C * 2); voffB[i] = (unsigned)(Rb * g.ldb * ESZ + C * 2); }
    const size_t kstep = (size_t)(BK * 2);
    const size_t hstepA = (size_t)HALF * g.lda * ESZ, hstepB = (size_t)HALF * g.ldb * ESZ;
    const unsigned ldsbase = (unsigned)(size_t)lds + (unsigned)wid * 1024u;
    const int aoff = lds_byte(wr * 64 + fr, fq * 8), boff = lds_byte(wc * 32 + fr, fq * 8);
#define PG8_SA(b, h) (((b) * 2 + (h)) * HTB)
#define PG8_SB(b, h) ((4 + (b) * 2 + (h)) * HTB)
#define PG8_UA(u) ((const char*)g.A + ((size_t)(u).am * BM * g.lda + (u).acol) * ESZ)
#define PG8_UB(u) ((const char*)g.Bt + ((size_t)(u).bt * BM * g.ldb + (u).bcol) * ESZ)
#define PG8_STAGE(bufoff, gbase, voff) do { _Pragma("unroll") for (int _i = 0; _i < 2; ++_i) glds_s((gbase), (voff)[_i], ldsbase + (unsigned)((bufoff) + _i * 8192)); } while (0)
#define PG8_LDA(dst, b, h) do { _Pragma("unroll") for (int m = 0; m < 4; ++m) _Pragma("unroll") for (int k = 0; k < 2; ++k) dst[m][k] = *(const PG8_LAS bf16x8*)(lds + PG8_SA(b, h) + aoff + m * 2048 + k * 1024); } while (0)
#define PG8_LDB(dst, b, h) do { _Pragma("unroll") for (int n = 0; n < 2; ++n) _Pragma("unroll") for (int k = 0; k < 2; ++k) dst[n][k] = *(const PG8_LAS bf16x8*)(lds + PG8_SB(b, h) + boff + n * 2048 + k * 1024); } while (0)
#define PG8_CAT8(x, y) __builtin_shufflevector(__builtin_bit_cast(i32x4, (x)), __builtin_bit_cast(i32x4, (y)), 0, 1, 2, 3, 4, 5, 6, 7)
#define PG8_MMA(ai, bj, At, Bt) do { __builtin_amdgcn_s_setprio(1); \
        if constexpr (ESZ == 2) { _Pragma("unroll") for (int m = 0; m < 4; ++m) _Pragma("unroll") for (int n = 0; n < 2; ++n) _Pragma("unroll") for (int k = 0; k < 2; ++k) \
            acc[ai][bj][m][n] = __builtin_amdgcn_mfma_f32_16x16x32_bf16(Bt[n][k], At[m][k], acc[ai][bj][m][n], 0, 0, 0); } \
        else if constexpr (I8) { _Pragma("unroll") for (int m = 0; m < 4; ++m) _Pragma("unroll") for (int n = 0; n < 2; ++n) _Pragma("unroll") for (int k = 0; k < 2; ++k) \
            acc[ai][bj][m][n] = __builtin_bit_cast(f32x4, __builtin_amdgcn_mfma_i32_16x16x64_i8(__builtin_bit_cast(i32x4, Bt[n][k]), __builtin_bit_cast(i32x4, At[m][k]), __builtin_bit_cast(i32x4, acc[ai][bj][m][n]), 0, 0, 0)); } \
        else { _Pragma("unroll") for (int m = 0; m < 4; ++m) _Pragma("unroll") for (int n = 0; n < 2; ++n) \
            acc[ai][bj][m][n] = __builtin_amdgcn_mfma_scale_f32_16x16x128_f8f6f4(PG8_CAT8(Bt[n][0], Bt[n][1]), PG8_CAT8(At[m][0], At[m][1]), acc[ai][bj][m][n], 0, 0, 0, 0, 0, 0); } \
        __builtin_amdgcn_s_setprio(0); } while (0)
#define PG8_WAIT_V(n) asm volatile("s_waitcnt vmcnt(" #n ")" ::: "memory")
#define PG8_WAIT_L(n) asm volatile("s_waitcnt lgkmcnt(" #n ")" ::: "memory")
#define PG8_BAR __builtin_amdgcn_s_barrier()
#define PG8_SCHED __builtin_amdgcn_sched_barrier(0)
    Unit cur, nxt; int ui = 0;
    if (!S.next(0, cur)) return;
    f32x4 acc[2][2][4][2];
#pragma unroll
    for (int a = 0; a < 2; ++a)
#pragma unroll
        for (int b = 0; b < 2; ++b)
#pragma unroll
            for (int m = 0; m < 4; ++m)
#pragma unroll
                for (int n = 0; n < 2; ++n) acc[a][b][m][n] = (f32x4){0.f, 0.f, 0.f, 0.f};
    bf16x8 At[4][2], B0[2][2], B1[2][2];
    const char* cA = PG8_UA(cur); const char* cB = PG8_UB(cur);
    S.a_ready(cur);
    if constexpr (SP2) {
        PG8_STAGE(PG8_SB(0, 0), cB, voffB); PG8_STAGE(PG8_SB(0, 1), cB + hstepB, voffB); PG8_STAGE(PG8_SA(0, 0), cA, voffA); PG8_STAGE(PG8_SA(0, 1), cA + hstepA, voffA);
        if (wr == 1) PG8_BAR;
        PG8_WAIT_V(2); PG8_BAR;
        PG8_STAGE(PG8_SB(1, 0), cB + kstep, voffB); PG8_STAGE(PG8_SA(1, 0), cA + kstep, voffA); PG8_STAGE(PG8_SB(1, 1), cB + hstepB + kstep, voffB);
        PG8_WAIT_V(6); PG8_BAR;
    } else {
        PG8_STAGE(PG8_SB(0, 0), cB, voffB); PG8_STAGE(PG8_SA(0, 0), cA, voffA); PG8_STAGE(PG8_SB(0, 1), cB + hstepB, voffB); PG8_STAGE(PG8_SA(0, 1), cA + hstepA, voffA);
        if (wr == 1) PG8_BAR;
        PG8_WAIT_V(4); PG8_BAR;
        PG8_STAGE(PG8_SB(1, 0), cB + kstep, voffB); PG8_STAGE(PG8_SA(1, 0), cA + kstep, voffA); PG8_STAGE(PG8_SB(1, 1), cB + hstepB + kstep, voffB);
        PG8_WAIT_V(6); PG8_BAR;
    }
    const unsigned rs_lds = (unsigned)(size_t)lds + (unsigned)STAGE_BYTES + 1024u;
    for (;;) {
        if constexpr (RSC) { if (wid < 4) glds_s4(g.rs + (size_t)cur.am * BM, (unsigned)(wid * 256 + lane * 4), rs_lds + (unsigned)((ui & 1) * 1024 + wid * 256)); }
        const bool has_next = S.next(ui + 1, nxt);
        const char* nA = has_next ? PG8_UA(nxt) : cA; const char* nB = has_next ? PG8_UB(nxt) : cB;
        for (int t = 0; t < nt; t += 2) {
            const bool last = (t == nt - 2);
            const char* a1 = cA + (size_t)(t + 1) * kstep;
            const char* a2 = last ? nA : cA + (size_t)(t + 2) * kstep; const char* b2 = last ? nB : cB + (size_t)(t + 2) * kstep;
            const char* a3 = a2 + kstep; const char* b3 = b2 + kstep;
            if (last && has_next) S.a_ready(nxt);
            if constexpr (SP2) {
            PG8_LDB(B0, 0, 0); PG8_LDB(B1, 0, 1); PG8_SCHED; PG8_LDA(At, 0, 0); PG8_STAGE(PG8_SA(1, 1), a1 + hstepA, voffA);
            PG8_WAIT_V(8); PG8_WAIT_L(0); PG8_BAR; PG8_MMA(0, 0, At, B0); PG8_MMA(0, 1, At, B1); PG8_BAR; PG8_SCHED;
            PG8_LDA(At, 0, 1); PG8_STAGE(PG8_SB(0, 0), b2, voffB); PG8_STAGE(PG8_SB(0, 1), b2 + hstepB, voffB); PG8_STAGE(PG8_SA(0, 0), a2, voffA);
            PG8_WAIT_V(8); PG8_WAIT_L(0); PG8_BAR; PG8_MMA(1, 0, At, B0); PG8_MMA(1, 1, At, B1); PG8_BAR; PG8_SCHED;
            PG8_LDB(B0, 1, 0); PG8_LDB(B1, 1, 1); PG8_SCHED; PG8_LDA(At, 1, 0); PG8_STAGE(PG8_SA(0, 1), a2 + hstepA, voffA);
            PG8_WAIT_V(8); PG8_WAIT_L(0); PG8_BAR; PG8_MMA(0, 0, At, B0); PG8_MMA(0, 1, At, B1); PG8_BAR; PG8_SCHED;
            PG8_LDA(At, 1, 1); PG8_STAGE(PG8_SB(1, 0), b3, voffB); PG8_STAGE(PG8_SB(1, 1), b3 + hstepB, voffB); PG8_STAGE(PG8_SA(1, 0), a3, voffA);
            PG8_WAIT_V(8); PG8_WAIT_L(0); PG8_BAR; PG8_MMA(1, 0, At, B0); PG8_MMA(1, 1, At, B1); PG8_BAR; PG8_SCHED;
            } else {
            PG8_LDB(B0, 0, 0); PG8_SCHED; PG8_LDA(At, 0, 0); PG8_STAGE(PG8_SA(1, 1), a1 + hstepA, voffA);
            PG8_WAIT_L(8); PG8_BAR; PG8_WAIT_L(0); PG8_MMA(0, 0, At, B0); PG8_BAR; PG8_SCHED;
            PG8_LDB(B1, 0, 1); PG8_STAGE(PG8_SB(0, 0), b2, voffB);
            PG8_BAR; PG8_WAIT_L(0); PG8_MMA(0, 1, At, B1); PG8_BAR;
            PG8_LDA(At, 0, 1); PG8_STAGE(PG8_SA(0, 0), a2, voffA);
            PG8_BAR; PG8_WAIT_L(0); PG8_MMA(1, 0, At, B0); PG8_BAR; PG8_SCHED;
            PG8_STAGE(PG8_SB(0, 1), b2 + hstepB, voffB);
            PG8_WAIT_V(6); PG8_BAR; PG8_MMA(1, 1, At, B1); PG8_BAR;
            PG8_LDB(B0, 1, 0); PG8_SCHED; PG8_LDA(At, 1, 0); PG8_STAGE(PG8_SA(0, 1), a2 + hstepA, voffA);
            PG8_WAIT_L(8); PG8_BAR; PG8_WAIT_L(0); PG8_MMA(0, 0, At, B0); PG8_BAR; PG8_SCHED;
            PG8_LDB(B1, 1, 1); PG8_STAGE(PG8_SB(1, 0), b3, voffB);
            PG8_BAR; PG8_WAIT_L(0); PG8_MMA(0, 1, At, B1); PG8_BAR;
            PG8_LDA(At, 1, 1); PG8_STAGE(PG8_SA(1, 0), a3, voffA);
            PG8_BAR; PG8_WAIT_L(0); PG8_MMA(1, 0, At, B0); PG8_BAR; PG8_SCHED;
            PG8_STAGE(PG8_SB(1, 1), b3 + hstepB, voffB);
            PG8_WAIT_V(6); PG8_BAR; PG8_MMA(1, 1, At, B1); PG8_BAR;
            }
        }
        if constexpr (ALIGN_EPI) { if (wr == 0) PG8_BAR; }
        if constexpr (I8) {
#pragma unroll
            for (int a = 0; a < 2; ++a)
#pragma unroll
                for (int b = 0; b < 2; ++b)
#pragma unroll
                    for (int m = 0; m < 4; ++m)
#pragma unroll
                        for (int n = 0; n < 2; ++n) acc[a][b][m][n] = __builtin_convertvector(__builtin_bit_cast(i32x4, acc[a][b][m][n]), f32x4); }
        if constexpr (!Epi::AFTER_DRAIN) { E(acc, cur, wr, wc, fr, fq, RSC ? (const PG8_LAS float*)(lds + STAGE_BYTES + 1024 + (ui & 1) * 1024) : (const PG8_LAS float*)nullptr); S.done(cur); }
        if (!has_next) break;
#pragma unroll
        for (int a = 0; a < 2; ++a)
#pragma unroll
            for (int b = 0; b < 2; ++b)
#pragma unroll
                for (int m = 0; m < 4; ++m)
#pragma unroll
                    for (int n = 0; n < 2; ++n) acc[a][b][m][n] = (f32x4){0.f, 0.f, 0.f, 0.f};
        cur = nxt; cA = nA; cB = nB; ++ui;
        if constexpr (ALIGN_EPI) { if (wr == 1) PG8_BAR; }
    }
    PG8_WAIT_V(0);
    if constexpr (!ALIGN_EPI) { if (wr == 0) PG8_BAR; }
    PG8_BAR;
    if constexpr (Epi::AFTER_DRAIN) { E.fused(acc, cur, wr, wc, fr, fq, lds, wid, lane); S.done(cur); }
#undef PG8_SA
#undef PG8_SB
#undef PG8_UA
#undef PG8_UB
#undef PG8_STAGE
#undef PG8_LDA
#undef PG8_LDB
#undef PG8_MMA
#undef PG8_CAT8
#undef PG8_WAIT_V
#undef PG8_WAIT_L
#undef PG8_BAR
#undef PG8_SCHED
}
}

#include <hip/hip_bf16.h>
#include <cmath>
namespace attn_body {
using bf16=__hip_bfloat16;
using bf16x8=__attribute__((ext_vector_type(8)))short;
using s16x4=__attribute__((ext_vector_type(4)))short;
using f32x16=__attribute__((ext_vector_type(16)))float;
using u32x4=__attribute__((ext_vector_type(4)))unsigned;
constexpr int BATCH=4,SEQ=4096,D=64,DM=1024;
constexpr int NW=8,QBLK=32,QB=QBLK*NW,KVBLK=64,NQB=SEQ/QB;
constexpr int ATTN_PITCH=DM, ATTN_UNIT_ROWS=QB;
static_assert(NQB==16,"attention order assumes 16 query blocks");
__device__ __forceinline__ int crow(int r,int hi){return (r&3)+8*(r>>2)+4*hi;}
#define SBAR() __builtin_amdgcn_sched_barrier(0)
__device__ __forceinline__ void cmask(f32x16&p0,f32x16&p1,int jb,int qrel,int hi){
  const float NEG=-INFINITY; int kb=64*jb+4*hi;
  #pragma unroll
  for(int r=0;r<16;++r){int kv=kb+(r&3)+8*(r>>2); if(kv>qrel)p0[r]=NEG; if(kv+32>qrel)p1[r]=NEG;}
}

constexpr int NSLOT=3, SLOTB=8192;
constexpr int LDS_K=0, LDS_V=NSLOT*SLOTB, LDS_WS=2*NSLOT*SLOTB, LDS_OST=LDS_WS+NW*64*4, LDS_BYTES=LDS_OST+NW*4096;
constexpr float C2=0.125f*1.4426950408889634f;
__device__ __forceinline__ void glds16(const void*gsrc,unsigned lds_dst){unsigned keep;
  asm volatile("s_mov_b32 %0, m0\n\ts_mov_b32 m0, %2\n\ts_nop 0\n\tglobal_load_lds_dwordx4 %1, off\n\ts_mov_b32 m0, %0":"=&s"(keep):"v"(gsrc),"s"(lds_dst):"memory");}
__device__ __forceinline__ float max3f(float a,float b,float c){float r;asm("v_max3_f32 %0, %1, %2, %3":"=v"(r):"v"(a),"v"(b),"v"(c));return r;}
__device__ __forceinline__ float max2f(float a,float b){float r;asm("v_max_f32_e32 %0, %1, %2":"=v"(r):"v"(a),"v"(b));return r;}
__device__ __forceinline__ float fadd_s(float a,float b){float r;asm("v_add_f32_e32 %0, %1, %2":"=v"(r):"v"(a),"v"(b));return r;}
__device__ __forceinline__ float fsub_s(float a,float b){float r;asm("v_sub_f32_e32 %0, %1, %2":"=v"(r):"v"(a),"v"(b));return r;}
typedef float f32x2_t __attribute__((ext_vector_type(2))); typedef __bf16 bf16x2_t __attribute__((ext_vector_type(2)));
__device__ __forceinline__ unsigned cvtpk_s(float lo,float hi){f32x2_t v={lo,hi};bf16x2_t b=__builtin_convertvector(v,bf16x2_t);return __builtin_bit_cast(unsigned,b);}
#define WAIT_BAR(N) asm volatile("s_waitcnt vmcnt(" #N ") lgkmcnt(0)\n\ts_barrier":::"memory")

__device__ __forceinline__ void qkt(f32x16&p0,f32x16&p1,const char*Kslot,const bf16x8*qr,const f32x16&negm,int r32,int hi){
  const char*kb=Kslot+hi*1024+r32*16;
  #pragma unroll
  for(int d0=0;d0<4;++d0){
    const bf16x8 b0=*reinterpret_cast<const bf16x8*>(kb+d0*2048);
    const bf16x8 b1=*reinterpret_cast<const bf16x8*>(kb+d0*2048+512);
    if(d0==0){p0=__builtin_amdgcn_mfma_f32_32x32x16_bf16(b0,qr[0],negm,0,0,0);p1=__builtin_amdgcn_mfma_f32_32x32x16_bf16(b1,qr[0],negm,0,0,0);}
    else{p0=__builtin_amdgcn_mfma_f32_32x32x16_bf16(b0,qr[d0],p0,0,0,0);p1=__builtin_amdgcn_mfma_f32_32x32x16_bf16(b1,qr[d0],p1,0,0,0);}}
}
typedef __attribute__((address_space(3))) const char* lds_cptr;
typedef short v4i16_t __attribute__((ext_vector_type(4)));
__device__ __forceinline__ void kload8(bf16x8*kf,lds_cptr kp){
  kf[0]=*(const __attribute__((address_space(3))) bf16x8*)(kp);      kf[1]=*(const __attribute__((address_space(3))) bf16x8*)(kp+512);
  kf[2]=*(const __attribute__((address_space(3))) bf16x8*)(kp+2048); kf[3]=*(const __attribute__((address_space(3))) bf16x8*)(kp+2560);
  kf[4]=*(const __attribute__((address_space(3))) bf16x8*)(kp+4096); kf[5]=*(const __attribute__((address_space(3))) bf16x8*)(kp+4608);
  kf[6]=*(const __attribute__((address_space(3))) bf16x8*)(kp+6144); kf[7]=*(const __attribute__((address_space(3))) bf16x8*)(kp+6656);
}
__device__ __forceinline__ void kload2(bf16x8*kf,lds_cptr kp,int j){ kf[2*j]=*(const __attribute__((address_space(3))) bf16x8*)(kp+j*2048); kf[2*j+1]=*(const __attribute__((address_space(3))) bf16x8*)(kp+j*2048+512); }
__device__ __forceinline__ s16x4 vtr(lds_cptr p){ return __builtin_bit_cast(s16x4,__builtin_amdgcn_ds_read_tr16_b64_v4i16((__attribute__((address_space(3))) v4i16_t*)p)); }
__device__ __forceinline__ float rowmax(const f32x16&p0,const f32x16&p1){
  float a=max3f(p0[0],p0[1],p1[0]),b=max3f(p0[2],p0[3],p1[1]);a=max3f(a,p1[2],p1[3]);
  #pragma unroll
  for(int r=4;r<16;r+=4){a=max3f(a,p0[r],p0[r+1]);b=max3f(b,p0[r+2],p0[r+3]);a=max3f(a,p1[r],p1[r+1]);b=max3f(b,p1[r+2],p1[r+3]);}
  const float m=max2f(a,b);
  auto rr=__builtin_amdgcn_permlane32_swap(__float_as_uint(m),__float_as_uint(m),false,false);
  return max2f(__uint_as_float(rr[0]),__uint_as_float(rr[1]));
}
__device__ __forceinline__ void pv(f32x16*o,int vb,bf16x8 pa0,bf16x8 pa1,bf16x8 pa2,bf16x8 pa3){
  #pragma unroll
  for(int d0=0;d0<2;++d0){s16x4 lo[4],hi[4];
    #pragma unroll
    for(int ks=0;ks<4;++ks){
      asm volatile("ds_read_b64_tr_b16 %0,%1 offset:%c2":"=&v"(lo[ks]):"v"(vb),"i"(d0*4096+ks*1024):"memory");
      asm volatile("ds_read_b64_tr_b16 %0,%1 offset:%c2":"=&v"(hi[ks]):"v"(vb),"i"(d0*4096+ks*1024+512):"memory");}
    asm volatile("s_waitcnt lgkmcnt(0)":::"memory");SBAR();
    #define PK(k) (bf16x8){lo[k][0],lo[k][1],lo[k][2],lo[k][3],hi[k][0],hi[k][1],hi[k][2],hi[k][3]}
    o[d0]=__builtin_amdgcn_mfma_f32_32x32x16_bf16(pa0,PK(0),o[d0],0,0,0);
    o[d0]=__builtin_amdgcn_mfma_f32_32x32x16_bf16(pa1,PK(1),o[d0],0,0,0);
    o[d0]=__builtin_amdgcn_mfma_f32_32x32x16_bf16(pa2,PK(2),o[d0],0,0,0);
    o[d0]=__builtin_amdgcn_mfma_f32_32x32x16_bf16(pa3,PK(3),o[d0],0,0,0);
    #undef PK
  }
}

#ifndef ATTN_STORE16
#define ATTN_STORE16(p,v) (*(u32x4*)(p)=(v))
#endif
template<int THRL> __device__ __forceinline__ void attn_unit(int b,int qkcol,int vcol,int qb,const bf16*Q,const bf16*__restrict__ K,const bf16*__restrict__ V,bf16*O,char*shm){
  const int tid=threadIdx.x,lane=tid&63,r32=lane&31,hi=lane>>5; const int wid=__builtin_amdgcn_readfirstlane(tid>>6);
  const long rowbase=(long)b*SEQ; const int q0=qb*QB;
  const bf16*Qw=Q+(rowbase+q0+wid*QBLK)*DM+qkcol;
  const bf16*Kh=K+rowbase*DM+qkcol,*Vh=V+rowbase*DM+vcol;
  const unsigned lds0=(unsigned)(uintptr_t)shm;
  float*wsf=(float*)(shm+LDS_WS)+wid*64;
  const bf16*ksrc=Kh+(long)lane*DM+wid*8;
  const bf16*vsrc=Vh+(long)(16*(wid&3)+(lane>>2))*DM+(wid>>2)*32+(lane&3)*8;
  const unsigned kdst=lds0+LDS_K+wid*1024, vdst=lds0+LDS_V+wid*1024;
  #define DMA_K(t,slot) glds16(ksrc+(long)(t)*KVBLK*DM,(unsigned)__builtin_amdgcn_readfirstlane(kdst+(slot)))
  #define DMA_V(t,slot) glds16(vsrc+(long)(t)*KVBLK*DM,(unsigned)__builtin_amdgcn_readfirstlane(vdst+(slot)))
  const int vb0=(int)(lds0+LDS_V)+((lane>>4)&1)*32+(lane&3)*8+(4*hi+((lane&15)>>2))*64;
  const char*Kbase=shm+LDS_K; bf16x8 kf[8];
  const lds_cptr shm3=(lds_cptr)shm; const lds_cptr kp0=shm3+LDS_K+hi*1024+r32*16; const lds_cptr vp0=shm3+LDS_V+((lane>>4)&1)*32+(lane&3)*8+(4*hi+((lane&15)>>2))*64;
  const int NT=(q0+QB)/KVBLK;
  DMA_K(0,0);DMA_V(0,0);DMA_K(1,SLOTB);
  bf16x8 qr[4];
  #pragma unroll
  for(int d0=0;d0<4;++d0)qr[d0]=*reinterpret_cast<const bf16x8*>(&Qw[(long)r32*DM+d0*16+hi*8]);
  float mhat=0.f,l_reg=0.f;f32x16 o[2];o[0]=f32x16{};o[1]=f32x16{};f32x16 negm=f32x16{};asm volatile("":"+v"(negm));
  const int qrel=wid*QBLK+r32;
  #define CMASK(P0,P1,t) do{int jb_=(t)-(NT-4); if(jb_>=0)cmask(P0,P1,jb_,qrel,hi);}while(0)
  bool resc=false;
  #define START(P0,P1) do{ const float rm=rowmax(P0,P1); resc=false; \
    { const float dl=rm; mhat=fadd_s(mhat,dl); \
      _Pragma("unroll") for(int r=0;r<16;++r){P0[r]=fsub_s(P0[r],dl);P1[r]=fsub_s(P1[r],dl);} \
      _Pragma("unroll") for(int r=0;r<16;++r)negm[r]=-mhat; asm volatile("":"+v"(negm)); } \
    _Pragma("unroll") for(int r=0;r<16;++r)P0[r]=__builtin_amdgcn_exp2f(P0[r]); }while(0)
  #define RESC() do{ if(resc){ asm volatile("s_waitcnt lgkmcnt(0)":::"memory"); \
      _Pragma("unroll") for(int d_=0;d_<2;++d_) _Pragma("unroll") for(int r=0;r<16;++r)o[d_][r]*=wsf[crow(r,hi)]; } }while(0)
  f32x16 pA0,pA1,pB0,pB1;
  int sl_prev=0,sl_cur=0,sl_next=SLOTB;
  #define ROT() do{sl_prev=sl_cur;sl_cur=sl_next;sl_next=(sl_next==(NSLOT-1)*SLOTB)?0:sl_next+SLOTB;}while(0)
  DMA_K(2,2*SLOTB);
  WAIT_BAR(3);
  qkt(pA0,pA1,Kbase,qr,negm,r32,hi);asm volatile("s_nop 15\n\ts_nop 7":"+v"(pA0),"+v"(pA1));CMASK(pA0,pA1,0);
  START(pA0,pA1);
  _Pragma("unroll") for(int r=0;r<16;++r)pA1[r]=__builtin_amdgcn_exp2f(pA1[r]);
  WAIT_BAR(0);
  DMA_K(3,0);DMA_V(1,SLOTB);
  ROT();
  kload8(kf,kp0+sl_cur);
  WAIT_BAR(2);
  s16x4 vlo[8],vhi[8]; u32x4 pw0,pw1,pw2,pw3;
  #define PKW(P,B) cvtpk_s(P[B],P[B+1])
  #define PAF(k) __builtin_bit_cast(bf16x8,pw##k)
  #define VFR(i) (bf16x8){vlo[i][0],vlo[i][1],vlo[i][2],vlo[i][3],vhi[i][0],vhi[i][1],vhi[i][2],vhi[i][3]}
  #define PIN(x) asm volatile("":"+v"(x))
  #define MX3(a,b,c) __builtin_fmaxf(__builtin_fmaxf((a),(b)),(c))
  #define GAPA(MF,A0,A1,A2,A3,W0,W1,PW) do{ MF; sacc+=A0; sacc+=A1; sacc+=A2; sacc+=A3; PIN(sacc); W0; W1; PIN(PW); SBAR(); }while(0)
  #define EX(v) __builtin_amdgcn_exp2f(v)
  #define GAPB(MF,X,B) do{ MF; X[B]=EX(X[B]); X[B+1]=EX(X[B+1]); X[B+2]=EX(X[B+2]); X[B+3]=EX(X[B+3]); PIN(X); SBAR(); }while(0)
  #define VRD(i) do{ vlo[i]=vtr(vp_+(((i)>>2)*4096+((i)&3)*1024)); vhi[i]=vtr(vp_+(((i)>>2)*4096+((i)&3)*1024+512)); }while(0)
  #define KRD(G,j) do{ if(G){ kload2(kf,kp0+sl_next,j); SBAR(); } }while(0)
  #define STEP(C0,C1,P0,P1,t,GK,GV,GL) do{ SBAR(); \
    const lds_cptr vp_=vp0+sl_prev; \
    VRD(0); SBAR(); float sacc=(P0[0]+P0[1]); \
    GAPA(C0=__builtin_amdgcn_mfma_f32_32x32x16_bf16(kf[0],qr[0],negm,0,0,0), P0[2],P0[3],P0[4],P0[5],     pw0[0]=PKW(P0,0), pw0[1]=PKW(P0,2), pw0); \
    VRD(4); SBAR(); GAPA(C1=__builtin_amdgcn_mfma_f32_32x32x16_bf16(kf[1],qr[0],negm,0,0,0), P0[6],P0[7],P0[8],P0[9],     pw0[2]=PKW(P0,4), pw0[3]=PKW(P0,6), pw0); \
    VRD(1); SBAR(); GAPA(C0=__builtin_amdgcn_mfma_f32_32x32x16_bf16(kf[2],qr[1],C0,0,0,0),   P0[10],P0[11],P0[12],P0[13], pw1[0]=PKW(P0,8), pw1[1]=PKW(P0,10), pw1); \
    VRD(5); SBAR(); GAPA(C1=__builtin_amdgcn_mfma_f32_32x32x16_bf16(kf[3],qr[1],C1,0,0,0),   P0[14],P0[15],P1[0],P1[1],   pw1[2]=PKW(P0,12),pw1[3]=PKW(P0,14), pw1); \
    VRD(2); SBAR(); GAPA(C0=__builtin_amdgcn_mfma_f32_32x32x16_bf16(kf[4],qr[2],C0,0,0,0),   P1[2],P1[3],P1[4],P1[5],     pw2[0]=PKW(P1,0), pw2[1]=PKW(P1,2), pw2); \
    VRD(6); SBAR(); GAPA(C1=__builtin_amdgcn_mfma_f32_32x32x16_bf16(kf[5],qr[2],C1,0,0,0),   P1[6],P1[7],P1[8],P1[9],     pw2[2]=PKW(P1,4), pw2[3]=PKW(P1,6), pw2); \
    VRD(3); SBAR(); GAPA(C0=__builtin_amdgcn_mfma_f32_32x32x16_bf16(kf[6],qr[3],C0,0,0,0),   P1[10],P1[11],P1[12],P1[13], pw3[0]=PKW(P1,8), pw3[1]=PKW(P1,10), pw3); \
    VRD(7); SBAR(); GAPA(C1=__builtin_amdgcn_mfma_f32_32x32x16_bf16(kf[7],qr[3],C1,0,0,0),   P1[14],P1[15],0.f,0.f,       pw3[2]=PKW(P1,12),pw3[3]=PKW(P1,14), pw3); \
    l_reg+=sacc; \
    if(GK){DMA_K((t)+3,sl_cur);} if(GV){DMA_V((t)+1,sl_next);} \
    CMASK(C0,C1,t); \
    { float a=MX3(C0[0],C0[1],C1[0]),b=MX3(C0[2],C0[3],C1[1]); a=MX3(a,C1[2],C1[3]); \
      _Pragma("unroll") for(int r=4;r<16;r+=4){a=MX3(a,C0[r],C0[r+1]);b=MX3(b,C0[r+2],C0[r+3]);a=MX3(a,C1[r],C1[r+1]);b=MX3(b,C1[r+2],C1[r+3]);} \
      float rm=__builtin_fmaxf(a,b); { auto rr=__builtin_amdgcn_permlane32_swap(__float_as_uint(rm),__float_as_uint(rm),false,false); rm=__builtin_fmaxf(__uint_as_float(rr[0]),__uint_as_float(rr[1])); } \
      resc=false; \
      if(__builtin_expect(__any(rm>(float)THRL),0)){ const float dl=__builtin_fmaxf(rm,0.f); mhat+=dl; \
        _Pragma("unroll") for(int r=0;r<16;++r){C0[r]-=dl;C1[r]-=dl;} \
        _Pragma("unroll") for(int r=0;r<16;++r)negm[r]=-mhat; asm volatile("":"+v"(negm)); \
        const float f=__builtin_amdgcn_exp2f(-dl); l_reg*=f; if(hi==0)wsf[r32]=f; resc=true; } } \
    SBAR(); \
    GAPB(o[0]=__builtin_amdgcn_mfma_f32_32x32x16_bf16(PAF(0),VFR(0),o[0],0,0,0), C0,0); \
    GAPB(o[1]=__builtin_amdgcn_mfma_f32_32x32x16_bf16(PAF(0),VFR(4),o[1],0,0,0), C0,4); \
    KRD(GL,0); GAPB(o[0]=__builtin_amdgcn_mfma_f32_32x32x16_bf16(PAF(1),VFR(1),o[0],0,0,0), C0,8); \
    KRD(GL,1); GAPB(o[1]=__builtin_amdgcn_mfma_f32_32x32x16_bf16(PAF(1),VFR(5),o[1],0,0,0), C0,12); \
    KRD(GL,2); GAPB(o[0]=__builtin_amdgcn_mfma_f32_32x32x16_bf16(PAF(2),VFR(2),o[0],0,0,0), C1,0); \
    KRD(GL,3); GAPB(o[1]=__builtin_amdgcn_mfma_f32_32x32x16_bf16(PAF(2),VFR(6),o[1],0,0,0), C1,4); \
    GAPB(o[0]=__builtin_amdgcn_mfma_f32_32x32x16_bf16(PAF(3),VFR(3),o[0],0,0,0), C1,8); \
    GAPB(o[1]=__builtin_amdgcn_mfma_f32_32x32x16_bf16(PAF(3),VFR(7),o[1],0,0,0), C1,12); \
    }while(0)
  int t=1;
  #undef CMASK
  #define CMASK(P0,P1,t) do{}while(0)
  for(;t+5<NT;t+=2){
    STEP(pB0,pB1,pA0,pA1,t,true,true,true);     WAIT_BAR(2); RESC(); ROT();
    STEP(pA0,pA1,pB0,pB1,t+1,true,true,true);   WAIT_BAR(2); RESC(); ROT();
  }
  #undef CMASK
  #define CMASK(P0,P1,t) do{int jb_=(t)-(NT-4); if(jb_>=0)cmask(P0,P1,jb_,qrel,hi);}while(0)
  #define ENDW(tt) do{ if((tt)+3<NT){WAIT_BAR(2);} else if((tt)+2<NT){WAIT_BAR(1);} else {WAIT_BAR(0);} }while(0)
  for(;t+1<NT;t+=2){
    STEP(pB0,pB1,pA0,pA1,t,(t+3<NT),(t+1<NT),(t+1<NT));       ENDW(t);   RESC(); ROT();
    STEP(pA0,pA1,pB0,pB1,t+1,(t+4<NT),(t+2<NT),(t+2<NT));     ENDW(t+1); RESC(); ROT();
  }
  STEP(pB0,pB1,pA0,pA1,NT-1,false,false,false); RESC();
  { float sacc=pB0[0]+pB0[1]; _Pragma("unroll") for(int r=2;r<16;++r)sacc+=pB0[r]; _Pragma("unroll") for(int r=0;r<16;++r)sacc+=pB1[r]; l_reg+=sacc;
    pw0=(u32x4){PKW(pB0,0),PKW(pB0,2),PKW(pB0,4),PKW(pB0,6)};pw1=(u32x4){PKW(pB0,8),PKW(pB0,10),PKW(pB0,12),PKW(pB0,14)};pw2=(u32x4){PKW(pB1,0),PKW(pB1,2),PKW(pB1,4),PKW(pB1,6)};pw3=(u32x4){PKW(pB1,8),PKW(pB1,10),PKW(pB1,12),PKW(pB1,14)};
    SBAR(); pv(o,vb0+sl_cur,PAF(0),PAF(1),PAF(2),PAF(3)); }
  #undef PKW
  #undef PAF
  #undef VFR
  #undef PIN
  #undef MX3
  #undef GAPA
  #undef GAPB
  #undef EX
  #undef VRD
  #undef KRD
  #undef STEP
  #undef ENDW
  {auto rr=__builtin_amdgcn_permlane32_swap(__float_as_uint(l_reg),__float_as_uint(l_reg),false,false);l_reg=__uint_as_float(rr[0])+__uint_as_float(rr[1]);}
  if(hi==0)wsf[32+r32]=l_reg;asm volatile("s_waitcnt lgkmcnt(0)":::"memory");
  float rli[16];
  #pragma unroll
  for(int r=0;r<16;++r)rli[r]=__builtin_amdgcn_rcpf(wsf[32+crow(r,hi)]);
  bf16*Ow=O+(rowbase+q0+wid*QBLK)*DM+vcol;
  { bf16*stg=(bf16*)(shm+LDS_OST)+wid*2048;
    #pragma unroll
    for(int r=0;r<16;++r){const int orow=crow(r,hi);
      #pragma unroll
      for(int d0=0;d0<2;++d0)stg[orow*64+d0*32+r32]=__float2bfloat16(o[d0][r]*rli[r]);}
    asm volatile("s_waitcnt lgkmcnt(0)":::"memory");
    #pragma unroll
    for(int i=0;i<4;++i){const int row=i*8+(lane>>3),ch=lane&7; const u32x4 v=*(const u32x4*)(stg+row*64+ch*8); ATTN_STORE16(Ow+(long)row*DM+ch*8,v);} }
  asm volatile("s_waitcnt lgkmcnt(0)\n\ts_barrier":::"memory");
  #undef DMA_K
  #undef DMA_V
  #undef CMASK
  #undef START
  #undef RESC
  #undef ROT
}
constexpr int ATTN_LDS_BYTES=LDS_BYTES;
struct AttnTensors { const bf16* Q; const bf16* K; const bf16* V; bf16* O2; };
struct AttnUnit { int b, qkcol, vcol, comp, qb; };
struct StaticOrder {
  int vcu, G;
  __device__ __forceinline__ explicit StaticOrder(int grid,int block):vcu((grid%8==0)?(block%8)*(grid/8)+block/8:block),G(grid){}
  __device__ __forceinline__ bool next(int i,AttnUnit&u)const{
    const int L=(i>>3)*G+vcu; const int j=i&7;
    if(L>=256)return false;
    const int combo=L>>1, s=4*(L&1)+(j>>1); const int b=combo>>5, ph=combo&31, h=ph>>2, c=(ph>>1)&1, vh=ph&1;
    u.b=b; u.qkcol=(h*2+c)*64; u.vcol=h*128+vh*64; u.comp=c; u.qb=(j&1)?15-s:s; return true; }
  __device__ __forceinline__ void a_ready(const AttnUnit&)const{}
  __device__ __forceinline__ void done(const AttnUnit&)const{}
};
template<class Sched,int THRL=8> __device__ __forceinline__ void attn_phase(char*lds,const AttnTensors&T,const Sched&S){
  AttnUnit u;
  for(int i=0;S.next(i,u);++i){ S.a_ready(u); attn_unit<THRL>(u.b,u.qkcol,u.vcol,u.qb,T.Q,T.K,T.V,T.O2+(size_t)u.comp*((size_t)BATCH*SEQ*DM),lds); S.done(u); }
}
namespace v128 {
constexpr int SLOTK=8192, SLOTV=16384;
constexpr int XK=0, XV=NSLOT*SLOTK, XWS=XV+NSLOT*SLOTV, XQO=XWS+NW*64*4, XBYTES=XQO+NW*4096;
}
__device__ __forceinline__ void pv128(f32x16*o,int vb,bf16x8 pa0,bf16x8 pa1,bf16x8 pa2,bf16x8 pa3){
  #pragma unroll
  for(int d0=0;d0<4;++d0){s16x4 lo[4],hi[4];
    #pragma unroll
    for(int ks=0;ks<4;++ks){
      asm volatile("ds_read_b64_tr_b16 %0,%1 offset:%c2":"=&v"(lo[ks]):"v"(vb),"i"(d0*4096+ks*1024):"memory");
      asm volatile("ds_read_b64_tr_b16 %0,%1 offset:%c2":"=&v"(hi[ks]):"v"(vb),"i"(d0*4096+ks*1024+512):"memory");}
    asm volatile("s_waitcnt lgkmcnt(0)":::"memory");SBAR();
    #define PK(k) (bf16x8){lo[k][0],lo[k][1],lo[k][2],lo[k][3],hi[k][0],hi[k][1],hi[k][2],hi[k][3]}
    o[d0]=__builtin_amdgcn_mfma_f32_32x32x16_bf16(pa0,PK(0),o[d0],0,0,0);
    o[d0]=__builtin_amdgcn_mfma_f32_32x32x16_bf16(pa1,PK(1),o[d0],0,0,0);
    o[d0]=__builtin_amdgcn_mfma_f32_32x32x16_bf16(pa2,PK(2),o[d0],0,0,0);
    o[d0]=__builtin_amdgcn_mfma_f32_32x32x16_bf16(pa3,PK(3),o[d0],0,0,0);
    #undef PK
  }
}
template<int THRL> __device__ __forceinline__ void attn_unit128(int b,int qkcol,int vcol,int qb,const bf16*Q,const bf16*__restrict__ K,const bf16*__restrict__ V,bf16*O,char*shm){
  using namespace v128;
  int tid=threadIdx.x; asm volatile("":"+v"(tid));
  const int lane=tid&63,r32=lane&31,hi=lane>>5; const int wid=__builtin_amdgcn_readfirstlane(tid>>6);
  const long rowbase=(long)b*SEQ; const int q0=qb*QB;
  const bf16*Qw=Q+(rowbase+q0+wid*QBLK)*DM+qkcol;
  const bf16*Kh=K+rowbase*DM+qkcol,*Vh=V+rowbase*DM+vcol;
  const unsigned lds0=(unsigned)(uintptr_t)shm;
  float*wsf=(float*)(shm+XWS)+wid*64;
  const bf16*ksrc=Kh+(long)lane*DM+wid*8;
  const bf16*vsrc=Vh+(long)(16*(wid&3)+(lane>>2))*DM+(wid>>2)*32+(lane&3)*8;
  const unsigned kdst=lds0+XK+wid*1024, vdst=lds0+XV+wid*1024, qdst=lds0+XQO+wid*4096;
  #define DMA_K(t,slot) glds16(ksrc+(long)(t)*KVBLK*DM,(unsigned)__builtin_amdgcn_readfirstlane(kdst+(slot)))
  #define DMA_V(t,slot) do{ glds16(vsrc+(long)(t)*KVBLK*DM,(unsigned)__builtin_amdgcn_readfirstlane(vdst+2*(slot))); glds16(vsrc+64+(long)(t)*KVBLK*DM,(unsigned)__builtin_amdgcn_readfirstlane(vdst+2*(slot)+8192)); }while(0)
  const char*Kbase=shm+XK; bf16x8 kf[8];
  const lds_cptr shm3=(lds_cptr)shm; const lds_cptr kp0=shm3+XK+hi*1024+r32*16; const lds_cptr vp0=shm3+XV+((lane>>4)&1)*32+(lane&3)*8+(4*hi+((lane&15)>>2))*64;
  const lds_cptr qp0=shm3+XQO+wid*4096+lane*16;
  #define QLD(d0) (*(const __attribute__((address_space(3))) bf16x8*)(qp0+(d0)*1024))
  const int NT=(q0+QB)/KVBLK;
  #pragma unroll
  for(int d0=0;d0<4;++d0) glds16(Qw+(long)r32*DM+d0*16+hi*8,(unsigned)__builtin_amdgcn_readfirstlane(qdst+d0*1024));
  DMA_K(0,0);DMA_V(0,0);DMA_K(1,SLOTK);
  float mhat=0.f,l_reg=0.f;f32x16 o[4];o[0]=f32x16{};o[1]=f32x16{};o[2]=f32x16{};o[3]=f32x16{};f32x16 negm=f32x16{};asm volatile("":"+v"(negm));
  const int qrel=wid*QBLK+r32;
  #define CMASK(P0,P1,t) do{int jb_=(t)-(NT-4); if(jb_>=0)cmask(P0,P1,jb_,qrel,hi);}while(0)
  bool resc=false;
  #define START(P0,P1) do{ const float rm=rowmax(P0,P1); resc=false; \
    { const float dl=rm; mhat=fadd_s(mhat,dl); \
      _Pragma("unroll") for(int r=0;r<16;++r){P0[r]=fsub_s(P0[r],dl);P1[r]=fsub_s(P1[r],dl);} \
      _Pragma("unroll") for(int r=0;r<16;++r)negm[r]=-mhat; asm volatile("":"+v"(negm)); } \
    _Pragma("unroll") for(int r=0;r<16;++r)P0[r]=__builtin_amdgcn_exp2f(P0[r]); }while(0)
  #define RESC() do{ if(resc){ asm volatile("s_waitcnt lgkmcnt(0)":::"memory"); \
      _Pragma("unroll") for(int d_=0;d_<4;++d_) _Pragma("unroll") for(int r=0;r<16;++r)o[d_][r]*=wsf[crow(r,hi)]; } }while(0)
  f32x16 pA0,pA1,pB0,pB1;
  int sl_prev=0,sl_cur=0,sl_next=SLOTK;
  #define ROT() do{sl_prev=sl_cur;sl_cur=sl_next;sl_next=(sl_next==(NSLOT-1)*SLOTK)?0:sl_next+SLOTK;}while(0)
  DMA_K(2,2*SLOTK);
  WAIT_BAR(4);
  { bf16x8 q4[4]; q4[0]=QLD(0);q4[1]=QLD(1);q4[2]=QLD(2);q4[3]=QLD(3);
    qkt(pA0,pA1,Kbase,q4,negm,r32,hi);asm volatile("s_nop 15\n\ts_nop 7":"+v"(pA0),"+v"(pA1)); }
  CMASK(pA0,pA1,0);
  START(pA0,pA1);
  _Pragma("unroll") for(int r=0;r<16;++r)pA1[r]=__builtin_amdgcn_exp2f(pA1[r]);
  WAIT_BAR(0);
  DMA_K(3,0);DMA_V(1,SLOTK);
  ROT();
  kload8(kf,kp0+sl_cur);
  bf16x8 qa=QLD(0),qb_;
  WAIT_BAR(3);
  s16x4 vlo[16],vhi[16]; u32x4 pw0,pw1,pw2,pw3;
  #define PKW(P,B) cvtpk_s(P[B],P[B+1])
  #define PAF(k) __builtin_bit_cast(bf16x8,pw##k)
  #define VFR(i) (bf16x8){vlo[i][0],vlo[i][1],vlo[i][2],vlo[i][3],vhi[i][0],vhi[i][1],vhi[i][2],vhi[i][3]}
  #define PIN(x) asm volatile("":"+v"(x))
  #define MX3(a,b,c) __builtin_fmaxf(__builtin_fmaxf((a),(b)),(c))
  #define GAPA(MF,A0,A1,A2,A3,W0,W1,PW) do{ MF; sacc+=A0; sacc+=A1; sacc+=A2; sacc+=A3; PIN(sacc); W0; W1; PIN(PW); SBAR(); }while(0)
  #define EX(v) __builtin_amdgcn_exp2f(v)
  #define GAPB(MF,X,B) do{ MF; X[B]=EX(X[B]); X[B+1]=EX(X[B+1]); PIN(X); SBAR(); }while(0)
  #define VRD(i) do{ vlo[i]=vtr(vp_+(((i)>>2)*4096+((i)&3)*1024)); vhi[i]=vtr(vp_+(((i)>>2)*4096+((i)&3)*1024+512)); SBAR(); }while(0)
  #define KRD(G,j) do{ if(G){ kload2(kf,kp0+sl_next,j); SBAR(); } }while(0)
  #define PVM(db,ks) o[db]=__builtin_amdgcn_mfma_f32_32x32x16_bf16(PAF(ks),VFR(4*(db)+(ks)),o[db],0,0,0)
  #define STEP(C0,C1,P0,P1,t,GK,GV,GL) do{ SBAR(); \
    const lds_cptr vp_=vp0+2*sl_prev; \
    VRD(0); float sacc=(P0[0]+P0[1]); \
    qb_=QLD(1); SBAR(); \
    GAPA(C0=__builtin_amdgcn_mfma_f32_32x32x16_bf16(kf[0],qa,negm,0,0,0), P0[2],P0[3],P0[4],P0[5],     pw0[0]=PKW(P0,0), pw0[1]=PKW(P0,2), pw0); \
    VRD(4); GAPA(C1=__builtin_amdgcn_mfma_f32_32x32x16_bf16(kf[1],qa,negm,0,0,0), P0[6],P0[7],P0[8],P0[9],     pw0[2]=PKW(P0,4), pw0[3]=PKW(P0,6), pw0); \
    qa=QLD(2); SBAR(); \
    GAPA(C0=__builtin_amdgcn_mfma_f32_32x32x16_bf16(kf[2],qb_,C0,0,0,0),   P0[10],P0[11],P0[12],P0[13], pw1[0]=PKW(P0,8), pw1[1]=PKW(P0,10), pw1); \
    VRD(8); GAPA(C1=__builtin_amdgcn_mfma_f32_32x32x16_bf16(kf[3],qb_,C1,0,0,0),   P0[14],P0[15],P1[0],P1[1],   pw1[2]=PKW(P0,12),pw1[3]=PKW(P0,14), pw1); \
    qb_=QLD(3); SBAR(); \
    GAPA(C0=__builtin_amdgcn_mfma_f32_32x32x16_bf16(kf[4],qa,C0,0,0,0),   P1[2],P1[3],P1[4],P1[5],     pw2[0]=PKW(P1,0), pw2[1]=PKW(P1,2), pw2); \
    GAPA(C1=__builtin_amdgcn_mfma_f32_32x32x16_bf16(kf[5],qa,C1,0,0,0),   P1[6],P1[7],P1[8],P1[9],     pw2[2]=PKW(P1,4), pw2[3]=PKW(P1,6), pw2); \
    GAPA(C0=__builtin_amdgcn_mfma_f32_32x32x16_bf16(kf[6],qb_,C0,0,0,0),   P1[10],P1[11],P1[12],P1[13], pw3[0]=PKW(P1,8), pw3[1]=PKW(P1,10), pw3); \
    GAPA(C1=__builtin_amdgcn_mfma_f32_32x32x16_bf16(kf[7],qb_,C1,0,0,0),   P1[14],P1[15],0.f,0.f,       pw3[2]=PKW(P1,12),pw3[3]=PKW(P1,14), pw3); \
    l_reg+=sacc; \
    if(GK){DMA_K((t)+3,sl_cur);} if(GV){DMA_V((t)+1,sl_next);} \
    CMASK(C0,C1,t); \
    { float a=MX3(C0[0],C0[1],C1[0]),b=MX3(C0[2],C0[3],C1[1]); a=MX3(a,C1[2],C1[3]); \
      _Pragma("unroll") for(int r=4;r<16;r+=4){a=MX3(a,C0[r],C0[r+1]);b=MX3(b,C0[r+2],C0[r+3]);a=MX3(a,C1[r],C1[r+1]);b=MX3(b,C1[r+2],C1[r+3]);} \
      float rm=__builtin_fmaxf(a,b); { auto rr=__builtin_amdgcn_permlane32_swap(__float_as_uint(rm),__float_as_uint(rm),false,false); rm=__builtin_fmaxf(__uint_as_float(rr[0]),__uint_as_float(rr[1])); } \
      resc=false; \
      if(__builtin_expect(__any(rm>(float)THRL),0)){ const float dl=__builtin_fmaxf(rm,0.f); mhat+=dl; \
        _Pragma("unroll") for(int r=0;r<16;++r){C0[r]-=dl;C1[r]-=dl;} \
        _Pragma("unroll") for(int r=0;r<16;++r)negm[r]=-mhat; asm volatile("":"+v"(negm)); \
        const float f=__builtin_amdgcn_exp2f(-dl); l_reg*=f; if(hi==0)wsf[r32]=f; resc=true; } } \
    SBAR(); \
      \
    GAPB(PVM(0,0), C0,0);  VRD(12); \
    GAPB(PVM(1,0), C0,2);  VRD(1);  \
    GAPB(PVM(2,0), C0,4);  VRD(5);  \
    KRD(GL,0); GAPB(PVM(3,0), C0,6);  VRD(9);  \
    GAPB(PVM(0,1), C0,8);  VRD(13); \
    KRD(GL,1); GAPB(PVM(1,1), C0,10); VRD(2);  \
    GAPB(PVM(2,1), C0,12); VRD(6);  \
    KRD(GL,2); GAPB(PVM(3,1), C0,14); VRD(10); \
    GAPB(PVM(0,2), C1,0);  VRD(14); \
    KRD(GL,3); GAPB(PVM(1,2), C1,2);  VRD(3);  \
    GAPB(PVM(2,2), C1,4);  VRD(7);  \
    GAPB(PVM(3,2), C1,6);  VRD(11); \
    GAPB(PVM(0,3), C1,8);  VRD(15); \
    GAPB(PVM(1,3), C1,10); \
    qa=QLD(0); SBAR(); \
    GAPB(PVM(2,3), C1,12); \
    GAPB(PVM(3,3), C1,14); \
    }while(0)
  int t=1;
  #undef CMASK
  #define CMASK(P0,P1,t) do{}while(0)
  for(;t+5<NT;t+=2){
    STEP(pB0,pB1,pA0,pA1,t,true,true,true);     WAIT_BAR(3); RESC(); ROT();
    STEP(pA0,pA1,pB0,pB1,t+1,true,true,true);   WAIT_BAR(3); RESC(); ROT();
  }
  #undef CMASK
  #define CMASK(P0,P1,t) do{int jb_=(t)-(NT-4); if(jb_>=0)cmask(P0,P1,jb_,qrel,hi);}while(0)
  #define ENDW(tt) do{ if((tt)+3<NT){WAIT_BAR(3);} else if((tt)+2<NT){WAIT_BAR(2);} else {WAIT_BAR(0);} }while(0)
  for(;t+1<NT;t+=2){
    STEP(pB0,pB1,pA0,pA1,t,(t+3<NT),(t+1<NT),(t+1<NT));       ENDW(t);   RESC(); ROT();
    STEP(pA0,pA1,pB0,pB1,t+1,(t+4<NT),(t+2<NT),(t+2<NT));     ENDW(t+1); RESC(); ROT();
  }
  STEP(pB0,pB1,pA0,pA1,NT-1,false,false,false); RESC();
  { float sacc=pB0[0]+pB0[1]; _Pragma("unroll") for(int r=2;r<16;++r)sacc+=pB0[r]; _Pragma("unroll") for(int r=0;r<16;++r)sacc+=pB1[r]; l_reg+=sacc;
    pw0=(u32x4){PKW(pB0,0),PKW(pB0,2),PKW(pB0,4),PKW(pB0,6)};pw1=(u32x4){PKW(pB0,8),PKW(pB0,10),PKW(pB0,12),PKW(pB0,14)};pw2=(u32x4){PKW(pB1,0),PKW(pB1,2),PKW(pB1,4),PKW(pB1,6)};pw3=(u32x4){PKW(pB1,8),PKW(pB1,10),PKW(pB1,12),PKW(pB1,14)};
    SBAR(); pv128(o,(int)(unsigned)(size_t)vp0+2*sl_cur,PAF(0),PAF(1),PAF(2),PAF(3)); }
  #undef PKW
  #undef PAF
  #undef VFR
  #undef PIN
  #undef MX3
  #undef GAPA
  #undef GAPB
  #undef EX
  #undef VRD
  #undef KRD
  #undef PVM
  #undef STEP
  #undef ENDW
  {auto rr=__builtin_amdgcn_permlane32_swap(__float_as_uint(l_reg),__float_as_uint(l_reg),false,false);l_reg=__uint_as_float(rr[0])+__uint_as_float(rr[1]);}
  if(hi==0)wsf[32+r32]=l_reg;asm volatile("s_waitcnt lgkmcnt(0)":::"memory");
  float rli[16];
  #pragma unroll
  for(int r=0;r<16;++r)rli[r]=__builtin_amdgcn_rcpf(wsf[32+crow(r,hi)]);
  bf16*Ow=O+(rowbase+q0+wid*QBLK)*DM+vcol;
  { bf16*stg=(bf16*)(shm+XQO)+wid*2048;
    #pragma unroll
    for(int p=0;p<2;++p){
      #pragma unroll
      for(int r=0;r<16;++r){const int orow=crow(r,hi);
        #pragma unroll
        for(int d0=0;d0<2;++d0)stg[orow*64+d0*32+r32]=__float2bfloat16(o[2*p+d0][r]*rli[r]);}
      asm volatile("s_waitcnt lgkmcnt(0)":::"memory");
      #pragma unroll
      for(int i=0;i<4;++i){const int row=i*8+(lane>>3),ch=lane&7; const u32x4 v=*(const u32x4*)(stg+row*64+ch*8); ATTN_STORE16(Ow+(long)row*DM+p*64+ch*8,v);}
      asm volatile("s_waitcnt lgkmcnt(0)":::"memory");
    } }
  asm volatile("s_waitcnt lgkmcnt(0)\n\ts_barrier":::"memory");
  #undef DMA_K
  #undef DMA_V
  #undef QLD
  #undef CMASK
  #undef START
  #undef RESC
  #undef ROT
}
struct StaticOrder128 {
  int vcu, G;
  __device__ __forceinline__ explicit StaticOrder128(int grid,int block):vcu((grid%8==0)?(block%8)*(grid/8)+block/8:block),G(grid){}
  __device__ __forceinline__ bool next(int i,AttnUnit&u)const{
    const int L=(i>>2)*G+vcu; const int j=i&3;
    if(L>=256)return false;
    const int combo=L>>2, s=2*(L&3)+(j>>1); const int b=combo>>4, hc=combo&15, h=hc>>1, c=hc&1;
    u.b=b; u.qkcol=(h*2+c)*64; u.vcol=h*128; u.comp=c; u.qb=(j&1)?15-s:s; return true; }
  __device__ __forceinline__ void a_ready(const AttnUnit&)const{}
  __device__ __forceinline__ void done(const AttnUnit&)const{}
};
template<class Sched,int THRL=8> __device__ __forceinline__ void attn_phase128(char*lds,const AttnTensors&T,const Sched&S){
  AttnUnit u;
  for(int i=0;S.next(i,u);++i){ S.a_ready(u); attn_unit128<THRL>(u.b,u.qkcol,u.vcol,u.qb,T.Q,T.K,T.V,T.O2+(size_t)u.comp*((size_t)BATCH*SEQ*DM),lds); S.done(u); }
}
constexpr int ATTN128_LDS_BYTES=v128::XBYTES;
#undef SBAR
#undef WAIT_BAR
}
constexpr float SX8 = 8.f, SWG = 256.f, SH8 = 4.f, SWD = 1024.f, SO8 = 64.f;
constexpr float WCLIP6 = 4.f * 0.02209708691f, SWI = 127.f / WCLIP6, DWI = WCLIP6 / 127.f;
constexpr int NWAVES = 8;
constexpr int NPHASE = 17;
constexpr size_t WS_W0IN = 1 * MiB, WS_WPOOL = 17 * MiB, WS_W0OUT = 18 * MiB, WS_WGU = 26 * MiB, WS_WD = 70 * MiB, WS_W1IN = 92 * MiB, WS_W1OUT = 116 * MiB,
                 WS_EGU = 124 * MiB, WS_ED = 572 * MiB;
static_assert(WS_ED + (size_t)NE * DM * EFF * 2 <= WS_XF, "weight copies end below the activation buffers");
static_assert(WS_OS + (size_t)SLOTS * DM * 2 <= WS_PERM && WS_HM + (size_t)SLOTS * EFF * 2 <= WS_OS && WS_CAT + (size_t)M * DM * 2 <= WS_OS && WS_H + (size_t)M * DFF * 2 <= WS_OS, "d_ws map");
constexpr size_t WS_RS = WS_TOK + 1 * MiB, WS_RSG = WS_RS + 1 * MiB;
static_assert(WS_RSG + (size_t)SLOTS * 4 <= 1792 * MiB, "d_ws map");
constexpr size_t WS_XGS = WS_HM + 238 * MiB;
static_assert(WS_XGS + (size_t)NE * M * DM <= WS_PERM && WS_HM + (size_t)SLOTS * EFF <= WS_XGS && WS_RSG + (size_t)NE * M * 4 <= 1792 * MiB, "d_ws map (sparse expert rows)");
constexpr size_t WS_OS1 = WS_HM + 240 * MiB;
static_assert(WS_HM + (size_t)SLOTS * EFF <= WS_OS1 && WS_OS1 + (size_t)SLOTS * DM * 2 <= WS_OS, "d_ws map (fp8 MoE)");
constexpr int CW_BAR = 4096;
constexpr int RING_OFF = 0, RING_BYTES = 131072;
constexpr int LDSCTL_OFF = RING_BYTES, MISC_OFF = LDSCTL_OFF + 320;
constexpr int LDS_BYTES = 147456;

#define GAS __attribute__((address_space(1)))
#define LAS __attribute__((address_space(3)))
typedef unsigned v4u __attribute__((ext_vector_type(4)));
typedef GAS unsigned gu32;
#define RLX_AGENT __ATOMIC_RELAXED, __HIP_MEMORY_SCOPE_AGENT
#define LDS_WAIT() asm volatile("s_waitcnt lgkmcnt(0)" ::: "memory")
#define VM_WAIT() asm volatile("s_waitcnt vmcnt(0)" ::: "memory")
__device__ __forceinline__ unsigned pk2(float lo, float hi) { return (unsigned)f2bf(lo) | ((unsigned)f2bf(hi) << 16); }
__device__ __forceinline__ float bflo(unsigned w) { return __uint_as_float(w << 16); }
__device__ __forceinline__ float bfhi(unsigned w) { return __uint_as_float(w & 0xffff0000u); }

#define XB_TMO      128
#define XB_XCNT(j)  (256  + 64 * (j))
#define XB_XSUB(j)  (1280 + 64 * (j))
#define XB_XGEN(j)  (2304 + 64 * (j))
#define XB_TOP      3328
#define XB_TOPGEN   3392
#define XCD_BAR_WORDS 3456
#define XB_SPIN_CAP (1u << 18)

__device__ __forceinline__ unsigned xb_ld(unsigned* p)              { return __hip_atomic_load(p, __ATOMIC_RELAXED, __HIP_MEMORY_SCOPE_AGENT); }
__device__ __forceinline__ unsigned xb_add(unsigned* p, unsigned v) { return __hip_atomic_fetch_add(p, v, __ATOMIC_RELAXED, __HIP_MEMORY_SCOPE_AGENT); }
__device__ __forceinline__ unsigned xb_xcc_id() { return (unsigned)__builtin_amdgcn_s_getreg((3 << 11) | 20) & 0xFu; }
#define XB_SPIN(cond, bar) do { unsigned _sp = 0; while (cond) { __builtin_amdgcn_s_sleep(1); \
    if ((++_sp & 255u) == 0u) { if (xb_ld(&(bar)[XB_TMO])) break; if (_sp > XB_SPIN_CAP) { atomicAdd(&(bar)[XB_TMO], 1u); break; } } } } while (0)

struct XcdBarrier {
    unsigned* bar; unsigned x;
    volatile LAS unsigned* st;
};

__device__ __forceinline__ XcdBarrier xcd_barrier_post(unsigned* bar, volatile LAS unsigned* st) {
    XcdBarrier b; b.bar = bar; b.x = xb_xcc_id(); b.st = st;
    if (threadIdx.x == 0) (void)xb_add(&bar[XB_XCNT(b.x)], 1u);
    return b;
}
__device__ __forceinline__ void xcd_barrier_complete(unsigned* bar, unsigned x, unsigned& nloc, unsigned& nx) {
    const unsigned G = gridDim.x * gridDim.y * gridDim.z;
    unsigned sum, cnt, mine, sp = 0u;
    for (;;) {
        sum = 0u; cnt = 0u; mine = 0u;
#pragma unroll
        for (unsigned j = 0; j < 16; ++j) { const unsigned c = xb_ld(&bar[XB_XCNT(j)]); sum += c; cnt += (c > 0u) ? 1u : 0u; mine = (j == x) ? c : mine; }
        if (sum == G) break;
        __builtin_amdgcn_s_sleep(1);
        if ((++sp & 255u) == 0u) { if (xb_ld(&bar[XB_TMO])) break; if (sp > XB_SPIN_CAP) { atomicAdd(&bar[XB_TMO], 1u); break; } }
    }
    nloc = mine > 0u ? mine : 1u; nx = cnt > 0u ? cnt : 1u;
}

__device__ __forceinline__ void xcd_barrier(const XcdBarrier& b) {
    asm volatile("s_waitcnt vmcnt(0)" ::: "memory");
    __syncthreads();
    if (threadIdx.x == 0) {
        unsigned* bar = b.bar;
        __builtin_amdgcn_s_waitcnt(0);
        unsigned nloc = b.st[0], nx = b.st[1];
        if (nloc == 0u) { xcd_barrier_complete(bar, b.x, nloc, nx); b.st[0] = nloc; b.st[1] = nx; }
        const unsigned old = xb_add(&bar[XB_XSUB(b.x)], 1u);
        const unsigned gen = old / nloc;
        if (old + 1u == (gen + 1u) * nloc) {
            __builtin_amdgcn_fence(__ATOMIC_RELEASE, "agent");
            asm volatile("s_waitcnt vmcnt(0)" ::: "memory");
            const unsigned og = xb_add(&bar[XB_TOP], 1u);
            const unsigned tg = og / nx;
            if (og + 1u == (tg + 1u) * nx) xb_add(&bar[XB_TOPGEN], 1u);
            else XB_SPIN(xb_ld(&bar[XB_TOPGEN]) == tg, bar);
            __builtin_amdgcn_fence(__ATOMIC_ACQUIRE, "agent");
            xb_add(&bar[XB_XGEN(b.x)], 1u);
            asm volatile("s_waitcnt vmcnt(0)" ::: "memory");
        } else {
            XB_SPIN(xb_ld(&bar[XB_XGEN(b.x)]) == gen, bar);
            __builtin_amdgcn_fence(__ATOMIC_ACQUIRE, "agent");
            asm volatile("s_waitcnt vmcnt(0)" ::: "memory");
        }
    }
    __syncthreads();
}

__device__ __forceinline__ float wave_max(float v) {
#pragma unroll
    for (int o = 1; o < 64; o <<= 1) v = fmaxf(v, __shfl_xor(v, o));
    return v;
}
__device__ __forceinline__ void quant_row_i8(const f32x4 (&v)[8], unsigned char* q, float* rs, int lane, unsigned char* q2 = nullptr, float* rs2 = nullptr) {
    float m = 0.f;
#pragma unroll
    for (int j = 0; j < 8; ++j) m = fmaxf(fmaxf(m, fmaxf(fabsf(v[j][0]), fabsf(v[j][1]))), fmaxf(fabsf(v[j][2]), fabsf(v[j][3])));
    m = wave_max(m);
    const float sc = m > 0.f ? m * (1.f / 127.f) : 1.f, inv = 1.f / sc;
#pragma unroll
    for (int j = 0; j < 8; ++j) { const unsigned w = pg8::pk4_i8(v[j][0] * inv, v[j][1] * inv, v[j][2] * inv, v[j][3] * inv); *(unsigned*)(q + j * 256 + lane * 4) = w; if (q2) *(unsigned*)(q2 + j * 256 + lane * 4) = w; }
    if (lane == 0) { *rs = sc; if (rs2) *rs2 = sc; }
}
struct P0Item { const float* W; unsigned char* WT; int ldw, k0, csrc, ldt, drow, mode; float sc; };
__device__ __forceinline__ int il_row(int n) { return ((n >> 7) << 8) + (n & 127); }
constexpr int I_W0IN = (DM / 128) * (4096 / 32), I_POOL1 = (PG / 128) * (PG / 32), I_POOL = NPG * I_POOL1, I_SQ = (DM / 128) * (DM / 32), I_FF = (DM / 128) * (DFF / 32), I_WD = (DFF / 128) * (DM / 32),
              I_W1IN = (DM / 128) * (3 * DM / 32), I_EG1 = (DM / 128) * (EFF / 32), I_ED1 = (EFF / 128) * (DM / 32);
constexpr int P0_NITEMS = I_W0IN + I_POOL + I_SQ + 2 * I_FF + I_WD + I_W1IN + I_SQ + 2 * NE * I_EG1 + NE * I_ED1;
constexpr int P0_LATE = 16384, P0_EARLY = P0_NITEMS - P0_LATE;
constexpr int P0_FIRST = I_W0IN, P0_MID = P0_FIRST + (P0_EARLY - P0_FIRST) / 2;
static_assert(P0_LATE <= NE * I_ED1, "late items are expert down-projection items only");
__device__ __forceinline__ bool p0_decode(int it, P0Item& d, const float* const* in, unsigned char* ws, int it_hi = P0_NITEMS) {
    if (it >= it_hi) return false;
    int r = it;
#define P0_SET(W_, ldw_, kb_, c_, WT_, ldt_, drow_, mode_, sc_) do { d.W = (W_); d.ldw = (ldw_); d.k0 = 128 * (kb_); d.csrc = (c_); d.WT = (unsigned char*)(WT_); d.ldt = (ldt_); d.drow = (drow_); d.mode = (mode_); d.sc = (sc_); return true; } while (0)
    if (r < I_W0IN) { const int kb = r / 128, nb = r % 128; P0_SET(in[1], 4096, kb, 32 * nb, ws + WS_W0IN, DM, 32 * nb, 2, SWI); } r -= I_W0IN;
    if (r < I_POOL) { const int g = r / I_POOL1, q = r % I_POOL1, kb = q / 8, nb = q % 8; P0_SET(in[2] + (size_t)g * PG * PG, PG, kb, 32 * nb, ws + WS_WPOOL + (size_t)g * PG * PG * 2, PG, 32 * nb, 0, 1.f); } r -= I_POOL;
    if (r < I_SQ) { const int kb = r / 64, nb = r % 64; P0_SET(in[9], DM, kb, 32 * nb, ws + WS_W0OUT, DM, 32 * nb, 2, 2.f * SWI); } r -= I_SQ;
    if (r < I_FF) { const int kb = r / 176, nb = r % 176; P0_SET(in[12], DFF, kb, 32 * nb, ws + WS_WGU, DM, il_row(32 * nb), 2, SWI); } r -= I_FF;
    if (r < I_FF) { const int kb = r / 176, nb = r % 176; P0_SET(in[13], DFF, kb, 32 * nb, ws + WS_WGU, DM, il_row(32 * nb) + 128, 2, SWI); } r -= I_FF;
    if (r < I_WD) { const int kb = r / 64, nb = r % 64; P0_SET(in[14], DM, kb, 32 * nb, ws + WS_WD, DFF, 32 * nb, 1, SWD); } r -= I_WD;
    if (r < I_W1IN) { const int kb = r / 192, nb = r % 192, n0 = 32 * nb, seg = n0 >> 11, nn = n0 & 2047;
        const int drow = seg == 0 ? 4096 + nn : il_row(nn) + (seg == 2 ? 128 : 0);
        P0_SET(in[17], 3 * DM, kb, n0, ws + WS_W1IN, DM, drow, 2, SWI); } r -= I_W1IN;
    if (r < I_SQ) { const int kb = r / 64, nb = r % 64; P0_SET(in[19], DM, kb, 32 * nb, ws + WS_W1OUT, DM, 32 * nb, 0, 1.f); } r -= I_SQ;
    if (r < NE * I_EG1) { const int e = r / I_EG1, q = r % I_EG1, kb = q / 224, nb = q % 224; P0_SET(in[23] + (size_t)e * DM * EFF, EFF, kb, 32 * nb, ws + WS_EGU + (size_t)e * 2 * EFF * DM, DM, il_row(32 * nb), 2, SWI); } r -= NE * I_EG1;
    if (r < NE * I_EG1) { const int e = r / I_EG1, q = r % I_EG1, kb = q / 224, nb = q % 224; P0_SET(in[24] + (size_t)e * DM * EFF, EFF, kb, 32 * nb, ws + WS_EGU + (size_t)e * 2 * EFF * DM, DM, il_row(32 * nb) + 128, 2, SWI); } r -= NE * I_EG1;
    { const int e = r / I_ED1, q = r % I_ED1, kb = q / 64, nb = q % 64; P0_SET(in[25] + (size_t)e * EFF * DM, DM, kb, 32 * nb, ws + WS_ED + (size_t)e * DM * EFF, EFF, 32 * nb, 1, SWD); }
#undef P0_SET
}
__device__ __forceinline__ void p0_load(const P0Item& d, f32x4 (&v)[16], int lane) {
    const int rg = lane >> 3, c4 = (lane & 7) * 4; const float* p = d.W + (size_t)(d.k0 + 16 * rg) * d.ldw + d.csrc + c4;
#pragma unroll
    for (int i = 0; i < 16; ++i) v[i] = __builtin_nontemporal_load((const GAS f32x4*)(p + (size_t)i * d.ldw));
}
__device__ __forceinline__ void p0_emit(const P0Item& d, const f32x4 (&v)[16], LAS float*, int lane) {
    const int rg = lane >> 3, c4 = (lane & 7) * 4; const float sc = d.sc;
#pragma unroll
    for (int c = 0; c < 4; ++c) {
        const size_t o = (size_t)(d.drow + c4 + c) * d.ldt + d.k0 + 16 * rg;
        if (d.mode == 0) { v4u w0, w1; w0.x = pk2(v[0][c], v[1][c]); w0.y = pk2(v[2][c], v[3][c]); w0.z = pk2(v[4][c], v[5][c]); w0.w = pk2(v[6][c], v[7][c]);
            w1.x = pk2(v[8][c], v[9][c]); w1.y = pk2(v[10][c], v[11][c]); w1.z = pk2(v[12][c], v[13][c]); w1.w = pk2(v[14][c], v[15][c]);
            __builtin_nontemporal_store(w0, (GAS v4u*)((bf16*)d.WT + o)); __builtin_nontemporal_store(w1, (GAS v4u*)((bf16*)d.WT + o + 8)); }
        else if (d.mode == 2) { v4u w; w.x = pg8::pk4_i8(v[0][c] * sc, v[1][c] * sc, v[2][c] * sc, v[3][c] * sc); w.y = pg8::pk4_i8(v[4][c] * sc, v[5][c] * sc, v[6][c] * sc, v[7][c] * sc);
            w.z = pg8::pk4_i8(v[8][c] * sc, v[9][c] * sc, v[10][c] * sc, v[11][c] * sc); w.w = pg8::pk4_i8(v[12][c] * sc, v[13][c] * sc, v[14][c] * sc, v[15][c] * sc); __builtin_nontemporal_store(w, (GAS v4u*)(d.WT + o)); }
        else { v4u w; w.x = pg8::pk4_fp8(v[0][c] * sc, v[1][c] * sc, v[2][c] * sc, v[3][c] * sc); w.y = pg8::pk4_fp8(v[4][c] * sc, v[5][c] * sc, v[6][c] * sc, v[7][c] * sc);
            w.z = pg8::pk4_fp8(v[8][c] * sc, v[9][c] * sc, v[10][c] * sc, v[11][c] * sc); w.w = pg8::pk4_fp8(v[12][c] * sc, v[13][c] * sc, v[14][c] * sc, v[15][c] * sc); __builtin_nontemporal_store(w, (GAS v4u*)(d.WT + o)); }
    }
}
__device__ __forceinline__ void p0_range(const float* const* in, unsigned char* ws, int lo, int hi, int widx, int nw, int lane) {
    P0Item d0, d1, d2; f32x4 v0[16], v1[16], v2[16];
    int it = lo + widx; bool h0 = p0_decode(it, d0, in, ws, hi), h1 = false, h2 = false;
    if (h0) p0_load(d0, v0, lane);
    it += nw; h1 = p0_decode(it, d1, in, ws, hi); if (h1) p0_load(d1, v1, lane);
    while (h0) {
        it += nw; h2 = p0_decode(it, d2, in, ws, hi); if (h2) p0_load(d2, v2, lane);
        p0_emit(d0, v0, nullptr, lane);
        if (!h1) break;
        it += nw; h0 = p0_decode(it, d0, in, ws, hi); if (h0) p0_load(d0, v0, lane);
        p0_emit(d1, v1, nullptr, lane);
        if (!h2) break;
        it += nw; h1 = p0_decode(it, d1, in, ws, hi); if (h1) p0_load(d1, v1, lane);
        p0_emit(d2, v2, nullptr, lane);
    }
}
__device__ __forceinline__ void p0_prologue(const float* const* in, unsigned char* ws, LAS unsigned char* lds, int gw, int NGW, int wave, int lane) {
    p0_range(in, ws, 0, P0_FIRST, gw, NGW, lane);
    const float* x = in[0]; unsigned char* XI8 = ws + WS_XBF; float* RS = (float*)(ws + WS_RS);
    f32x4 va[8], vb[8]; int row = gw;
    if (row < M) {
#pragma unroll
        for (int j = 0; j < 8; ++j) va[j] = *(const f32x4*)(x + (size_t)row * DM + j * 256 + lane * 4); }
    while (row < M) {
        const int r2 = row + NGW;
        if (r2 < M) {
#pragma unroll
            for (int j = 0; j < 8; ++j) vb[j] = *(const f32x4*)(x + (size_t)r2 * DM + j * 256 + lane * 4); }
        __builtin_amdgcn_sched_barrier(0);
        quant_row_i8(va, XI8 + (size_t)row * DM, RS + row, lane);
        if (!(r2 < M)) break;
        const int r3 = r2 + NGW;
        if (r3 < M) {
#pragma unroll
            for (int j = 0; j < 8; ++j) va[j] = *(const f32x4*)(x + (size_t)r3 * DM + j * 256 + lane * 4); }
        __builtin_amdgcn_sched_barrier(0);
        quant_row_i8(vb, XI8 + (size_t)r2 * DM, RS + r2, lane);
        row = r3;
    }
}
__device__ __forceinline__ void pooled_ld16(const bf16* p, float (&v)[16]) {
    const v4u a = *(const v4u*)p, b = *(const v4u*)(p + 8);
    v[0] = bflo(a.x); v[1] = bfhi(a.x); v[2] = bflo(a.y); v[3] = bfhi(a.y); v[4] = bflo(a.z); v[5] = bfhi(a.z); v[6] = bflo(a.w); v[7] = bfhi(a.w);
    v[8] = bflo(b.x); v[9] = bfhi(b.x); v[10] = bflo(b.y); v[11] = bfhi(b.y); v[12] = bflo(b.z); v[13] = bfhi(b.z); v[14] = bflo(b.w); v[15] = bfhi(b.w);
}
__device__ __forceinline__ void pooled_rows(const bf16* PU, bf16* PLD, int gw, int NGW, int lane) {
    const int g = lane >> 4, w = 2 << g;
    for (int blk = gw; blk < M / 8; blk += NGW) {
        const int t0 = blk * 8, pos0 = t0 & (SEQ - 1);
        float acc[16];
#pragma unroll
        for (int i = 0; i < 16; ++i) acc[i] = 0.f;
#pragma unroll
        for (int j = 1; j < 16; ++j) if (j < w && j <= pos0) { float v[16]; pooled_ld16(PU + (size_t)(t0 - j) * PW + lane * 16, v);
#pragma unroll
            for (int i = 0; i < 16; ++i) acc[i] += v[i]; }
#pragma unroll
        for (int r = 0; r < 8; ++r) {
            const int row = t0 + r, pos = pos0 + r, cnt = (pos + 1 < w) ? pos + 1 : w;
            float cur[16]; pooled_ld16(PU + (size_t)row * PW + lane * 16, cur);
#pragma unroll
            for (int i = 0; i < 16; ++i) acc[i] += cur[i];
            if (r > 0 && pos >= w) { float old[16]; pooled_ld16(PU + (size_t)(row - w) * PW + lane * 16, old);
#pragma unroll
                for (int i = 0; i < 16; ++i) acc[i] -= old[i]; }
            const float rc = 1.f / (float)cnt;
            v4u o0, o1;
            o0.x = pk2(acc[0] * rc - cur[0], acc[1] * rc - cur[1]); o0.y = pk2(acc[2] * rc - cur[2], acc[3] * rc - cur[3]); o0.z = pk2(acc[4] * rc - cur[4], acc[5] * rc - cur[5]); o0.w = pk2(acc[6] * rc - cur[6], acc[7] * rc - cur[7]);
            o1.x = pk2(acc[8] * rc - cur[8], acc[9] * rc - cur[9]); o1.y = pk2(acc[10] * rc - cur[10], acc[11] * rc - cur[11]); o1.z = pk2(acc[12] * rc - cur[12], acc[13] * rc - cur[13]); o1.w = pk2(acc[14] * rc - cur[14], acc[15] * rc - cur[15]);
            *(v4u*)(PLD + (size_t)row * PW + lane * 16) = o0; *(v4u*)(PLD + (size_t)row * PW + lane * 16 + 8) = o1;
        }
    }
}
__device__ __forceinline__ void combine_rows_q(const bf16* O2, const bf16* CAT, unsigned char* CATQ, float* RS, const float* q1, const float* k1, const float* q2, const float* k2, const float* subg, int gw, int NGW, int lane) {
    const float lam = lambda_full(q1, k1, q2, k2, lane);
    const int cg = (lane & 7) * 16;
    float gg[16];
#pragma unroll
    for (int i = 0; i < 16; ++i) gg[i] = subg[cg + i] * (1.f - LAM_INIT0);
    for (int row = gw; row < M; row += NGW) {
        const bf16* p1 = O2 + (size_t)row * AW + lane * 16; const bf16* p2 = p1 + (size_t)M * AW; const bf16* pa = CAT + (size_t)row * DM + lane * 16;
        const v4u a0 = *(const v4u*)p1, a1 = *(const v4u*)(p1 + 8), b0 = *(const v4u*)p2, b1 = *(const v4u*)(p2 + 8), c0 = *(const v4u*)pa, c1 = *(const v4u*)(pa + 8);
        const float x[16] = {bflo(a0.x), bfhi(a0.x), bflo(a0.y), bfhi(a0.y), bflo(a0.z), bfhi(a0.z), bflo(a0.w), bfhi(a0.w), bflo(a1.x), bfhi(a1.x), bflo(a1.y), bfhi(a1.y), bflo(a1.z), bfhi(a1.z), bflo(a1.w), bfhi(a1.w)};
        const float y[16] = {bflo(b0.x), bfhi(b0.x), bflo(b0.y), bfhi(b0.y), bflo(b0.z), bfhi(b0.z), bflo(b0.w), bfhi(b0.w), bflo(b1.x), bfhi(b1.x), bflo(b1.y), bfhi(b1.y), bflo(b1.z), bfhi(b1.z), bflo(b1.w), bfhi(b1.w)};
        const float pa_[16] = {bflo(c0.x), bfhi(c0.x), bflo(c0.y), bfhi(c0.y), bflo(c0.z), bfhi(c0.z), bflo(c0.w), bfhi(c0.w), bflo(c1.x), bfhi(c1.x), bflo(c1.y), bfhi(c1.y), bflo(c1.z), bfhi(c1.z), bflo(c1.w), bfhi(c1.w)};
        float o[16], ss = 0.f;
#pragma unroll
        for (int i = 0; i < 16; ++i) { o[i] = x[i] - lam * y[i]; ss += o[i] * o[i]; }
        ss += __shfl_xor(ss, 1); ss += __shfl_xor(ss, 2); ss += __shfl_xor(ss, 4);
        const float r = 1.f / sqrtf(ss * (1.f / 128.f) + RMS_EPS);
        float m = 0.f;
#pragma unroll
        for (int i = 0; i < 16; ++i) { o[i] = o[i] * r * gg[i]; m = fmaxf(m, fmaxf(fabsf(o[i]), fabsf(pa_[i]))); }
        m = wave_max(m);
        const float sc = m > 0.f ? m * (1.f / 127.f) : 1.f, inv = 1.f / sc;
        v4u wa, wo;
        wa.x = pg8::pk4_i8(pa_[0] * inv, pa_[1] * inv, pa_[2] * inv, pa_[3] * inv); wa.y = pg8::pk4_i8(pa_[4] * inv, pa_[5] * inv, pa_[6] * inv, pa_[7] * inv);
        wa.z = pg8::pk4_i8(pa_[8] * inv, pa_[9] * inv, pa_[10] * inv, pa_[11] * inv); wa.w = pg8::pk4_i8(pa_[12] * inv, pa_[13] * inv, pa_[14] * inv, pa_[15] * inv);
        wo.x = pg8::pk4_i8(o[0] * inv, o[1] * inv, o[2] * inv, o[3] * inv); wo.y = pg8::pk4_i8(o[4] * inv, o[5] * inv, o[6] * inv, o[7] * inv);
        wo.z = pg8::pk4_i8(o[8] * inv, o[9] * inv, o[10] * inv, o[11] * inv); wo.w = pg8::pk4_i8(o[12] * inv, o[13] * inv, o[14] * inv, o[15] * inv);
        unsigned char* d = CATQ + (size_t)row * DM + lane * 16; *(v4u*)d = wa; *(v4u*)(d + PW) = wo;
        if (lane == 0) RS[row] = sc;
    }
}
__device__ __forceinline__ unsigned pk4_fp8_(float a, float b, float c, float d) { return pg8::pk4_fp8(a, b, c, d); }
__device__ __forceinline__ void ln_rows(const bf16* Y, const float* g, const float* b, float* XF, bf16* XBF, int gw, int NGW, int lane) {
    for (int row = gw; row < M; row += NGW) { f32x4 v[8]; ln_row(nullptr, g, b, XF + (size_t)row * DM, XBF + (size_t)row * DM, lane, v, nullptr, 1.f, Y + (size_t)row * DM); }
}
__device__ __forceinline__ void row_load_bf16(const bf16* y, int lane, unsigned long long (&raw)[8]) {
#pragma unroll
    for (int j = 0; j < 8; ++j) raw[j] = __builtin_nontemporal_load((const unsigned long long*)(y + j * 256 + lane * 4));
}
__device__ __forceinline__ void ln_row_raw(const unsigned long long (&raw)[8], const f32x4 (&gg)[8], const f32x4 (&bb)[8], bf16* xf, int lane, f32x4 (&v)[8]) {
    float s = 0.f;
#pragma unroll
    for (int j = 0; j < 8; ++j) { const unsigned long long w = raw[j]; v[j] = (f32x4){__uint_as_float((unsigned)w << 16), __uint_as_float((unsigned)w & 0xffff0000u), __uint_as_float((unsigned)(w >> 32) << 16), __uint_as_float((unsigned)(w >> 32) & 0xffff0000u)};
        s += (v[j][0] + v[j][1]) + (v[j][2] + v[j][3]); }
    const float mean = wave_sum(s) * (1.f / DM); float s2 = 0.f;
#pragma unroll
    for (int j = 0; j < 8; ++j) { v[j] = v[j] - mean; s2 += (v[j][0] * v[j][0] + v[j][1] * v[j][1]) + (v[j][2] * v[j][2] + v[j][3] * v[j][3]); }
    const float rstd = 1.f / sqrtf(wave_sum(s2) * (1.f / DM) + LN_EPS);
#pragma unroll
    for (int j = 0; j < 8; ++j) { v[j] = v[j] * rstd * gg[j] + bb[j];
        const unsigned long long w = (unsigned long long)f2bf(v[j][0]) | ((unsigned long long)f2bf(v[j][1]) << 16) | ((unsigned long long)f2bf(v[j][2]) << 32) | ((unsigned long long)f2bf(v[j][3]) << 48);
        *(unsigned long long*)(xf + j * 256 + lane * 4) = w; }
}
__device__ __forceinline__ void ln_rows_q(const bf16* Y, const float* g, const float* b, bf16* XF, unsigned char* XI8, float* RS, int gw, int NGW, int lane) {
    f32x4 gg[8], bb[8];
#pragma unroll
    for (int j = 0; j < 8; ++j) { gg[j] = *(const f32x4*)(g + j * 256 + lane * 4); bb[j] = *(const f32x4*)(b + j * 256 + lane * 4); }
    unsigned long long cur[8], nxt[8];
    int row = gw; if (row < M) row_load_bf16(Y + (size_t)row * DM, lane, cur);
    for (; row < M; row += NGW) {
        const int nr = row + NGW; if (nr < M) row_load_bf16(Y + (size_t)nr * DM, lane, nxt);
        __builtin_amdgcn_sched_barrier(0);
        f32x4 v[8]; ln_row_raw(cur, gg, bb, XF + (size_t)row * DM, lane, v);
        quant_row_i8(v, XI8 + (size_t)row * DM, RS + row, lane);
#pragma unroll
        for (int j = 0; j < 8; ++j) cur[j] = nxt[j];
    }
}
__device__ __forceinline__ void ln_rows8(const bf16* Y, const float* g, const float* b, float* XF, unsigned char* X8, float s8, int gw, int NGW, int lane) {
    for (int row = gw; row < M; row += NGW) { f32x4 v[8]; ln_row(nullptr, g, b, XF + (size_t)row * DM, nullptr, lane, v, X8 + (size_t)row * DM, s8, Y + (size_t)row * DM); }
}
__device__ __forceinline__ void conv_rows(const bf16* BG, const bf16* Z, const float* cw, bf16* V1, int gw, int NGW, int lane) {
    for (int row = gw; row < M; row += NGW) {
        const int pos = row & (SEQ - 1);
#pragma unroll
        for (int q = 0; q < 4; ++q) {
            const int c0 = q * 512 + lane * 8; const size_t o = (size_t)row * DM + c0;
            const v4u z0 = *(const v4u*)(Z + o), bg = *(const v4u*)(BG + o);
            v4u z1 = (v4u){0u, 0u, 0u, 0u}, z2 = (v4u){0u, 0u, 0u, 0u};
            if (pos >= 1) z1 = *(const v4u*)(Z + o - DM);
            if (pos >= 2) z2 = *(const v4u*)(Z + o - 2 * DM);
            const f32x4 w0a = *(const f32x4*)(cw + c0), w0b = *(const f32x4*)(cw + c0 + 4), w1a = *(const f32x4*)(cw + DM + c0), w1b = *(const f32x4*)(cw + DM + c0 + 4),
                        w2a = *(const f32x4*)(cw + 2 * DM + c0), w2b = *(const f32x4*)(cw + 2 * DM + c0 + 4);
            const float zz0[8] = {bflo(z0.x), bfhi(z0.x), bflo(z0.y), bfhi(z0.y), bflo(z0.z), bfhi(z0.z), bflo(z0.w), bfhi(z0.w)};
            const float zz1[8] = {bflo(z1.x), bfhi(z1.x), bflo(z1.y), bfhi(z1.y), bflo(z1.z), bfhi(z1.z), bflo(z1.w), bfhi(z1.w)};
            const float zz2[8] = {bflo(z2.x), bfhi(z2.x), bflo(z2.y), bfhi(z2.y), bflo(z2.z), bfhi(z2.z), bflo(z2.w), bfhi(z2.w)};
            const float bb[8] = {bflo(bg.x), bfhi(bg.x), bflo(bg.y), bfhi(bg.y), bflo(bg.z), bfhi(bg.z), bflo(bg.w), bfhi(bg.w)};
            const float k0[8] = {w0a[0], w0a[1], w0a[2], w0a[3], w0b[0], w0b[1], w0b[2], w0b[3]}, k1[8] = {w1a[0], w1a[1], w1a[2], w1a[3], w1b[0], w1b[1], w1b[2], w1b[3]},
                        k2[8] = {w2a[0], w2a[1], w2a[2], w2a[3], w2b[0], w2b[1], w2b[2], w2b[3]};
            float y[8];
#pragma unroll
            for (int i = 0; i < 8; ++i) y[i] = bb[i] * (k0[i] * zz2[i] + k1[i] * zz1[i] + k2[i] * zz0[i]);
            v4u w; w.x = pk2(y[0], y[1]); w.y = pk2(y[2], y[3]); w.z = pk2(y[4], y[5]); w.w = pk2(y[6], y[7]);
            *(v4u*)(V1 + o) = w;
        }
    }
}
__device__ __forceinline__ void ln_route_rows(const bf16* Y, const float* g, const float* b, bf16* XF, unsigned char* XGS, float* RSGS, const float* wr, unsigned* cnt, int* tok, int gw, int NGW, int lane, LAS float* wl, const float* const* in, unsigned char* ws) {
    for (int i = threadIdx.x; i < DM * NE; i += NWAVES * 64) wl[(i & 7) * DM + (i >> 3)] = wr[i];
    __syncthreads();
    f32x4 gg[8], bb[8];
#pragma unroll
    for (int j = 0; j < 8; ++j) { gg[j] = *(const f32x4*)(g + j * 256 + lane * 4); bb[j] = *(const f32x4*)(b + j * 256 + lane * 4); }
    unsigned long long cur[8], nxt[8];
    int row = gw; if (row < M) row_load_bf16(Y + (size_t)row * DM, lane, cur);
    int cit = P0_EARLY + gw;
    for (; row < M; row += NGW) {
        const int nr = row + NGW; if (nr < M) row_load_bf16(Y + (size_t)nr * DM, lane, nxt);
        P0Item cd; f32x4 cv[16]; const bool chave = p0_decode(cit, cd, in, ws); if (chave) p0_load(cd, cv, lane); cit += NGW;
        __builtin_amdgcn_sched_barrier(0);
        f32x4 v[8]; ln_row_raw(cur, gg, bb, XF + (size_t)row * DM, lane, v);
        float lg[NE];
#pragma unroll
        for (int e = 0; e < NE; ++e) { float a = 0.f;
#pragma unroll
            for (int j = 0; j < 8; ++j) { const f32x4 w = *(const LAS f32x4*)(wl + e * DM + j * 256 + lane * 4); a += (v[j][0] * w[0] + v[j][1] * w[1]) + (v[j][2] * w[2] + v[j][3] * w[3]); }
            lg[e] = wave_sum(a); }
        int i1 = 0; float v1 = lg[0];
#pragma unroll
        for (int e = 1; e < NE; ++e) if (lg[e] > v1) { v1 = lg[e]; i1 = e; }
        int i2 = -1; float v2 = -3.0e38f;
#pragma unroll
        for (int e = 0; e < NE; ++e) if (e != i1 && lg[e] > v2) { v2 = lg[e]; i2 = e; }
        int p1 = 0, p2 = 0;
        if (lane == 0) {
            const float g1 = 1.f / (1.f + expf(v2 - v1)), g2 = 1.f - g1;
            p1 = (int)__hip_atomic_fetch_add(cnt + 64 * i1, 1u, RLX_AGENT); p2 = (int)__hip_atomic_fetch_add(cnt + 64 * i2, 1u, RLX_AGENT);
            int* t = tok + (size_t)row * 8; t[0] = i1; t[1] = i2; t[2] = p1; t[3] = p2; ((float*)t)[4] = g1; ((float*)t)[5] = g2;
        }
        p1 = __builtin_amdgcn_readfirstlane(p1); p2 = __builtin_amdgcn_readfirstlane(p2);
        const size_t s1 = (size_t)i1 * M + p1, s2 = (size_t)i2 * M + p2;
        quant_row_i8(v, XGS + s1 * DM, RSGS + s1, lane, XGS + s2 * DM, RSGS + s2);
        if (chave) p0_emit(cd, cv, nullptr, lane);
#pragma unroll
        for (int j = 0; j < 8; ++j) cur[j] = nxt[j];
    }
    for (; cit < P0_NITEMS; cit += NGW) { P0Item cd; f32x4 cv[16]; if (p0_decode(cit, cd, in, ws)) { p0_load(cd, cv, lane); p0_emit(cd, cv, nullptr, lane); } }
}
__device__ __forceinline__ void gather_rows(const float* XF, unsigned char* XG8, float* RSG, const int* perm, const unsigned* cnt, int gw, int NGW, int lane) {
    int base = 0;
    for (int e = 0; e < NE; ++e) {
        const int n = (int)cnt[64 * e], nt = (n + 255) >> 8;
        for (int pos = gw; pos < nt * 256; pos += NGW) {
            const int tk = pos < n ? perm[e * M + pos] : 0; const size_t slot = (size_t)base * 256 + pos;
            f32x4 v[8];
#pragma unroll
            for (int j = 0; j < 8; ++j) v[j] = *(const f32x4*)(XF + (size_t)tk * DM + j * 256 + lane * 4);
            quant_row_i8(v, XG8 + slot * DM, RSG + slot, lane);
        }
        base += nt;
    }
}
typedef float f32x2_ __attribute__((ext_vector_type(2)));
template <int KS> __device__ __forceinline__ void final_rows(const bf16* XF, const unsigned char* OS, long ks_stride, float os_inv, const int* tok, const unsigned* cnt, const float* g, const float* b, float* out, int gw, int NGW, int lane) {
    int tb[NE + 1]; { int base = 0;
#pragma unroll
        for (int e = 0; e < NE; ++e) { tb[e] = base; base += ((int)cnt[64 * e] + 255) >> 8; } tb[NE] = base; }
    for (int row = gw; row < M; row += NGW) {
        const int* t = tok + (size_t)row * 8; const int e0 = t[0], e1 = t[1], p0 = t[2], p1 = t[3]; const float g0 = ((const float*)t)[4], g1 = ((const float*)t)[5];
        int b0 = 0, b1 = 0;
#pragma unroll
        for (int e = 0; e < NE; ++e) { if (e == e0) b0 = tb[e]; if (e == e1) b1 = tb[e]; }
        const unsigned char* r0 = OS + ((size_t)b0 * 256 + p0) * DM; const unsigned char* r1 = OS + ((size_t)b1 * 256 + p1) * DM; const float h0 = g0 * os_inv, h1 = g1 * os_inv;
        f32x4 v[8]; float s = 0.f;
#pragma unroll
        for (int j = 0; j < 8; ++j) { const unsigned long long xw = *(const unsigned long long*)(XF + (size_t)row * DM + j * 256 + lane * 4);
            const f32x4 x = (f32x4){bflo((unsigned)xw), bfhi((unsigned)xw), bflo((unsigned)(xw >> 32)), bfhi((unsigned)(xw >> 32))};
            f32x4 m0 = (f32x4){0.f, 0.f, 0.f, 0.f}, m1 = m0;
#pragma unroll
            for (int ks = 0; ks < KS; ++ks) { const int a = *(const int*)(r0 + (long)ks * ks_stride + j * 256 + lane * 4), c = *(const int*)(r1 + (long)ks * ks_stride + j * 256 + lane * 4);
                const f32x2_ a0 = __builtin_amdgcn_cvt_pk_f32_fp8(a, false), a1 = __builtin_amdgcn_cvt_pk_f32_fp8(a, true), c0 = __builtin_amdgcn_cvt_pk_f32_fp8(c, false), c1 = __builtin_amdgcn_cvt_pk_f32_fp8(c, true);
                m0 += (f32x4){a0[0], a0[1], a1[0], a1[1]}; m1 += (f32x4){c0[0], c0[1], c1[0], c1[1]}; }
            v[j] = x * ALPHA + m0 * h0 + m1 * h1;
            s += (v[j][0] + v[j][1]) + (v[j][2] + v[j][3]); }
        const float mean = wave_sum(s) * (1.f / DM); float s2 = 0.f;
#pragma unroll
        for (int j = 0; j < 8; ++j) { v[j] = v[j] - mean; s2 += (v[j][0] * v[j][0] + v[j][1] * v[j][1]) + (v[j][2] * v[j][2] + v[j][3] * v[j][3]); }
        const float rstd = 1.f / sqrtf(wave_sum(s2) * (1.f / DM) + LN_EPS);
#pragma unroll
        for (int j = 0; j < 8; ++j) { const f32x4 gg = *(const f32x4*)(g + j * 256 + lane * 4), bb = *(const f32x4*)(b + j * 256 + lane * 4);
            *(f32x4*)(out + (size_t)row * DM + j * 256 + lane * 4) = v[j] * rstd * gg + bb; }
    }
}

#ifndef MOE_KS
#define MOE_KS 2
#endif
struct Args { const float* in[28]; float* out; unsigned char* ws; int ph_lo, ph_hi, li, pad; };
__global__ void __launch_bounds__(NWAVES * 64, 2) mk_fwd(Args args) {
    extern __shared__ __attribute__((aligned(16))) unsigned char lds[];
    LAS unsigned char* L = (LAS unsigned char*)lds;
    volatile LAS unsigned* MISC = (volatile LAS unsigned*)(L + MISC_OFF);
    const int tid = threadIdx.x, wave = __builtin_amdgcn_readfirstlane(tid >> 6);
#define lane ({ int l_ = (int)threadIdx.x & 63; asm volatile("" : "+v"(l_)); l_; })
    const int G = gridDim.x; const int bx = blockIdx.x; const int vcu = (G % 8 == 0) ? (bx % 8) * (G / 8) + bx / 8 : bx;
    const int gw = vcu * NWAVES + wave, NGW = G * NWAVES;
    unsigned char* ws = args.ws;
    gu32* ctl = (gu32*)(ws + WS_CTL);
    for (int u = tid; u < (LDS_BYTES - LDSCTL_OFF) / 4; u += NWAVES * 64) ((LAS unsigned*)(L + LDSCTL_OFF))[u] = 0u;
    __syncthreads();
    XcdBarrier bar = xcd_barrier_post((unsigned*)(ctl + CW_BAR) + args.li * XCD_BAR_WORDS, MISC + 8);
    const int lo = args.ph_lo, hi = args.ph_hi;
#define IN(k) (lo <= (k) && (k) < hi)
#ifndef PROBE_DUP
#define PROBE_DUP -1
#endif
#define REP(k) _Pragma("unroll") for (int rep_ = 0; rep_ < ((PROBE_DUP == (k)) ? 2 : 1); ++rep_)
#define SEAM(k) do { if (IN(k) && IN((k) + 1)) xcd_barrier(bar); } while (0)
    const float* const* in; { const void* kp_ = (const void*)__builtin_amdgcn_kernarg_segment_ptr(); asm volatile("" : "+s"(kp_)); in = (const float* const*)kp_; }
    bf16* XF = (bf16*)(ws + WS_XF); bf16* Y = (bf16*)(ws + WS_Y); bf16* XBF = (bf16*)(ws + WS_XBF);
    bf16 *PU = (bf16*)(ws + WS_PU), *Q = (bf16*)(ws + WS_Q), *K = (bf16*)(ws + WS_K), *V = (bf16*)(ws + WS_V), *PLD = (bf16*)(ws + WS_PLD), *O2 = (bf16*)(ws + WS_O2), *CAT = (bf16*)(ws + WS_CAT);
    bf16 *H = (bf16*)(ws + WS_H), *BG = (bf16*)(ws + WS_BG), *Z = (bf16*)(ws + WS_Z), *V1 = (bf16*)(ws + WS_V1); unsigned char *OS = ws + WS_OS, *HM8 = ws + WS_HM;
    constexpr long OS_KS_STRIDE = (long)WS_OS1 - (long)WS_OS;
    int* perm = (int*)(ws + WS_PERM); int* tok = (int*)(ws + WS_TOK); unsigned* cnt = (unsigned*)(ws + WS_CTL) + CW_CNT;
    float* RS = (float*)(ws + WS_RS); float* RSG = (float*)(ws + WS_RSG); unsigned char* XGS = ws + WS_XGS;
    constexpr bool AL = true, SP = true;

    if (IN(0)) { REP(0) { p0_prologue(in, ws, L, gw, NGW, wave, lane); } SEAM(0); }
    if (IN(1)) { REP(1) { pg8::Gemm g{XBF, (const bf16*)(ws + WS_W0IN), DM, DM, DM, 0, RS}; pg8::StaticOrder S; S.init(M / 256, 4096 / 256, G, bx);
        pg8::EpiQkv E{PU, (size_t)(WS_Q - WS_PU) / 2, C2, DWI};
        pg8::gemm_phase<pg8::EpiQkv, pg8::StaticOrder, AL, SP, 1, true, true>(L + RING_OFF, g, S, E); } SEAM(1); }
    if (IN(2)) { REP(2) { pooled_rows(PU, PLD, gw, NGW, lane);
        const bool split = (G & 15) == 0, grpA = !split || (bx & 4) == 0;
        const int cw = split ? ((((bx >> 3) << 2) | (bx & 3)) * NWAVES + wave) : gw, cn = split ? NGW / 2 : NGW;
        if (grpA) p0_range(in, ws, P0_FIRST, split ? P0_MID : P0_EARLY, cw, cn, lane);
        VM_WAIT(); __syncthreads();
        const attn_body::AttnTensors AT{(const attn_body::bf16*)Q, (const attn_body::bf16*)K, (const attn_body::bf16*)V, (attn_body::bf16*)O2};
        static_assert(attn_body::ATTN128_LDS_BYTES <= RING_BYTES, "attention scratch fits the stage region");
        const attn_body::StaticOrder128 S(G, bx);
        attn_body::attn_phase128<attn_body::StaticOrder128>((char*)lds + RING_OFF, AT, S);
        if (!grpA) p0_range(in, ws, P0_MID, P0_EARLY, cw, cn, lane); } SEAM(2); }
    if (IN(3)) { REP(3) { pg8::Gemm g{PLD, (const bf16*)(ws + WS_WPOOL), PW, PG, PG, 0, nullptr}; pg8::PoolOrder S; S.init(M / 256, NPG, G, bx);
        pg8::EpiPool E{CAT, in[3], DM, 0};
        pg8::gemm_phase<pg8::EpiPool, pg8::PoolOrder, AL, SP>(L + RING_OFF, g, S, E);
        xcd_barrier(bar);
        combine_rows_q(O2, CAT, ws + WS_PLD, RS, in[4], in[5], in[6], in[7], in[8], gw, NGW, lane); } SEAM(3); }
    if (IN(4)) { REP(4) { pg8::Gemm g{(const bf16*)(ws + WS_PLD), (const bf16*)(ws + WS_W0OUT), DM, DM, DM, 0, RS}; pg8::StaticOrder S; S.init(M / 256, DM / 256, G, bx);
        pg8::EpiResid<false> E{Y, in[0], DM, ALPHA, 0.5f * DWI, 0};
        pg8::gemm_phase<pg8::EpiResid<false>, pg8::StaticOrder, AL, SP, 1, true, true>(L + RING_OFF, g, S, E); } SEAM(4); }
    if (IN(5)) { REP(5) { ln_rows_q(Y, in[10], in[11], XF, (unsigned char*)XBF, RS, gw, NGW, lane); } SEAM(5); }
    if (IN(6)) { REP(6) { pg8::Gemm g{XBF, (const bf16*)(ws + WS_WGU), DM, DM, DM, 0, RS}; pg8::StaticOrder S; S.init(M / 256, 2 * DFF / 256, G, bx);
        pg8::EpiSwigluF8 E{(unsigned char*)H, DFF, DWI, SH8};
        pg8::gemm_phase<pg8::EpiSwigluF8, pg8::StaticOrder, AL, SP, 1, true, true>(L + RING_OFF, g, S, E); } SEAM(6); }
    if (IN(7)) { REP(7) { pg8::Gemm g{H, (const bf16*)(ws + WS_WD), DFF, DFF, DFF, 0, nullptr}; pg8::StaticOrder S; S.init(M / 256, DM / 256, G, bx);
        pg8::EpiResid<true> E{Y, XF, DM, ALPHA, 1.f / (SH8 * SWD), 0};
        pg8::gemm_phase<pg8::EpiResid<true>, pg8::StaticOrder, AL, SP, 1>(L + RING_OFF, g, S, E); } SEAM(7); }
    if (IN(8)) { REP(8) { ln_rows_q(Y, in[15], in[16], XF, (unsigned char*)XBF, RS, gw, NGW, lane); } SEAM(8); }
    if (IN(9)) { REP(9) { pg8::Gemm g{XBF, (const bf16*)(ws + WS_W1IN), DM, DM, DM, 0, RS}; pg8::StaticOrder S; S.init(M / 256, 3 * DM / 256, G, bx);
        pg8::EpiL1in E{Z, BG, DWI, 0};
        pg8::gemm_phase<pg8::EpiL1in, pg8::StaticOrder, AL, SP, 1, true, true>(L + RING_OFF, g, S, E); } SEAM(9); }
    if (IN(10)) { REP(10) { conv_rows(BG, Z, in[18], V1, gw, NGW, lane); } SEAM(10); }
    if (IN(11)) { REP(11) { pg8::Gemm g{V1, (const bf16*)(ws + WS_W1OUT), DM, DM, DM, 0, nullptr}; pg8::StaticOrder S; S.init(M / 256, DM / 256, G, bx);
        pg8::EpiResid<true> E{Y, XF, DM, ALPHA, 1.f, 0};
        pg8::gemm_phase<pg8::EpiResid<true>, pg8::StaticOrder, AL, SP>(L + RING_OFF, g, S, E); } SEAM(11); }
    if (IN(12)) { ln_route_rows(Y, in[20], in[21], XF, XGS, RSG, in[22], cnt, tok, gw, NGW, lane, (LAS float*)(L + RING_OFF), in, ws); SEAM(12); }
    if (IN(14) || IN(15)) {
        int ts[NE + 1]; { int base = 0;
#pragma unroll
            for (int e = 0; e < NE; ++e) { ts[e] = base; base += (__builtin_amdgcn_readfirstlane((int)cnt[64 * e]) + 255) >> 8; } ts[NE] = base; }
        if (IN(14)) { REP(14) { pg8::Gemm g{(const bf16*)XGS, (const bf16*)(ws + WS_EGU), DM, DM, DM, 0, RSG}; typedef pg8::MoeOrderX<2 * EFF / 256> OrdGU; OrdGU S; S.init(ts[NE], 2 * EFF / 256, G, bx);
            S.ts1 = ts[1]; S.ts2 = ts[2]; S.ts3 = ts[3]; S.ts4 = ts[4]; S.ts5 = ts[5]; S.ts6 = ts[6]; S.ts7 = ts[7];
            pg8::EpiSwigluF8 E{HM8, EFF, DWI, SH8};
            pg8::gemm_phase<pg8::EpiSwigluF8, OrdGU, AL, SP, 1, true, true>(L + RING_OFF, g, S, E); } SEAM(14); }
        if (IN(15)) { REP(15) { pg8::Gemm g{(const bf16*)HM8, (const bf16*)(ws + WS_ED), EFF, EFF, EFF / MOE_KS, 0, nullptr}; typedef pg8::MoeOrder<DM / 256, MOE_KS, EFF / MOE_KS> OrdD; OrdD S; S.init(ts[NE], MOE_KS * DM / 256, G, bx);
            S.ts1 = ts[1]; S.ts2 = ts[2]; S.ts3 = ts[3]; S.ts4 = ts[4]; S.ts5 = ts[5]; S.ts6 = ts[6]; S.ts7 = ts[7];
            pg8::EpiOut8 E{OS, OS_KS_STRIDE, DM, SO8 / (SH8 * SWD)};
            pg8::gemm_phase<pg8::EpiOut8, OrdD, AL, SP, 1>(L + RING_OFF, g, S, E); } SEAM(15); }
    }
    if (IN(16)) { REP(16) { final_rows<MOE_KS>(XF, OS, OS_KS_STRIDE, 1.f / SO8, tok, cnt, in[26], in[27], args.out, gw, NGW, lane); } }
#undef IN
#undef SEAM
#undef lane
}

#ifndef MK_OPT_MASK
#define MK_OPT_MASK 0x1FFFF
#endif
static_assert(MK_OPT_MASK == 0x1FFFF, "the naive fallbacks no longer match the buffer formats of the persistent kernel (fp8 paths, bf16 Y)");
extern "C" void kernel_launch(void* const* d_in, const int* in_sizes, int n_in, void* d_out, int out_size, void* d_ws, size_t ws_size, hipStream_t stream) {
    static int grid = 0;
    if (grid == 0) {
        if (n_in != 28 || out_size != M * DM || in_sizes[0] != M * DM || ws_size < WS_RSG + (size_t)NE * M * 4) { fprintf(stderr, "kernel_launch: unexpected shapes: n_in %d out %d ws %zu (need %zu); nothing launched\n", n_in, out_size, ws_size, (size_t)(WS_RSG + (size_t)NE * M * 4)); grid = -1; return; }
        int dev = 0, cus = 0, per_cu = 0;
        if (hipGetDevice(&dev) != hipSuccess || hipDeviceGetAttribute(&cus, hipDeviceAttributeMultiprocessorCount, dev) != hipSuccess) { fprintf(stderr, "kernel_launch: device query failed\n"); grid = -1; return; }
        if (hipFuncSetAttribute((const void*)mk_fwd, hipFuncAttributeMaxDynamicSharedMemorySize, LDS_BYTES) != hipSuccess) { fprintf(stderr, "kernel_launch: hipFuncSetAttribute failed\n"); grid = -1; return; }
        if (hipOccupancyMaxActiveBlocksPerMultiprocessor(&per_cu, (const void*)mk_fwd, NWAVES * 64, LDS_BYTES) != hipSuccess || per_cu < 1)
            fprintf(stderr, "kernel_launch: note: occupancy query reports %d workgroups per CU\n", per_cu);
        (void)hipGetLastError();
        grid = cus;
    }
    if (grid < 0) return;
    const float* in[28]; for (int i = 0; i < 28; ++i) in[i] = (const float*)d_in[i];
    unsigned char* ws = (unsigned char*)d_ws; float* out = (float*)d_out;
    if (hipMemsetAsync(ws + WS_CTL, 0, CTL_ZERO_BYTES, stream) != hipSuccess) { fprintf(stderr, "kernel_launch: memset failed\n"); return; }
    Args a{}; for (int i = 0; i < 28; ++i) a.in[i] = in[i]; a.out = out; a.ws = ws;
    int li = 0;
#if defined(PROBE_A_END)
    a.ph_lo = 0; a.ph_hi = PROBE_A_END; a.li = 0; hipLaunchKernelGGL(mk_fwd, dim3(grid), dim3(NWAVES * 64), LDS_BYTES, stream, a);
    a.ph_lo = PROBE_B_BEGIN; a.ph_hi = NPHASE; a.li = 1; hipLaunchKernelGGL(mk_fwd, dim3(grid), dim3(NWAVES * 64), LDS_BYTES, stream, a);
    return;
#endif
    for (int p = 0; p < NPHASE;) {
        if ((MK_OPT_MASK >> p) & 1) {
            int q = p; while (q < NPHASE && ((MK_OPT_MASK >> q) & 1)) ++q;
            a.ph_lo = p; a.ph_hi = q; a.li = li++;
            hipLaunchKernelGGL(mk_fwd, dim3(grid), dim3(NWAVES * 64), LDS_BYTES, stream, a);
            const hipError_t le = hipPeekAtLastError();
            if (le != hipSuccess) { fprintf(stderr, "kernel_launch: launch failed: %s\n", hipGetErrorName(le)); return; }
            p = q; continue;
        }
        fprintf(stderr, "kernel_launch: phase %d has no fallback\n", p); return;
    }
}
```
